# Optimizing an MI355X kernel written in HIP

```python
import jax, jax.numpy as jnp
from jax import lax
import numpy as np

D_MODEL = 1024
BATCH = 8
SEQ = 4096
DEPTH = 1

N_MEM = 256
HG_HEADS = 4
HG_DK = 128
HG_DV = 128
ML_HEADS = 4
ML_DK = 128
ML_DV = 128
D_HG = HG_HEADS * HG_DV
D_ML = ML_HEADS * ML_DV
D_MIX = D_HG + D_ML
CHUNK = 64
ML_CONV = 4
FFN_CONV = 3
D_FF = 2816
CA_HEADS = 4
CA_DH = D_MODEL // CA_HEADS
ALPHA = (2.0 * DEPTH) ** 0.25
BETA = (8.0 * DEPTH) ** -0.25
LN_EPS = 1e-5
NEG_BIG = -1e30

IN_SIZES = (HG_HEADS * HG_DK, HG_HEADS * HG_DK, D_HG, D_HG,
            ML_HEADS * ML_DK, ML_HEADS * ML_DK, D_ML, D_ML, ML_HEADS, ML_HEADS)
IN_SPLITS = tuple(int(c) for c in np.cumsum(IN_SIZES)[:-1])
D_IN = int(sum(IN_SIZES))
FG_START = int(sum(IN_SIZES[:-1]))

kernel_name = 'hybrid_hgrn2_mlstm_deepnorm'


def layer_norm(x, g, b):
    xf = x.astype(jnp.float32)
    mu = jnp.mean(xf, axis=-1, keepdims=True)
    var = jnp.mean(jnp.square(xf - mu), axis=-1, keepdims=True)
    return ((xf - mu) * lax.rsqrt(var + LN_EPS) * g + b).astype(x.dtype)


def head_rms_norm(h, w):
    y = h * lax.rsqrt(jnp.mean(h * h, axis=-1, keepdims=True) + LN_EPS)
    return y.reshape(*h.shape[:-2], -1) * w


def head_layer_norm(h, w):
    mu = jnp.mean(h, axis=-1, keepdims=True)
    var = jnp.mean(jnp.square(h - mu), axis=-1, keepdims=True)
    y = (h - mu) * lax.rsqrt(var + LN_EPS)
    return y.reshape(*h.shape[:-2], -1) * w


def causal_dwconv(x, w, b):
    k_w = w.shape[0]
    s = x.shape[1]
    xp = jnp.pad(x, ((0, 0), (k_w - 1, 0), (0, 0)))
    y = b
    for j in range(k_w):
        y = y + xp[:, j:j + s] * w[j]
    return y


def to_chunks(t):
    bsz, s, h = t.shape[:3]
    t = t.reshape(bsz, s // CHUNK, CHUNK, h, *t.shape[3:])
    return jnp.moveaxis(jnp.moveaxis(t, 1, 0), 3, 2)


def from_chunks(t):
    t = jnp.moveaxis(jnp.moveaxis(t, 2, 3), 0, 1)
    return t.reshape(t.shape[0], t.shape[1] * t.shape[2], *t.shape[3:])


def hgrn2_chunkwise(q, k, v, log_f):
    bsz, _, h, dk = q.shape
    dv = v.shape[-1]
    mask = jnp.tril(jnp.ones((CHUNK, CHUNK), dtype=bool))

    def step(state, inp):
        q_, k_, v_, lf = inp
        b = jnp.cumsum(lf, axis=2)
        b_ref = b[:, :, CHUNK // 2 - 1:CHUNK // 2]
        attn = jnp.einsum('bhtd,bhsd->bhts', q_ * jnp.exp(b - b_ref), k_ * jnp.exp(b_ref - b))
        attn = jnp.where(mask, attn, 0.0)
        o = (jnp.einsum('bhts,bhsv->bhtv', attn, v_)
             + jnp.einsum('bhtd,bhdv->bhtv', q_ * jnp.exp(b), state))
        b_last = b[:, :, -1:]
        state = (jnp.exp(b_last)[:, :, 0, :, None] * state
                 + jnp.einsum('bhsd,bhsv->bhdv', k_ * jnp.exp(b_last - b), v_))
        return state, o

    s0 = jnp.zeros((bsz, h, dk, dv), jnp.float32)
    _, o = lax.scan(step, s0, (to_chunks(q), to_chunks(k), to_chunks(v), to_chunks(log_f)))
    return from_chunks(o)


def mlstm_chunkwise(q, k, v, i_log, f_log):
    bsz, _, h, dk = q.shape
    dv = v.shape[-1]
    mask = jnp.tril(jnp.ones((CHUNK, CHUNK), dtype=bool))

    def step(carry, inp):
        c_st, n_st, m_st = carry
        q_, k_, v_, ig, lf = inp
        b = jnp.cumsum(lf, axis=-1)
        g = b[..., -1]
        d = jnp.where(mask, b[..., :, None] - b[..., None, :] + ig[..., None, :], -jnp.inf)
        inter = b + m_st[..., None]
        m_t = jnp.maximum(inter, jnp.max(d, axis=-1))
        w = jnp.exp(d - m_t[..., None])
        s = jnp.einsum('bhtd,bhsd->bhts', q_, k_) * w
        w_inter = jnp.exp(inter - m_t)
        num = (jnp.einsum('bhts,bhsv->bhtv', s, v_)
               + w_inter[..., None] * jnp.einsum('bhtd,bhdv->bhtv', q_, c_st))
        den = jnp.sum(s, axis=-1) + w_inter * jnp.einsum('bhtd,bhd->bht', q_, n_st)
        h_out = num / jnp.maximum(jnp.abs(den), jnp.exp(-m_t))[..., None]
        a = g[..., None] - b + ig
        m_new = jnp.maximum(g + m_st, jnp.max(a, axis=-1))
        decay = jnp.exp(g + m_st - m_new)
        wk = k_ * jnp.exp(a - m_new[..., None])[..., None]
        c_st = decay[..., None, None] * c_st + jnp.einsum('bhsd,bhsv->bhdv', wk, v_)
        n_st = decay[..., None] * n_st + jnp.sum(wk, axis=2)
        return (c_st, n_st, m_new), h_out

    init = (jnp.zeros((bsz, h, dk, dv), jnp.float32),
            jnp.zeros((bsz, h, dk), jnp.float32),
            jnp.full((bsz, h), NEG_BIG, jnp.float32))
    _, o = lax.scan(step, init, (to_chunks(q), to_chunks(k), to_chunks(v),
                                 to_chunks(i_log), to_chunks(f_log)))
    return from_chunks(o)


def hybrid_mixer(x, w_in, b_in, lb, hg_norm_w, ml_conv_w, ml_conv_b, ml_norm_w, w_out):
    bsz, s, _ = x.shape
    proj = x @ w_in + b_in
    hq, hf, hi, hg, mq, mk, mv, mo, mi, mf = jnp.split(proj, IN_SPLITS, axis=-1)
    f32 = lambda t: t.astype(jnp.float32)
    heads = lambda t, nh: t.reshape(bsz, s, nh, -1)
    sig = jax.nn.sigmoid(f32(hf))
    log_f = jnp.log(lb + (1.0 - lb) * sig)
    k_in = (1.0 - lb) * jax.nn.sigmoid(-f32(hf))
    o_hg = hgrn2_chunkwise(heads(jax.nn.silu(f32(hq)), HG_HEADS), heads(k_in, HG_HEADS),
                           heads(f32(hi), HG_HEADS), heads(log_f, HG_HEADS))
    o_hg = head_rms_norm(o_hg, hg_norm_w) * jax.nn.silu(f32(hg))
    qk = jax.nn.silu(f32(causal_dwconv(jnp.concatenate([mq, mk], axis=-1), ml_conv_w, ml_conv_b)))
    q_ml, k_ml = jnp.split(qk, 2, axis=-1)
    h_ml = mlstm_chunkwise(heads(q_ml, ML_HEADS) * (ML_DK ** -0.5), heads(k_ml, ML_HEADS),
                           heads(f32(mv), ML_HEADS), f32(mi), jax.nn.log_sigmoid(f32(mf)))
    o_ml = jax.nn.sigmoid(f32(mo)) * head_layer_norm(h_ml, ml_norm_w)
    y = jnp.concatenate([o_hg, o_ml], axis=-1).astype(x.dtype)
    return y @ w_out


def memory_cross_attention(x, mem, wq, wkv, wo):
    bsz, s, d = x.shape
    q = (x @ wq).reshape(bsz, s, CA_HEADS, CA_DH)
    k, v = jnp.split(mem @ wkv, 2, axis=-1)
    k = k.reshape(bsz, -1, CA_HEADS, CA_DH)
    v = v.reshape(bsz, -1, CA_HEADS, CA_DH)
    sc = jnp.einsum('bshd,bmhd->bhsm', q, k).astype(jnp.float32) * (CA_DH ** -0.5)
    p = jax.nn.softmax(sc, axis=-1).astype(v.dtype)
    o = jnp.einsum('bhsm,bmhd->bshd', p, v).reshape(bsz, s, d)
    return o @ wo


def conv_ffn(x, w_up, conv_w, conv_b, w_down):
    u = causal_dwconv(x @ w_up, conv_w, conv_b)
    gate, val = jnp.split(u, 2, axis=-1)
    return (jax.nn.gelu(gate) * val) @ w_down


def setup_inputs(seed: int = 0) -> dict:
    key = jax.random.key(seed)
    ks = jax.random.split(key, 24)
    nrm = lambda k, shape, scale: jax.random.normal(k, shape, jnp.float32) * scale
    b_in = nrm(ks[3], (DEPTH, D_IN), 0.02)
    b_in = b_in.at[:, FG_START:].add(jnp.linspace(3.0, 6.0, ML_HEADS, dtype=jnp.float32))
    return {
        'x': nrm(ks[0], (BATCH, SEQ, D_MODEL), 1.0),
        'mem': nrm(ks[1], (BATCH, N_MEM, D_MODEL), 1.0),
        'w_in': nrm(ks[2], (DEPTH, D_MODEL, D_IN), D_MODEL ** -0.5),
        'b_in': b_in,
        'hg_lb_logits': 1.0 + nrm(ks[4], (DEPTH + 1, D_HG), 0.3),
        'hg_norm_w': 1.0 + nrm(ks[5], (DEPTH, D_HG), 0.02),
        'ml_conv_w': nrm(ks[6], (DEPTH, ML_CONV, 2 * D_ML), ML_CONV ** -0.5),
        'ml_conv_b': nrm(ks[7], (DEPTH, 2 * D_ML), 0.02),
        'ml_norm_w': 1.0 + nrm(ks[8], (DEPTH, D_ML), 0.02),
        'w_out': nrm(ks[9], (DEPTH, D_MIX, D_MODEL), BETA * D_MIX ** -0.5),
        'ln1_g': 1.0 + nrm(ks[10], (DEPTH, D_MODEL), 0.02),
        'ln1_b': nrm(ks[11], (DEPTH, D_MODEL), 0.02),
        'ca_wq': nrm(ks[12], (DEPTH, D_MODEL, D_MODEL), D_MODEL ** -0.5),
        'ca_wkv': nrm(ks[13], (DEPTH, D_MODEL, 2 * D_MODEL), D_MODEL ** -0.5),
        'ca_wo': nrm(ks[14], (DEPTH, D_MODEL, D_MODEL), BETA * D_MODEL ** -0.5),
        'ln2_g': 1.0 + nrm(ks[15], (DEPTH, D_MODEL), 0.02),
        'ln2_b': nrm(ks[16], (DEPTH, D_MODEL), 0.02),
        'ffn_w_up': nrm(ks[17], (DEPTH, D_MODEL, 2 * D_FF), D_MODEL ** -0.5),
        'ffn_conv_w': nrm(ks[18], (DEPTH, FFN_CONV, 2 * D_FF), FFN_CONV ** -0.5),
        'ffn_conv_b': nrm(ks[19], (DEPTH, 2 * D_FF), 0.02),
        'ffn_w_down': nrm(ks[20], (DEPTH, D_FF, D_MODEL), BETA * D_FF ** -0.5),
        'ln3_g': 1.0 + nrm(ks[21], (DEPTH, D_MODEL), 0.02),
        'ln3_b': nrm(ks[22], (DEPTH, D_MODEL), 0.02),
    }


def reference(x, mem, w_in, b_in, hg_lb_logits, hg_norm_w, ml_conv_w, ml_conv_b, ml_norm_w,
              w_out, ln1_g, ln1_b, ca_wq, ca_wkv, ca_wo, ln2_g, ln2_b,
              ffn_w_up, ffn_conv_w, ffn_conv_b, ffn_w_down, ln3_g, ln3_b):
    lower_bounds = jnp.cumsum(jax.nn.softmax(hg_lb_logits.astype(jnp.float32), axis=0), axis=0)
    for l in range(DEPTH):
        mix = hybrid_mixer(x, w_in[l], b_in[l], lower_bounds[l], hg_norm_w[l],
                           ml_conv_w[l], ml_conv_b[l], ml_norm_w[l], w_out[l])
        x = layer_norm(ALPHA * x + mix, ln1_g[l], ln1_b[l])
        ca = memory_cross_attention(x, mem, ca_wq[l], ca_wkv[l], ca_wo[l])
        x = layer_norm(ALPHA * x + ca, ln2_g[l], ln2_b[l])
        ff = conv_ffn(x, ffn_w_up[l], ffn_conv_w[l], ffn_conv_b[l], ffn_w_down[l])
        x = layer_norm(ALPHA * x + ff, ln3_g[l], ln3_b[l])
    return x
```

```cpp
#include <hip/hip_runtime.h>
#include <hip/hip_cooperative_groups.h>
#include <cstdio>
#include <cstdint>
namespace cg = cooperative_groups;
namespace pg8 {
#define PG8_LAS __attribute__((address_space(3)))
typedef unsigned short bf16_t;
typedef short bf16x8 __attribute__((ext_vector_type(8)));
typedef float f32x4 __attribute__((ext_vector_type(4)));
typedef unsigned u32x4 __attribute__((ext_vector_type(4)));
constexpr int BM = 256, BK = 64, HALF = 128, HTB = HALF * BK * 2  , STAGE_BYTES = 8 * HTB, NXCD = 8, WGM = 8;

__host__ __device__ __forceinline__ int lds_byte(int r, int c) { const int st = (r >> 4) * 2 + (c >> 5), rr = r & 15, cc = c & 31, ob = rr * 64 + cc * 2; return st * 1024 + (ob ^ (((ob >> 9) & 1) << 5)); }
__host__ __device__ __forceinline__ void stage_rc(int b, int& R, int& C) { const int st = b / 1024, sb = b % 1024, swz = sb ^ (((sb >> 9) & 1) << 5); R = (st >> 1) * 16 + swz / 64; C = (st & 1) * 32 + (swz % 64) / 2; }
__host__ __device__ __forceinline__ int perm32(int rho) { const int n = rho >> 4, i = rho & 15; return 8 * (i >> 2) + 4 * n + (i & 3); }

struct Unit { int pm, pn; };
struct Gemm { const bf16_t* A; const bf16_t* Bt; int M, N, K; };

struct StaticOrder {
    int nM, nN, nwg, G, c;
    __host__ __device__ void init(int M, int N, int G_, int c_) { nM = M / BM; nN = N / BM; nwg = nM * nN; G = G_; c = c_; }
    __host__ __device__ bool next(int i, Unit& u) const {
        const long L = (long)i * G + c; if (L >= nwg) return false;
        int wgid = (int)L; { const int q = nwg / NXCD, r = nwg % NXCD, xcd = wgid % NXCD, off = wgid / NXCD; wgid = (xcd < r ? xcd * (q + 1) : r * (q + 1) + (xcd - r) * q) + off; }
        const int nig = WGM * nN, gid = wgid / nig, fm = gid * WGM, gsz = (nM - fm) < WGM ? (nM - fm) : WGM;
        u.pm = fm + ((wgid % nig) % gsz); u.pn = (wgid % nig) / gsz; return true;
    }
    __device__ __forceinline__ void a_ready(const Unit&) const {}
    __device__ __forceinline__ void done(const Unit&) const {}
};
__device__ __forceinline__ unsigned cvt_pk_bf16(float lo, float hi) { unsigned r; asm volatile("v_cvt_pk_bf16_f32 %0, %1, %2" : "=v"(r) : "v"(lo), "v"(hi)); return r; }
typedef float f32x2 __attribute__((ext_vector_type(2)));
struct EpiB16 {
    static constexpr bool PERM = true, AFTER_DRAIN = false;
    bf16_t* O; int ldc; const float* bias;
    __device__ __forceinline__ void operator()(const f32x4 (&acc)[2][2][4][2], const Unit& u, int wr, int wc, int fr, int fq) const {
        const int row0 = u.pm * BM + wr * 64 + fr; const int col0 = u.pn * BM + wc * 32 + 8 * fq;
        f32x4 bv[2][2];
#pragma unroll
        for (int bj = 0; bj < 2; ++bj)
#pragma unroll
            for (int n = 0; n < 2; ++n) bv[bj][n] = bias ? *(const f32x4*)(bias + col0 + bj * HALF + 4 * n) : (f32x4){0.f, 0.f, 0.f, 0.f};
#pragma unroll
        for (int ai = 0; ai < 2; ++ai)
#pragma unroll
            for (int m = 0; m < 4; ++m) { bf16_t* rowp = O + (size_t)(row0 + ai * HALF + m * 16) * ldc + col0;
#pragma unroll
                for (int bj = 0; bj < 2; ++bj) { f32x4 v0 = acc[ai][bj][m][0] + bv[bj][0], v1 = acc[ai][bj][m][1] + bv[bj][1];
                    u32x4 w; w.x = cvt_pk_bf16(v0[0], v0[1]); w.y = cvt_pk_bf16(v0[2], v0[3]); w.z = cvt_pk_bf16(v1[0], v1[1]); w.w = cvt_pk_bf16(v1[2], v1[3]);
                    *(u32x4*)(rowp + bj * HALF) = w; } }
    }
};
struct EpiRes {
    static constexpr bool PERM = false, AFTER_DRAIN = false;
    const float* base; float* out; int ldc; float alpha;
    __device__ __forceinline__ void operator()(const f32x4 (&acc)[2][2][4][2], const Unit& u, int wr, int wc, int fr, int fq) const {
        const int row0 = u.pm * BM + wr * 64 + fr, col0 = u.pn * BM + wc * 32 + 4 * fq;
#pragma unroll
        for (int ai = 0; ai < 2; ++ai)
#pragma unroll
            for (int m = 0; m < 4; ++m) { const size_t off = (size_t)(row0 + ai * HALF + m * 16) * ldc + col0;
#pragma unroll
                for (int bj = 0; bj < 2; ++bj)
#pragma unroll
                    for (int n = 0; n < 2; ++n) { const f32x4 bs = *(const f32x4*)(base + off + bj * HALF + n * 16);
                        *(f32x4*)(out + off + bj * HALF + n * 16) = bs * alpha + acc[ai][bj][m][n]; } }
    }
};
template <class Epi, class Sched, bool STAMP = false>
__device__ __forceinline__ void gemm_phase(PG8_LAS unsigned char* lds, const Gemm g, const Sched& S, const Epi& E, unsigned long long* stamps) {
    const int tid = threadIdx.x, wid = __builtin_amdgcn_readfirstlane(tid >> 6), lane = tid & 63, wr = wid >> 2, wc = wid & 3, fr = lane & 15, fq = lane >> 4;
    const int K = g.K, nt = K / BK;
    int ts_lo = 0, ts_hi = 0, nts = 0; const unsigned long long rt_entry = STAMP ? (unsigned long long)wall_clock64() : 0ull;
#define PG8_STAMP() do { if (STAMP && wid == 0 && nts < 64) { const unsigned long long _c = (unsigned long long)clock64(); \
        ts_lo = (lane == nts) ? (int)(unsigned)_c : ts_lo; ts_hi = (lane == nts) ? (int)(unsigned)(_c >> 32) : ts_hi; ++nts; } } while (0)
    PG8_STAMP();
    unsigned voffA[2], voffB[2];
#pragma unroll
    for (int i = 0; i < 2; ++i) { int R, C; stage_rc(tid * 16 + i * 8192, R, C); const int Rb = Epi::PERM ? ((R & ~31) + perm32(R & 31)) : R;
        voffA[i] = (unsigned)(R * K + C) * 2u; voffB[i] = (unsigned)(Rb * K + C) * 2u; }
    const size_t kstep = (size_t)(BK * 2);
    const size_t hstep = (size_t)HALF * K * 2;
    const size_t tstep = 2 * hstep;
    const unsigned ldsw = (unsigned)wid * 1024u;
    const int aoff = lds_byte(wr * 64 + fr, fq * 8), boff = lds_byte(wc * 32 + fr, fq * 8);
#define PG8_SA(b, h) (((b) * 2 + (h)) * HTB)
#define PG8_SB(b, h) ((4 + (b) * 2 + (h)) * HTB)
#define PG8_STAGE(bufoff, gbase, voff) do { _Pragma("unroll") for (int _i = 0; _i < 2; ++_i) \
        __builtin_amdgcn_global_load_lds((const unsigned*)((const char*)(gbase) + (voff)[_i]), (PG8_LAS unsigned*)(lds + (bufoff) + ldsw + _i * 8192), 16, 0, 0); } while (0)
#define PG8_LDA(dst, b, h) do { _Pragma("unroll") for (int m = 0; m < 4; ++m) _Pragma("unroll") for (int k = 0; k < 2; ++k) dst[m][k] = *(const PG8_LAS bf16x8*)(lds + PG8_SA(b, h) + aoff + m * 2048 + k * 1024); } while (0)
#define PG8_LDB(dst, b, h) do { _Pragma("unroll") for (int n = 0; n < 2; ++n) _Pragma("unroll") for (int k = 0; k < 2; ++k) dst[n][k] = *(const PG8_LAS bf16x8*)(lds + PG8_SB(b, h) + boff + n * 2048 + k * 1024); } while (0)
#define PG8_MMA(ai, bj, At, Bt) do { __builtin_amdgcn_s_setprio(1); _Pragma("unroll") for (int m = 0; m < 4; ++m) _Pragma("unroll") for (int n = 0; n < 2; ++n) _Pragma("unroll") for (int k = 0; k < 2; ++k) \
        acc[ai][bj][m][n] = __builtin_amdgcn_mfma_f32_16x16x32_bf16(Bt[n][k], At[m][k], acc[ai][bj][m][n], 0, 0, 0); __builtin_amdgcn_s_setprio(0); } while (0)
#define PG8_WAIT_V(n) asm volatile("s_waitcnt vmcnt(" #n ")" ::: "memory")
#define PG8_WAIT_L(n) asm volatile("s_waitcnt lgkmcnt(" #n ")" ::: "memory")
#define PG8_BAR __builtin_amdgcn_s_barrier()
#define PG8_SCHED __builtin_amdgcn_sched_barrier(0)
    Unit cur, nxt; int ui = 0;
    if (!S.next(0, cur)) return;
    f32x4 acc[2][2][4][2];
#pragma unroll
    for (int a = 0; a < 2; ++a)
#pragma unroll
        for (int b = 0; b < 2; ++b)
#pragma unroll
            for (int m = 0; m < 4; ++m)
#pragma unroll
                for (int n = 0; n < 2; ++n) acc[a][b][m][n] = (f32x4){0.f, 0.f, 0.f, 0.f};
    bf16x8 At[4][2], B0[2][2], B1[2][2];
    const char* cA = (const char*)g.A + (size_t)cur.pm * tstep; const char* cB = (const char*)g.Bt + (size_t)cur.pn * tstep;
    S.a_ready(cur);
    PG8_STAGE(PG8_SB(0, 0), cB, voffB); PG8_STAGE(PG8_SA(0, 0), cA, voffA); PG8_STAGE(PG8_SB(0, 1), cB + hstep, voffB); PG8_STAGE(PG8_SA(0, 1), cA + hstep, voffA);
    if (wr == 1) PG8_BAR;
    PG8_WAIT_V(4); PG8_BAR;
    PG8_STAGE(PG8_SB(1, 0), cB + kstep, voffB); PG8_STAGE(PG8_SA(1, 0), cA + kstep, voffA); PG8_STAGE(PG8_SB(1, 1), cB + hstep + kstep, voffB);
    PG8_WAIT_V(6); PG8_BAR;
    PG8_STAMP();
    for (;;) {
        const bool has_next = S.next(ui + 1, nxt);
        const char* nA = has_next ? (const char*)g.A + (size_t)nxt.pm * tstep : cA; const char* nB = has_next ? (const char*)g.Bt + (size_t)nxt.pn * tstep : cB;
        for (int t = 0; t < nt; t += 2) {
            const bool last = (t == nt - 2);
            const char* a1 = cA + (size_t)(t + 1) * kstep;
            const char* a2 = last ? nA : cA + (size_t)(t + 2) * kstep; const char* b2 = last ? nB : cB + (size_t)(t + 2) * kstep;
            const char* a3 = a2 + kstep; const char* b3 = b2 + kstep;
            if (last && has_next) S.a_ready(nxt);
            PG8_LDB(B0, 0, 0); PG8_SCHED; PG8_LDA(At, 0, 0); PG8_STAGE(PG8_SA(1, 1), a1 + hstep, voffA);
            PG8_WAIT_L(8); PG8_BAR; PG8_WAIT_L(0); PG8_MMA(0, 0, At, B0); PG8_BAR; PG8_SCHED;
            PG8_LDB(B1, 0, 1); PG8_STAGE(PG8_SB(0, 0), b2, voffB);
            PG8_BAR; PG8_WAIT_L(0); PG8_MMA(0, 1, At, B1); PG8_BAR;
            PG8_LDA(At, 0, 1); PG8_STAGE(PG8_SA(0, 0), a2, voffA);
            PG8_BAR; PG8_WAIT_L(0); PG8_MMA(1, 0, At, B0); PG8_BAR; PG8_SCHED;
            PG8_STAGE(PG8_SB(0, 1), b2 + hstep, voffB);
            PG8_WAIT_V(6); PG8_BAR; PG8_MMA(1, 1, At, B1); PG8_BAR;
            PG8_LDB(B0, 1, 0); PG8_SCHED; PG8_LDA(At, 1, 0); PG8_STAGE(PG8_SA(0, 1), a2 + hstep, voffA);
            PG8_WAIT_L(8); PG8_BAR; PG8_WAIT_L(0); PG8_MMA(0, 0, At, B0); PG8_BAR; PG8_SCHED;
            PG8_LDB(B1, 1, 1); PG8_STAGE(PG8_SB(1, 0), b3, voffB);
            PG8_BAR; PG8_WAIT_L(0); PG8_MMA(0, 1, At, B1); PG8_BAR;
            PG8_LDA(At, 1, 1); PG8_STAGE(PG8_SA(1, 0), a3, voffA);
            PG8_BAR; PG8_WAIT_L(0); PG8_MMA(1, 0, At, B0); PG8_BAR; PG8_SCHED;
            PG8_STAGE(PG8_SB(1, 1), b3 + hstep, voffB);
            PG8_WAIT_V(6); PG8_BAR; PG8_MMA(1, 1, At, B1); PG8_BAR;
        }
        PG8_STAMP();
        if constexpr (!Epi::AFTER_DRAIN) { E(acc, cur, wr, wc, fr, fq); S.done(cur); }
        PG8_STAMP();
        if (!has_next) break;
#pragma unroll
        for (int a = 0; a < 2; ++a)
#pragma unroll
            for (int b = 0; b < 2; ++b)
#pragma unroll
                for (int m = 0; m < 4; ++m)
#pragma unroll
                    for (int n = 0; n < 2; ++n) acc[a][b][m][n] = (f32x4){0.f, 0.f, 0.f, 0.f};
        cur = nxt; cA = nA; cB = nB; ++ui;
    }
    PG8_WAIT_V(0);
    if (wr == 0) PG8_BAR;
    PG8_BAR;
    if constexpr (Epi::AFTER_DRAIN) { E.fused(acc, cur, wr, wc, fr, fq, lds, wid, lane); S.done(cur); }
    PG8_STAMP();
    if (STAMP && wid == 0) { stamps[lane] = lane < nts ? (((unsigned long long)(unsigned)ts_hi << 32) | (unsigned)ts_lo) : 0ull;
        if (lane == 62) stamps[62] = rt_entry; if (lane == 63) stamps[63] = (unsigned long long)wall_clock64(); }
#undef PG8_STAMP
#undef PG8_SA
#undef PG8_SB
#undef PG8_STAGE
#undef PG8_LDA
#undef PG8_LDB
#undef PG8_MMA
#undef PG8_WAIT_V
#undef PG8_WAIT_L
#undef PG8_BAR
#undef PG8_SCHED
}
}
using pg8::bf16_t; using pg8::bf16x8; using pg8::f32x4;
#define LAS __attribute__((address_space(3)))
#ifndef N_LAUNCH_MODE
#define N_LAUNCH_MODE 1
#endif
constexpr int T = 32768, D = 1024, SEQ = 4096, NMEMR = 2048, DIN = 4104, NP = 4096, DFF = 2816, NUP = 5632, TH = 16384;
constexpr float ALPHA = 1.189207115002721f, LN_EPS = 1e-5f;
constexpr int HQ = 0, HF = 512, HI = 1024, HG = 1536, MQ = 2048, MK = 2560, MV = 3072, MO = 3584;
constexpr size_t MiB = 1ull << 20;
constexpr size_t WS_WIN = 0, WS_WOUT = 8 * MiB, WS_WQ = 10 * MiB, WS_WKV = 12 * MiB, WS_WO = 16 * MiB, WS_WUP = 18 * MiB, WS_WDN = 29 * MiB,
                 WS_GATES = 35 * MiB, WS_MEMB = 36 * MiB, WS_KB = 40 * MiB, WS_VT = 44 * MiB,
                 WS_XB = 50 * MiB  , WS_PROJ = 114 * MiB, WS_X1 = 114 * MiB, WS_X1B = 242 * MiB  , WS_QB = 306 * MiB,
                 WS_UB = 50 * MiB, WS_HB = 306 * MiB;
constexpr int LDS_BYTES = 132 * 1024;
constexpr int NPH = 15;
struct Args { const float* in[23]; float* out; unsigned char* ws; int ph_lo, ph_hi; };

#define WAVE_LDS_SYNC() asm volatile("s_waitcnt lgkmcnt(0)" ::: "memory")
__device__ __forceinline__ unsigned pk2(float a, float b) { return pg8::cvt_pk_bf16(a, b); }
__device__ __forceinline__ bf16_t f2bf(float a) { return (bf16_t)(pk2(a, a) & 0xffffu); }
__device__ __forceinline__ float bf2f(bf16_t u) { return __uint_as_float(((unsigned)u) << 16); }
__device__ __forceinline__ float bflo(unsigned u) { return __uint_as_float(u << 16); }
__device__ __forceinline__ float bfhi(unsigned u) { return __uint_as_float(u & 0xffff0000u); }
__device__ __forceinline__ float wave_sum(float v) {
#pragma unroll
    for (int o = 1; o < 64; o <<= 1) v += __shfl_xor(v, o);
    return v;
}
__device__ __forceinline__ float sigm(float x) { return 1.f / (1.f + __expf(-x)); }
__device__ __forceinline__ float gelu_tanh(float x) { const float u = 0.7978845608028654f * (x + 0.044715f * x * x * x); const float th = 1.f - 2.f / (1.f + __expf(2.f * u)); return 0.5f * x * (1.f + th); }

__device__ __forceinline__ void transpose_item(const float* W, int ldw, int K, int N, bf16_t* WT, LAS float* scr, int item, int lane) {
    const int nblk = N / 32, kb = item / nblk, nb = item % nblk, k0 = 64 * kb, n0 = 32 * nb;
#pragma unroll 8
    for (int i = 0; i < 32; ++i) { const int kk = 2 * i + (lane >> 5); scr[kk * 33 + (lane & 31)] = W[(size_t)(k0 + kk) * ldw + n0 + (lane & 31)]; }
    WAVE_LDS_SYNC();
    const int c = lane & 7;
#pragma unroll
    for (int j = 0; j < 4; ++j) { const int n = (lane >> 3) + 8 * j; const LAS float* s = scr + (8 * c) * 33 + n;
        uint4 o; o.x = pk2(s[0 * 33], s[1 * 33]); o.y = pk2(s[2 * 33], s[3 * 33]); o.z = pk2(s[4 * 33], s[5 * 33]); o.w = pk2(s[6 * 33], s[7 * 33]);
        *(uint4*)(WT + (size_t)(n0 + n) * K + k0 + 8 * c) = o; }
    WAVE_LDS_SYNC();
}
__device__ __forceinline__ void p0_prep(const Args& a, LAS unsigned char* lds, int tid, int wave, int lane, int gw, int NGW) {
    unsigned char* ws = a.ws;
    LAS float* wgT = (LAS float*)lds;
    LAS float* scr = (LAS float*)(lds + 32768 + wave * 8448);
    const float* w_in = a.in[2];
    for (int e = tid; e < 8192; e += 512) { const int k = e >> 3, c = e & 7; wgT[c * 1024 + k] = w_in[(size_t)k * DIN + 4096 + c]; }
    __syncthreads();
    constexpr int I_IN = 16 * 128, I_SQ = 16 * 32, I_KV = 16 * 64, I_UP = 16 * 176, I_DN = 44 * 32;
    constexpr int NITEMS = I_IN + 3 * I_SQ + I_KV + I_UP + I_DN;
    for (int it = gw; it < NITEMS; it += NGW) {
        int r = it;
        if (r < I_IN) { transpose_item(a.in[2], DIN, D, NP, (bf16_t*)(ws + WS_WIN), scr, r, lane); continue; } r -= I_IN;
        if (r < I_SQ) { transpose_item(a.in[9], D, D, D, (bf16_t*)(ws + WS_WOUT), scr, r, lane); continue; } r -= I_SQ;
        if (r < I_SQ) { transpose_item(a.in[12], D, D, D, (bf16_t*)(ws + WS_WQ), scr, r, lane); continue; } r -= I_SQ;
        if (r < I_KV) { transpose_item(a.in[13], 2 * D, D, 2 * D, (bf16_t*)(ws + WS_WKV), scr, r, lane); continue; } r -= I_KV;
        if (r < I_SQ) { transpose_item(a.in[14], D, D, D, (bf16_t*)(ws + WS_WO), scr, r, lane); continue; } r -= I_SQ;
        if (r < I_UP) { transpose_item(a.in[17], NUP, D, NUP, (bf16_t*)(ws + WS_WUP), scr, r, lane); continue; } r -= I_UP;
        transpose_item(a.in[20], D, DFF, D, (bf16_t*)(ws + WS_WDN), scr, r, lane);
    }
    const float* x = a.in[0]; const float* b_in = a.in[3];
    bf16_t* xb = (bf16_t*)(ws + WS_XB); float* gates = (float*)(ws + WS_GATES);
    for (int m = gw; m < T; m += NGW) {
        const f32x4* xr = (const f32x4*)(x + (size_t)m * D) + lane;
        uint2* xo = (uint2*)(xb + (size_t)m * D) + lane;
        float g[8];
#pragma unroll
        for (int c = 0; c < 8; ++c) g[c] = 0.f;
#pragma unroll
        for (int j = 0; j < 4; ++j) { const f32x4 v = xr[64 * j]; uint2 o; o.x = pk2(v[0], v[1]); o.y = pk2(v[2], v[3]); xo[64 * j] = o;
#pragma unroll
            for (int c = 0; c < 8; ++c) { const f32x4 w = *(const LAS f32x4*)(wgT + c * 1024 + 4 * (lane + 64 * j)); g[c] += (v[0] * w[0] + v[1] * w[1]) + (v[2] * w[2] + v[3] * w[3]); } }
#pragma unroll
        for (int c = 0; c < 8; ++c) g[c] = wave_sum(g[c]);
        float r = g[0];
#pragma unroll
        for (int c = 1; c < 8; ++c) r = (lane == c) ? g[c] : r;
        if (lane < 8) gates[(size_t)m * 8 + lane] = r + b_in[4096 + lane];
    }
    const float* mem = a.in[1]; bf16_t* memb = (bf16_t*)(ws + WS_MEMB);
    for (int m = gw; m < NMEMR; m += NGW) {
        const f32x4* xr = (const f32x4*)(mem + (size_t)m * D) + lane; uint2* xo = (uint2*)(memb + (size_t)m * D) + lane;
#pragma unroll
        for (int j = 0; j < 4; ++j) { const f32x4 v = xr[64 * j]; uint2 o; o.x = pk2(v[0], v[1]); o.y = pk2(v[2], v[3]); xo[64 * j] = o; }
    }
}

__device__ __forceinline__ void hgrn2_rec(const Args& a, int b, int h, LAS float* lds, int tid, int wave, int lane) {
    const bf16_t* projb = (const bf16_t*)(a.ws + WS_PROJ); bf16_t* y = (bf16_t*)(a.ws + WS_XB);
    const float* lbl = a.in[4]; const float* nw = a.in[5];
    LAS float* sq = lds; LAS float* sf = lds + 2048; LAS float* sv = lds + 4096; LAS float* spart = lds + 6144;
    const int v = tid & 127, g = tid >> 7;
    const float l0 = lbl[h * 128 + v], l1 = lbl[512 + h * 128 + v]; const float lb = 1.f / (1.f + __expf(l1 - l0));
    float S[32];
#pragma unroll
    for (int i = 0; i < 32; ++i) S[i] = 0.f;
    for (int t0 = 0; t0 < SEQ; t0 += 16) {
#pragma unroll
        for (int i = 0; i < 4; ++i) { const int tt = g + 4 * i; const bf16_t* pr = projb + (size_t)(b * SEQ + t0 + tt) * NP + h * 128 + v;
            const float hq = bf2f(pr[HQ]), hf = bf2f(pr[HF]), hi = bf2f(pr[HI]);
            sq[tt * 128 + v] = hq * sigm(hq); sf[tt * 128 + v] = lb + (1.f - lb) * sigm(hf); sv[tt * 128 + v] = hi; }
        __syncthreads();
        for (int tt = 0; tt < 16; ++tt) { const float vv = sv[tt * 128 + v]; float part = 0.f;
#pragma unroll
            for (int i = 0; i < 32; i += 4) { const f32x4 f4 = *(const LAS f32x4*)(sf + tt * 128 + g * 32 + i), q4 = *(const LAS f32x4*)(sq + tt * 128 + g * 32 + i);
#pragma unroll
                for (int jj = 0; jj < 4; ++jj) { S[i + jj] = f4[jj] * S[i + jj] + (1.f - f4[jj]) * vv; part += q4[jj] * S[i + jj]; } }
            spart[(tt * 4 + g) * 128 + v] = part; }
        __syncthreads();
#pragma unroll
        for (int q = 0; q < 2; ++q) { const int tt = 2 * wave + q; const size_t row = (size_t)(b * SEQ + t0 + tt);
            float o0 = 0.f, o1 = 0.f;
#pragma unroll
            for (int gg = 0; gg < 4; ++gg) { o0 += spart[(tt * 4 + gg) * 128 + lane]; o1 += spart[(tt * 4 + gg) * 128 + lane + 64]; }
            const float rstd = rsqrtf(wave_sum(o0 * o0 + o1 * o1) * (1.f / 128.f) + LN_EPS);
            const float g0 = bf2f(projb[row * NP + HG + h * 128 + lane]), g1 = bf2f(projb[row * NP + HG + h * 128 + lane + 64]);
            y[row * D + h * 128 + lane] = f2bf(o0 * rstd * nw[h * 128 + lane] * (g0 * sigm(g0)));
            y[row * D + h * 128 + lane + 64] = f2bf(o1 * rstd * nw[h * 128 + lane + 64] * (g1 * sigm(g1))); }
    }
}
__device__ __forceinline__ void mlstm_rec(const Args& a, int b, int h, LAS float* lds, int tid, int wave, int lane) {
    const bf16_t* projb = (const bf16_t*)(a.ws + WS_PROJ); bf16_t* y = (bf16_t*)(a.ws + WS_XB); const float* gates = (const float*)(a.ws + WS_GATES);
    const float* cw = a.in[6]; const float* cb = a.in[7]; const float* nw = a.in[8];
    LAS float* sq = lds; LAS float* sk = lds + 2048; LAS float* sv = lds + 4096; LAS float* spart = lds + 6144;
    LAS float* sgi = lds + 6144 + 16 * 4 * 132; LAS float* sgf = sgi + 16; LAS float* smt = sgf + 16;
    const int v = tid & 127, g = tid >> 7;
    float cwq[4], cwk[4];
#pragma unroll
    for (int j = 0; j < 4; ++j) { cwq[j] = cw[j * 1024 + h * 128 + v]; cwk[j] = cw[j * 1024 + 512 + h * 128 + v]; }
    const float cbq = cb[h * 128 + v], cbk = cb[512 + h * 128 + v];
    float C[32], nn[32];
#pragma unroll
    for (int i = 0; i < 32; ++i) { C[i] = 0.f; nn[i] = 0.f; }
    float mrun = -1e30f;
    for (int t0 = 0; t0 < SEQ; t0 += 16) {
#pragma unroll
        for (int i = 0; i < 4; ++i) { const int tt = g + 4 * i, t = t0 + tt; const bf16_t* pr = projb + (size_t)(b * SEQ + t) * NP + h * 128 + v;
            float aq = cbq, ak = cbk;
#pragma unroll
            for (int j = 0; j < 4; ++j) { const int ts = t - 3 + j; if (ts >= 0) { const bf16_t* ps = pr - (size_t)(3 - j) * NP; aq += bf2f(ps[MQ]) * cwq[j]; ak += bf2f(ps[MK]) * cwk[j]; } }
            sq[tt * 128 + v] = aq * sigm(aq) * 0.08838834764831845f; sk[tt * 128 + v] = ak * sigm(ak); sv[tt * 128 + v] = bf2f(pr[MV]); }
        if (tid < 16) { const size_t row = (size_t)(b * SEQ + t0 + tid); const float mi = gates[row * 8 + h], mf = gates[row * 8 + 4 + h];
            sgi[tid] = mi; sgf[tid] = fminf(mf, 0.f) - log1pf(__expf(-fabsf(mf))); }
        __syncthreads();
        for (int tt = 0; tt < 16; ++tt) { const float vv = sv[tt * 128 + v];
            const float it = sgi[tt], lf = sgf[tt]; const float mnew = fmaxf(lf + mrun, it); const float fp = __expf(lf + mrun - mnew), ip = __expf(it - mnew); mrun = mnew;
            float part = 0.f, dpart = 0.f; const float iv = ip * vv;
#pragma unroll
            for (int i = 0; i < 32; i += 4) { const f32x4 k4 = *(const LAS f32x4*)(sk + tt * 128 + g * 32 + i), q4 = *(const LAS f32x4*)(sq + tt * 128 + g * 32 + i);
#pragma unroll
                for (int jj = 0; jj < 4; ++jj) { C[i + jj] = fp * C[i + jj] + iv * k4[jj]; nn[i + jj] = fp * nn[i + jj] + ip * k4[jj]; part += q4[jj] * C[i + jj]; dpart += q4[jj] * nn[i + jj]; } }
            spart[(tt * 4 + g) * 132 + v] = part; if (v == 0) spart[(tt * 4 + g) * 132 + 128] = dpart; if (tid == 0) smt[tt] = mnew; }
        __syncthreads();
#pragma unroll
        for (int q = 0; q < 2; ++q) { const int tt = 2 * wave + q; const size_t row = (size_t)(b * SEQ + t0 + tt);
            float o0 = 0.f, o1 = 0.f, den = 0.f;
#pragma unroll
            for (int gg = 0; gg < 4; ++gg) { o0 += spart[(tt * 4 + gg) * 132 + lane]; o1 += spart[(tt * 4 + gg) * 132 + lane + 64]; den += spart[(tt * 4 + gg) * 132 + 128]; }
            const float dn = 1.f / fmaxf(fabsf(den), __expf(-smt[tt]));
            o0 *= dn; o1 *= dn;
            const float mean = wave_sum(o0 + o1) * (1.f / 128.f); const float d0 = o0 - mean, d1 = o1 - mean;
            const float rstd = rsqrtf(wave_sum(d0 * d0 + d1 * d1) * (1.f / 128.f) + LN_EPS);
            const float g0 = bf2f(projb[row * NP + MO + h * 128 + lane]), g1 = bf2f(projb[row * NP + MO + h * 128 + lane + 64]);
            y[row * D + 512 + h * 128 + lane] = f2bf(sigm(g0) * d0 * rstd * nw[h * 128 + lane]);
            y[row * D + 512 + h * 128 + lane + 64] = f2bf(sigm(g1) * d1 * rstd * nw[h * 128 + lane + 64]); }
    }
}

__device__ __forceinline__ void ln_rows(const float* r, const float* gam, const float* bet, float* xo, bf16_t* xbo, int lane, int gw, int NGW) {
    const f32x4 *gp = (const f32x4*)gam + lane, *bp = (const f32x4*)bet + lane;
    for (int m = gw; m < T; m += NGW) {
        const f32x4* xr = (const f32x4*)(r + (size_t)m * D) + lane;
        f32x4 v[4]; float s = 0.f;
#pragma unroll
        for (int j = 0; j < 4; ++j) { v[j] = xr[64 * j]; s += (v[j][0] + v[j][1]) + (v[j][2] + v[j][3]); }
        const float mean = wave_sum(s) * (1.f / D); float s2 = 0.f;
#pragma unroll
        for (int j = 0; j < 4; ++j) { v[j] = v[j] - mean; s2 += (v[j][0] * v[j][0] + v[j][1] * v[j][1]) + (v[j][2] * v[j][2] + v[j][3] * v[j][3]); }
        const float rstd = rsqrtf(wave_sum(s2) * (1.f / D) + LN_EPS);
#pragma unroll
        for (int j = 0; j < 4; ++j) { const f32x4 o = v[j] * rstd * gp[64 * j] + bp[64 * j];
            if (xo) ((f32x4*)(xo + (size_t)m * D) + lane)[64 * j] = o;
            if (xbo) { uint2 w; w.x = pk2(o[0], o[1]); w.y = pk2(o[2], o[3]); ((uint2*)(xbo + (size_t)m * D) + lane)[64 * j] = w; } }
    }
}

__device__ __forceinline__ void attn_phase(const bf16_t* qb, const bf16_t* kb, const bf16_t* vT, bf16_t* ao, LAS unsigned char* lds, int wave, int lane, int blk, int G) {
    LAS bf16_t* P = (LAS bf16_t*)(lds + wave * 8448);
    const int r16 = lane & 15, quad = lane >> 4;
    for (int bi = blk; bi < (T / 128) * 4; bi += G) {
        const int h = bi & 3, r0 = (bi >> 2) * 128 + wave * 16, b = r0 / SEQ;
        bf16x8 qa[8];
        const bf16_t* qp = qb + (size_t)(r0 + r16) * D + h * 256 + quad * 8;
#pragma unroll
        for (int ks = 0; ks < 8; ++ks) qa[ks] = *(const bf16x8*)(qp + ks * 32);
        f32x4 s[16];
        const bf16_t* kp = kb + (size_t)(b * 256 + r16) * D + h * 256 + quad * 8;
#pragma unroll
        for (int nt = 0; nt < 16; ++nt) { f32x4 acc = {0.f, 0.f, 0.f, 0.f};
#pragma unroll
            for (int ks = 0; ks < 8; ++ks) { const bf16x8 bfr = *(const bf16x8*)(kp + (size_t)nt * 16 * D + ks * 32); acc = __builtin_amdgcn_mfma_f32_16x16x32_bf16(qa[ks], bfr, acc, 0, 0, 0); }
            s[nt] = acc; }
        float sm[4];
#pragma unroll
        for (int j = 0; j < 4; ++j) { float mx = s[0][j];
#pragma unroll
            for (int nt = 1; nt < 16; ++nt) mx = fmaxf(mx, s[nt][j]);
            mx = fmaxf(mx, __shfl_xor(mx, 1)); mx = fmaxf(mx, __shfl_xor(mx, 2)); mx = fmaxf(mx, __shfl_xor(mx, 4)); mx = fmaxf(mx, __shfl_xor(mx, 8));
            float sum = 0.f;
#pragma unroll
            for (int nt = 0; nt < 16; ++nt) { const float p = __expf((s[nt][j] - mx) * 0.0625f); sum += p; P[(quad * 4 + j) * 264 + nt * 16 + r16] = f2bf(p); }
            sum += __shfl_xor(sum, 1); sum += __shfl_xor(sum, 2); sum += __shfl_xor(sum, 4); sum += __shfl_xor(sum, 8);
            sm[j] = 1.f / sum; }
        WAVE_LDS_SYNC();
        bf16x8 pa[8];
#pragma unroll
        for (int ks = 0; ks < 8; ++ks) pa[ks] = *(const LAS bf16x8*)(P + r16 * 264 + ks * 32 + quad * 8);
        WAVE_LDS_SYNC();
        const bf16_t* vp = vT + (size_t)(h * 256 + r16) * NMEMR + b * 256 + quad * 8;
        bf16_t* op = ao + (size_t)(r0 + quad * 4) * D + h * 256 + r16;
#pragma unroll
        for (int nt = 0; nt < 16; ++nt) { f32x4 acc = {0.f, 0.f, 0.f, 0.f};
#pragma unroll
            for (int ks = 0; ks < 8; ++ks) { const bf16x8 bfr = *(const bf16x8*)(vp + (size_t)nt * 16 * NMEMR + ks * 32); acc = __builtin_amdgcn_mfma_f32_16x16x32_bf16(pa[ks], bfr, acc, 0, 0, 0); }
#pragma unroll
            for (int j = 0; j < 4; ++j) op[(size_t)j * D + nt * 16] = f2bf(acc[j] * sm[j]); }
    }
}

__device__ __forceinline__ void conv_phase(const bf16_t* ub, const float* cw, const float* cb, bf16_t* hb, int half, int gtid, int NT) {
    for (int item = gtid; item < TH * 352; item += NT) {
        const int tl = item / 352, c8 = item - tl * 352, n0 = c8 * 8, t = half * TH + tl, tpos = t & (SEQ - 1);
        float ga[8], va[8];
#pragma unroll
        for (int i = 0; i < 8; ++i) { ga[i] = cb[n0 + i]; va[i] = cb[DFF + n0 + i]; }
#pragma unroll
        for (int j = 0; j < 3; ++j) { if (tpos - 2 + j >= 0) { const bf16_t* p = ub + (size_t)(tl - 2 + j) * NUP + n0;
            const uint4 gq = *(const uint4*)p, vq = *(const uint4*)(p + DFF); const unsigned gw4[4] = {gq.x, gq.y, gq.z, gq.w}, vw4[4] = {vq.x, vq.y, vq.z, vq.w};
            const float* wg = cw + (size_t)j * NUP + n0; const float* wv = wg + DFF;
#pragma unroll
            for (int i = 0; i < 4; ++i) { ga[2 * i] += bflo(gw4[i]) * wg[2 * i]; ga[2 * i + 1] += bfhi(gw4[i]) * wg[2 * i + 1]; va[2 * i] += bflo(vw4[i]) * wv[2 * i]; va[2 * i + 1] += bfhi(vw4[i]) * wv[2 * i + 1]; } } }
        uint4 o; o.x = pk2(gelu_tanh(ga[0]) * va[0], gelu_tanh(ga[1]) * va[1]); o.y = pk2(gelu_tanh(ga[2]) * va[2], gelu_tanh(ga[3]) * va[3]);
        o.z = pk2(gelu_tanh(ga[4]) * va[4], gelu_tanh(ga[5]) * va[5]); o.w = pk2(gelu_tanh(ga[6]) * va[6], gelu_tanh(ga[7]) * va[7]);
        *(uint4*)(hb + (size_t)t * DFF + n0) = o;
    }
}

template <class Epi> __device__ __forceinline__ void run_gemm(LAS unsigned char* lds, const bf16_t* A, const bf16_t* Bt, int M, int N, int K, const Epi& E) {
    pg8::Gemm g{A, Bt, M, N, K}; pg8::StaticOrder S; S.init(M, N, (int)gridDim.x, (int)blockIdx.x);
    pg8::gemm_phase<Epi, pg8::StaticOrder, false>(lds, g, S, E, nullptr);
}
__global__ void __launch_bounds__(512, 2) fwd_megakernel(Args a) {
    extern __shared__ __attribute__((aligned(16))) unsigned char shm[];
    LAS unsigned char* lds = (LAS unsigned char*)shm;
    const int tid = threadIdx.x, lane = tid & 63, wave = __builtin_amdgcn_readfirstlane(tid >> 6);
    const int G = gridDim.x, blk = blockIdx.x, gw = blk * 8 + wave, NGW = G * 8;
    unsigned char* ws = a.ws;
    const int lo = a.ph_lo, hi = a.ph_hi;
#if N_LAUNCH_MODE == 0
    cg::grid_group grid = cg::this_grid();
#define SEAM(k) do { if (lo <= (k) && (k) + 1 < hi) grid.sync(); } while (0)
#else
#define SEAM(k) do { } while (0)
#endif
#define IN(k) (lo <= (k) && (k) < hi)
    bf16_t* xb = (bf16_t*)(ws + WS_XB); bf16_t* projb = (bf16_t*)(ws + WS_PROJ);
    float* x1 = (float*)(ws + WS_X1); bf16_t* x1b = (bf16_t*)(ws + WS_X1B); bf16_t* qb = (bf16_t*)(ws + WS_QB);
    bf16_t* kb = (bf16_t*)(ws + WS_KB); bf16_t* vT = (bf16_t*)(ws + WS_VT); bf16_t* memb = (bf16_t*)(ws + WS_MEMB);
    bf16_t* ub = (bf16_t*)(ws + WS_UB); bf16_t* hb = (bf16_t*)(ws + WS_HB);

    if (IN(0)) { p0_prep(a, lds, tid, wave, lane, gw, NGW); __syncthreads(); SEAM(0); }
    if (IN(1)) {
        run_gemm(lds, xb, (const bf16_t*)(ws + WS_WIN), T, NP, D, pg8::EpiB16{projb, NP, a.in[3]});
        run_gemm(lds, memb, (const bf16_t*)(ws + WS_WKV), NMEMR, D, D, pg8::EpiB16{kb, D, nullptr});
        run_gemm(lds, (const bf16_t*)(ws + WS_WKV) + (size_t)D * D, memb, D, NMEMR, D, pg8::EpiB16{vT, NMEMR, nullptr});
        __syncthreads(); SEAM(1); }
    if (IN(2)) {
        for (int it = blk; it < 64; it += G) { const int kind = it >> 5, b = (it >> 2) & 7, h = it & 3;
            if (kind == 0) hgrn2_rec(a, b, h, (LAS float*)lds, tid, wave, lane); else mlstm_rec(a, b, h, (LAS float*)lds, tid, wave, lane);
            __syncthreads(); }
        SEAM(2); }
    if (IN(3)) { run_gemm(lds, xb  , (const bf16_t*)(ws + WS_WOUT), T, D, D, pg8::EpiRes{a.in[0], x1, D, ALPHA}); __syncthreads(); SEAM(3); }
    if (IN(4)) { ln_rows(x1, a.in[10], a.in[11], x1, x1b, lane, gw, NGW); SEAM(4); }
    if (IN(5)) { run_gemm(lds, x1b, (const bf16_t*)(ws + WS_WQ), T, D, D, pg8::EpiB16{qb, D, nullptr}); __syncthreads(); SEAM(5); }
    if (IN(6)) { attn_phase(qb, kb, vT, xb  , lds, wave, lane, blk, G); __syncthreads(); SEAM(6); }
    if (IN(7)) { run_gemm(lds, xb  , (const bf16_t*)(ws + WS_WO), T, D, D, pg8::EpiRes{x1, a.out, D, ALPHA}); __syncthreads(); SEAM(7); }
    if (IN(8)) { ln_rows(a.out, a.in[15], a.in[16], a.out, x1b  , lane, gw, NGW); SEAM(8); }
    if (IN(9)) { run_gemm(lds, x1b, (const bf16_t*)(ws + WS_WUP), TH, NUP, D, pg8::EpiB16{ub, NUP, nullptr}); __syncthreads(); SEAM(9); }
    if (IN(10)) { conv_phase(ub, a.in[18], a.in[19], hb, 0, blk * 512 + tid, G * 512); SEAM(10); }
    if (IN(11)) { run_gemm(lds, x1b + (size_t)TH * D, (const bf16_t*)(ws + WS_WUP), TH, NUP, D, pg8::EpiB16{ub, NUP, nullptr}); __syncthreads(); SEAM(11); }
    if (IN(12)) { conv_phase(ub, a.in[18], a.in[19], hb, 1, blk * 512 + tid, G * 512); SEAM(12); }
    if (IN(13)) { run_gemm(lds, hb, (const bf16_t*)(ws + WS_WDN), T, D, DFF, pg8::EpiRes{a.out, a.out, D, ALPHA}); __syncthreads(); SEAM(13); }
    if (IN(14)) { ln_rows(a.out, a.in[21], a.in[22], a.out, nullptr, lane, gw, NGW); }
}

extern "C" void kernel_launch(void* const* d_in, const int* in_sizes, int n_in, void* d_out, int out_size, void* d_ws, size_t ws_size, hipStream_t stream) {
    static int grid = 0;
    if (grid == 0) {
        int dev = 0, cus = 0, per_cu = 0;
        hipGetDevice(&dev); hipDeviceGetAttribute(&cus, hipDeviceAttributeMultiprocessorCount, dev);
        if (hipFuncSetAttribute((const void*)fwd_megakernel, hipFuncAttributeMaxDynamicSharedMemorySize, LDS_BYTES) != hipSuccess) { fprintf(stderr, "hipFuncSetAttribute failed\n"); }
        if (hipOccupancyMaxActiveBlocksPerMultiprocessor(&per_cu, (const void*)fwd_megakernel, 512, LDS_BYTES) != hipSuccess || per_cu < 1) { fprintf(stderr, "occupancy query: %d\n", per_cu); per_cu = 1; }
        (void)hipGetLastError();
        grid = cus * per_cu;
        if (ws_size < 482 * MiB) fprintf(stderr, "workspace too small: %zu\n", ws_size);
    }
    Args a{};
    for (int i = 0; i < 23; ++i) a.in[i] = (const float*)d_in[i];
    a.out = (float*)d_out; a.ws = (unsigned char*)d_ws;
#if N_LAUNCH_MODE == 0
    a.ph_lo = 0; a.ph_hi = NPH; void* args[] = {&a};
    hipError_t e = hipLaunchCooperativeKernel((const void*)fwd_megakernel, dim3(grid), dim3(512), args, LDS_BYTES, stream);
    if (e != hipSuccess) fprintf(stderr, "cooperative launch failed: %s (grid %d)\n", hipGetErrorString(e), grid);
#else
    for (int ph = 0; ph < NPH; ++ph) { a.ph_lo = ph; a.ph_hi = ph + 1; hipLaunchKernelGGL(fwd_megakernel, dim3(grid), dim3(512), LDS_BYTES, stream, a); }
#endif
}
```

```cpp
#include <hip/hip_runtime.h>
#include <hip/hip_cooperative_groups.h>
#include <cstdio>
#include <cstdint>
namespace cg = cooperative_groups;
namespace pg8 {
#define PG8_LAS __attribute__((address_space(3)))
typedef unsigned short bf16_t;
typedef short bf16x8 __attribute__((ext_vector_type(8)));
typedef float f32x4 __attribute__((ext_vector_type(4)));
typedef unsigned u32x4 __attribute__((ext_vector_type(4)));
constexpr int BM = 256, BK = 64, HALF = 128, HTB = HALF * BK * 2  , STAGE_BYTES = 8 * HTB, NXCD = 8, WGM = 8;

__host__ __device__ __forceinline__ int lds_byte(int r, int c) { const int st = (r >> 4) * 2 + (c >> 5), rr = r & 15, cc = c & 31, ob = rr * 64 + cc * 2; return st * 1024 + (ob ^ (((ob >> 9) & 1) << 5)); }
__host__ __device__ __forceinline__ void stage_rc(int b, int& R, int& C) { const int st = b / 1024, sb = b % 1024, swz = sb ^ (((sb >> 9) & 1) << 5); R = (st >> 1) * 16 + swz / 64; C = (st & 1) * 32 + (swz % 64) / 2; }
__host__ __device__ __forceinline__ int perm32(int rho) { const int n = rho >> 4, i = rho & 15; return 8 * (i >> 2) + 4 * n + (i & 3); }

struct Unit { int pm, pn; };
struct Gemm { const bf16_t* A; const bf16_t* Bt; int M, N, K; };

struct StaticOrder {
    int nM, nN, nwg, G, c;
    __host__ __device__ void init(int M, int N, int G_, int c_) { nM = M / BM; nN = N / BM; nwg = nM * nN; G = G_; c = c_; }
    __host__ __device__ bool next(int i, Unit& u) const {
        const long L = (long)i * G + c; if (L >= nwg) return false;
        int wgid = (int)L; { const int q = nwg / NXCD, r = nwg % NXCD, xcd = wgid % NXCD, off = wgid / NXCD; wgid = (xcd < r ? xcd * (q + 1) : r * (q + 1) + (xcd - r) * q) + off; }
        const int nig = WGM * nN, gid = wgid / nig, fm = gid * WGM, gsz = (nM - fm) < WGM ? (nM - fm) : WGM;
        u.pm = fm + ((wgid % nig) % gsz); u.pn = (wgid % nig) / gsz; return true;
    }
    __device__ __forceinline__ void a_ready(const Unit&) const {}
    __device__ __forceinline__ void done(const Unit&) const {}
};
typedef __bf16 bf16x2_nat __attribute__((ext_vector_type(2))); typedef float f32x2_nat __attribute__((ext_vector_type(2)));
__device__ __forceinline__ unsigned cvt_pk_bf16(float lo, float hi) { f32x2_nat v = {lo, hi}; bf16x2_nat r = __builtin_convertvector(v, bf16x2_nat); return __builtin_bit_cast(unsigned, r); }
typedef float f32x2 __attribute__((ext_vector_type(2)));
struct EpiB16 {
    static constexpr bool PERM = true, AFTER_DRAIN = false;
    bf16_t* O; int ldc; const float* bias; unsigned silu_mask, sig_mask;
    __device__ __forceinline__ void operator()(const f32x4 (&acc)[2][2][4][2], const Unit& u, int wr, int wc, int fr, int fq) const {
        const int row0 = u.pm * BM + wr * 64 + fr; const int col0 = u.pn * BM + wc * 32 + 8 * fq;
        const int act = ((silu_mask >> u.pn) & 1u) ? 1 : (((sig_mask >> u.pn) & 1u) ? 2 : 0);
        f32x4 bv[2][2];
#pragma unroll
        for (int bj = 0; bj < 2; ++bj)
#pragma unroll
            for (int n = 0; n < 2; ++n) bv[bj][n] = bias ? *(const f32x4*)(bias + col0 + bj * HALF + 4 * n) : (f32x4){0.f, 0.f, 0.f, 0.f};
#pragma unroll
        for (int ai = 0; ai < 2; ++ai)
#pragma unroll
            for (int m = 0; m < 4; ++m) { bf16_t* rowp = O + (size_t)(row0 + ai * HALF + m * 16) * ldc + col0;
#pragma unroll
                for (int bj = 0; bj < 2; ++bj) { f32x4 v0 = acc[ai][bj][m][0] + bv[bj][0], v1 = acc[ai][bj][m][1] + bv[bj][1];
                    if (act) {
#pragma unroll
                        for (int j = 0; j < 4; ++j) { const float s0 = __builtin_amdgcn_rcpf(1.f + __expf(-v0[j])), s1 = __builtin_amdgcn_rcpf(1.f + __expf(-v1[j]));
                            v0[j] = (act == 1) ? v0[j] * s0 : s0; v1[j] = (act == 1) ? v1[j] * s1 : s1; } }
                    u32x4 w; w.x = cvt_pk_bf16(v0[0], v0[1]); w.y = cvt_pk_bf16(v0[2], v0[3]); w.z = cvt_pk_bf16(v1[0], v1[1]); w.w = cvt_pk_bf16(v1[2], v1[3]);
                    *(u32x4*)(rowp + bj * HALF) = w; } }
    }
};
template <bool BASE16> struct EpiResO16 {
    static constexpr bool PERM = false, AFTER_DRAIN = false;
    const void* base; bf16_t* out; int ldc; float alpha; float* stats;
    __device__ __forceinline__ void operator()(const f32x4 (&acc)[2][2][4][2], const Unit& u, int wr, int wc, int fr, int fq) const {
        typedef unsigned u32x2e __attribute__((ext_vector_type(2)));
        const int row0 = u.pm * BM + wr * 64 + fr, col0 = u.pn * BM + wc * 32 + 4 * fq;
#pragma unroll
        for (int ai = 0; ai < 2; ++ai)
#pragma unroll
            for (int m = 0; m < 4; ++m) { const size_t off = (size_t)(row0 + ai * HALF + m * 16) * ldc + col0; float rs = 0.f, rq = 0.f;
#pragma unroll
                for (int bj = 0; bj < 2; ++bj)
#pragma unroll
                    for (int n = 0; n < 2; ++n) { f32x4 bs;
                        if (BASE16) { const u32x2e bw = *(const u32x2e*)((const bf16_t*)base + off + bj * HALF + n * 16);
                            bs = (f32x4){__uint_as_float(bw.x << 16), __uint_as_float(bw.x & 0xffff0000u), __uint_as_float(bw.y << 16), __uint_as_float(bw.y & 0xffff0000u)}; }
                        else bs = *(const f32x4*)((const float*)base + off + bj * HALF + n * 16);
                        const f32x4 v = bs * alpha + acc[ai][bj][m][n]; u32x2e w; w.x = cvt_pk_bf16(v[0], v[1]); w.y = cvt_pk_bf16(v[2], v[3]);
                        rs += (v[0] + v[1]) + (v[2] + v[3]); rq += (v[0] * v[0] + v[1] * v[1]) + (v[2] * v[2] + v[3] * v[3]);
                        *(u32x2e*)(out + off + bj * HALF + n * 16) = w; }
                if (stats) { rs += __shfl_xor(rs, 16); rs += __shfl_xor(rs, 32); rq += __shfl_xor(rq, 16); rq += __shfl_xor(rq, 32);
                    if (fq == 0) { float* sp = stats + 2 * (size_t)(row0 + ai * HALF + m * 16); atomicAdd(sp, rs); atomicAdd(sp + 1, rq); } } }
    }
};
struct EpiLNq {
    static constexpr bool PERM = true, AFTER_DRAIN = false;
    bf16_t* O; int ldc; const float* st; const float* c1; const float* c2;
    __device__ __forceinline__ void operator()(const f32x4 (&acc)[2][2][4][2], const Unit& u, int wr, int wc, int fr, int fq) const {
        const int row0 = u.pm * BM + wr * 64 + fr, col0 = u.pn * BM + wc * 32 + 8 * fq;
        f32x4 k1[2][2], k2[2][2];
#pragma unroll
        for (int bj = 0; bj < 2; ++bj)
#pragma unroll
            for (int n = 0; n < 2; ++n) { k1[bj][n] = *(const f32x4*)(c1 + col0 + bj * HALF + 4 * n); k2[bj][n] = *(const f32x4*)(c2 + col0 + bj * HALF + 4 * n); }
#pragma unroll
        for (int ai = 0; ai < 2; ++ai)
#pragma unroll
            for (int m = 0; m < 4; ++m) { const int row = row0 + ai * HALF + m * 16; const f32x2_nat sv = *(const f32x2_nat*)(st + 2 * (size_t)row);
                const float mu = sv[0] * (1.f / 1024.f), rstd = __builtin_amdgcn_rsqf(fmaxf(sv[1] * (1.f / 1024.f) - mu * mu, 0.f) + 1e-5f);
                bf16_t* rowp = O + (size_t)row * ldc + col0;
#pragma unroll
                for (int bj = 0; bj < 2; ++bj) { const f32x4 v0 = (acc[ai][bj][m][0] - k1[bj][0] * mu) * rstd + k2[bj][0], v1 = (acc[ai][bj][m][1] - k1[bj][1] * mu) * rstd + k2[bj][1];
                    u32x4 w; w.x = cvt_pk_bf16(v0[0], v0[1]); w.y = cvt_pk_bf16(v0[2], v0[3]); w.z = cvt_pk_bf16(v1[0], v1[1]); w.w = cvt_pk_bf16(v1[2], v1[3]);
                    *(u32x4*)(rowp + bj * HALF) = w; } }
    }
};
struct EpiResLN {
    static constexpr bool PERM = false, AFTER_DRAIN = false;
    const bf16_t* rsrc; const float* st; const float* gam; const float* bet; bf16_t* out; int ldc; float alpha; float* stats;
    __device__ __forceinline__ void operator()(const f32x4 (&acc)[2][2][4][2], const Unit& u, int wr, int wc, int fr, int fq) const {
        typedef unsigned u32x2e __attribute__((ext_vector_type(2)));
        const int row0 = u.pm * BM + wr * 64 + fr, col0 = u.pn * BM + wc * 32 + 4 * fq;
        f32x4 gv[2][2], bv[2][2];
#pragma unroll
        for (int bj = 0; bj < 2; ++bj)
#pragma unroll
            for (int n = 0; n < 2; ++n) { gv[bj][n] = *(const f32x4*)(gam + col0 + bj * HALF + n * 16); bv[bj][n] = *(const f32x4*)(bet + col0 + bj * HALF + n * 16); }
#pragma unroll
        for (int ai = 0; ai < 2; ++ai)
#pragma unroll
            for (int m = 0; m < 4; ++m) { const int row = row0 + ai * HALF + m * 16; const size_t off = (size_t)row * ldc + col0; const f32x2_nat sv = *(const f32x2_nat*)(st + 2 * (size_t)row);
                const float mu = sv[0] * (1.f / 1024.f), rstd = __builtin_amdgcn_rsqf(fmaxf(sv[1] * (1.f / 1024.f) - mu * mu, 0.f) + 1e-5f); float rs = 0.f, rq = 0.f;
#pragma unroll
                for (int bj = 0; bj < 2; ++bj)
#pragma unroll
                    for (int n = 0; n < 2; ++n) { const u32x2e bw = *(const u32x2e*)(rsrc + off + bj * HALF + n * 16);
                        const f32x4 rr = {__uint_as_float(bw.x << 16), __uint_as_float(bw.x & 0xffff0000u), __uint_as_float(bw.y << 16), __uint_as_float(bw.y & 0xffff0000u)};
                        const f32x4 xb_ = (rr - mu) * rstd * gv[bj][n] + bv[bj][n]; const f32x4 v = xb_ * alpha + acc[ai][bj][m][n];
                        u32x2e w; w.x = cvt_pk_bf16(v[0], v[1]); w.y = cvt_pk_bf16(v[2], v[3]);
                        rs += (v[0] + v[1]) + (v[2] + v[3]); rq += (v[0] * v[0] + v[1] * v[1]) + (v[2] * v[2] + v[3] * v[3]);
                        *(u32x2e*)(out + off + bj * HALF + n * 16) = w; }
                if (stats) { rs += __shfl_xor(rs, 16); rs += __shfl_xor(rs, 32); rq += __shfl_xor(rq, 16); rq += __shfl_xor(rq, 32);
                    if (fq == 0) { float* sp = stats + 2 * (size_t)row; atomicAdd(sp, rs); atomicAdd(sp + 1, rq); } } }
    }
};
struct EpiResB {
    static constexpr bool PERM = false, AFTER_DRAIN = false;
    const bf16_t* base; float* out; int ldc; float alpha;
    __device__ __forceinline__ void operator()(const f32x4 (&acc)[2][2][4][2], const Unit& u, int wr, int wc, int fr, int fq) const {
        const int row0 = u.pm * BM + wr * 64 + fr, col0 = u.pn * BM + wc * 32 + 4 * fq;
#pragma unroll
        for (int ai = 0; ai < 2; ++ai)
#pragma unroll
            for (int m = 0; m < 4; ++m) { const size_t off = (size_t)(row0 + ai * HALF + m * 16) * ldc + col0;
#pragma unroll
                for (int bj = 0; bj < 2; ++bj)
#pragma unroll
                    for (int n = 0; n < 2; ++n) { typedef unsigned u32x2e __attribute__((ext_vector_type(2))); const u32x2e bw = *(const u32x2e*)(base + off + bj * HALF + n * 16);
                        const f32x4 bs = {__uint_as_float(bw.x << 16), __uint_as_float(bw.x & 0xffff0000u), __uint_as_float(bw.y << 16), __uint_as_float(bw.y & 0xffff0000u)};
                        *(f32x4*)(out + off + bj * HALF + n * 16) = bs * alpha + acc[ai][bj][m][n]; } }
    }
};
struct EpiRes {
    static constexpr bool PERM = false, AFTER_DRAIN = false;
    const float* base; float* out; int ldc; float alpha;
    __device__ __forceinline__ void operator()(const f32x4 (&acc)[2][2][4][2], const Unit& u, int wr, int wc, int fr, int fq) const {
        const int row0 = u.pm * BM + wr * 64 + fr, col0 = u.pn * BM + wc * 32 + 4 * fq;
#pragma unroll
        for (int ai = 0; ai < 2; ++ai)
#pragma unroll
            for (int m = 0; m < 4; ++m) { const size_t off = (size_t)(row0 + ai * HALF + m * 16) * ldc + col0;
#pragma unroll
                for (int bj = 0; bj < 2; ++bj)
#pragma unroll
                    for (int n = 0; n < 2; ++n) { const f32x4 bs = *(const f32x4*)(base + off + bj * HALF + n * 16);
                        *(f32x4*)(out + off + bj * HALF + n * 16) = bs * alpha + acc[ai][bj][m][n]; } }
    }
};
template <class Epi, class Sched, bool STAMP = false>
__device__ __forceinline__ void gemm_phase(PG8_LAS unsigned char* lds, const Gemm g, const Sched& S, const Epi& E, unsigned long long* stamps) {
    const int tid = threadIdx.x, wid = __builtin_amdgcn_readfirstlane(tid >> 6), lane = tid & 63, wr = wid >> 2, wc = wid & 3, fr = lane & 15, fq = lane >> 4;
    const int K = g.K, nt = K / BK;
    int ts_lo = 0, ts_hi = 0, nts = 0; const unsigned long long rt_entry = STAMP ? (unsigned long long)wall_clock64() : 0ull;
#define PG8_STAMP() do { if (STAMP && wid == 0 && nts < 64) { const unsigned long long _c = (unsigned long long)clock64(); \
        ts_lo = (lane == nts) ? (int)(unsigned)_c : ts_lo; ts_hi = (lane == nts) ? (int)(unsigned)(_c >> 32) : ts_hi; ++nts; } } while (0)
    PG8_STAMP();
    unsigned voffA[2], voffB[2];
#pragma unroll
    for (int i = 0; i < 2; ++i) { int R, C; stage_rc(tid * 16 + i * 8192, R, C); const int Rb = Epi::PERM ? ((R & ~31) + perm32(R & 31)) : R;
        voffA[i] = (unsigned)(R * K + C) * 2u; voffB[i] = (unsigned)(Rb * K + C) * 2u; }
    const size_t kstep = (size_t)(BK * 2);
    const size_t hstep = (size_t)HALF * K * 2;
    const size_t tstep = 2 * hstep;
    const unsigned ldsw = (unsigned)wid * 1024u;
    const int aoff = lds_byte(wr * 64 + fr, fq * 8), boff = lds_byte(wc * 32 + fr, fq * 8);
#define PG8_SA(b, h) (((b) * 2 + (h)) * HTB)
#define PG8_SB(b, h) ((4 + (b) * 2 + (h)) * HTB)
#define PG8_STAGE(bufoff, gbase, voff) do { _Pragma("unroll") for (int _i = 0; _i < 2; ++_i) \
        __builtin_amdgcn_global_load_lds((const unsigned*)((const char*)(gbase) + (voff)[_i]), (PG8_LAS unsigned*)(lds + (bufoff) + ldsw + _i * 8192), 16, 0, 0); } while (0)
#define PG8_LDA(dst, b, h) do { _Pragma("unroll") for (int m = 0; m < 4; ++m) _Pragma("unroll") for (int k = 0; k < 2; ++k) dst[m][k] = *(const PG8_LAS bf16x8*)(lds + PG8_SA(b, h) + aoff + m * 2048 + k * 1024); } while (0)
#define PG8_LDB(dst, b, h) do { _Pragma("unroll") for (int n = 0; n < 2; ++n) _Pragma("unroll") for (int k = 0; k < 2; ++k) dst[n][k] = *(const PG8_LAS bf16x8*)(lds + PG8_SB(b, h) + boff + n * 2048 + k * 1024); } while (0)
#define PG8_MMA(ai, bj, At, Bt) do { __builtin_amdgcn_s_setprio(1); _Pragma("unroll") for (int m = 0; m < 4; ++m) _Pragma("unroll") for (int n = 0; n < 2; ++n) _Pragma("unroll") for (int k = 0; k < 2; ++k) \
        acc[ai][bj][m][n] = __builtin_amdgcn_mfma_f32_16x16x32_bf16(Bt[n][k], At[m][k], acc[ai][bj][m][n], 0, 0, 0); __builtin_amdgcn_s_setprio(0); } while (0)
#define PG8_WAIT_V(n) asm volatile("s_waitcnt vmcnt(" #n ")" ::: "memory")
#define PG8_WAIT_L(n) asm volatile("s_waitcnt lgkmcnt(" #n ")" ::: "memory")
#define PG8_BAR __builtin_amdgcn_s_barrier()
#define PG8_SCHED __builtin_amdgcn_sched_barrier(0)
    Unit cur, nxt; int ui = 0;
    if (!S.next(0, cur)) return;
    f32x4 acc[2][2][4][2];
#pragma unroll
    for (int a = 0; a < 2; ++a)
#pragma unroll
        for (int b = 0; b < 2; ++b)
#pragma unroll
            for (int m = 0; m < 4; ++m)
#pragma unroll
                for (int n = 0; n < 2; ++n) acc[a][b][m][n] = (f32x4){0.f, 0.f, 0.f, 0.f};
    bf16x8 At[4][2], B0[2][2], B1[2][2];
    const char* cA = (const char*)g.A + (size_t)cur.pm * tstep; const char* cB = (const char*)g.Bt + (size_t)cur.pn * tstep;
    S.a_ready(cur);
    PG8_STAGE(PG8_SB(0, 0), cB, voffB); PG8_STAGE(PG8_SA(0, 0), cA, voffA); PG8_STAGE(PG8_SB(0, 1), cB + hstep, voffB); PG8_STAGE(PG8_SA(0, 1), cA + hstep, voffA);
    if (wr == 1) PG8_BAR;
    PG8_WAIT_V(4); PG8_BAR;
    PG8_STAGE(PG8_SB(1, 0), cB + kstep, voffB); PG8_STAGE(PG8_SA(1, 0), cA + kstep, voffA); PG8_STAGE(PG8_SB(1, 1), cB + hstep + kstep, voffB);
    PG8_WAIT_V(6); PG8_BAR;
    PG8_STAMP();
    for (;;) {
        const bool has_next = S.next(ui + 1, nxt);
        const char* nA = has_next ? (const char*)g.A + (size_t)nxt.pm * tstep : cA; const char* nB = has_next ? (const char*)g.Bt + (size_t)nxt.pn * tstep : cB;
        for (int t = 0; t < nt; t += 2) {
            const bool last = (t == nt - 2);
            const char* a1 = cA + (size_t)(t + 1) * kstep;
            const char* a2 = last ? nA : cA + (size_t)(t + 2) * kstep; const char* b2 = last ? nB : cB + (size_t)(t + 2) * kstep;
            const char* a3 = a2 + kstep; const char* b3 = b2 + kstep;
            if (last && has_next) S.a_ready(nxt);
            PG8_LDB(B0, 0, 0); PG8_SCHED; PG8_LDA(At, 0, 0); PG8_STAGE(PG8_SA(1, 1), a1 + hstep, voffA);
            PG8_WAIT_L(8); PG8_BAR; PG8_WAIT_L(0); PG8_MMA(0, 0, At, B0); PG8_BAR; PG8_SCHED;
            PG8_LDB(B1, 0, 1); PG8_STAGE(PG8_SB(0, 0), b2, voffB);
            PG8_BAR; PG8_WAIT_L(0); PG8_MMA(0, 1, At, B1); PG8_BAR;
            PG8_LDA(At, 0, 1); PG8_STAGE(PG8_SA(0, 0), a2, voffA);
            PG8_BAR; PG8_WAIT_L(0); PG8_MMA(1, 0, At, B0); PG8_BAR; PG8_SCHED;
            PG8_STAGE(PG8_SB(0, 1), b2 + hstep, voffB);
            PG8_WAIT_V(6); PG8_BAR; PG8_MMA(1, 1, At, B1); PG8_BAR;
            PG8_LDB(B0, 1, 0); PG8_SCHED; PG8_LDA(At, 1, 0); PG8_STAGE(PG8_SA(0, 1), a2 + hstep, voffA);
            PG8_WAIT_L(8); PG8_BAR; PG8_WAIT_L(0); PG8_MMA(0, 0, At, B0); PG8_BAR; PG8_SCHED;
            PG8_LDB(B1, 1, 1); PG8_STAGE(PG8_SB(1, 0), b3, voffB);
            PG8_BAR; PG8_WAIT_L(0); PG8_MMA(0, 1, At, B1); PG8_BAR;
            PG8_LDA(At, 1, 1); PG8_STAGE(PG8_SA(1, 0), a3, voffA);
            PG8_BAR; PG8_WAIT_L(0); PG8_MMA(1, 0, At, B0); PG8_BAR; PG8_SCHED;
            PG8_STAGE(PG8_SB(1, 1), b3 + hstep, voffB);
            PG8_WAIT_V(6); PG8_BAR; PG8_MMA(1, 1, At, B1); PG8_BAR;
        }
        PG8_STAMP();
        if constexpr (!Epi::AFTER_DRAIN) { E(acc, cur, wr, wc, fr, fq); S.done(cur); }
        PG8_STAMP();
        if (!has_next) break;
#pragma unroll
        for (int a = 0; a < 2; ++a)
#pragma unroll
            for (int b = 0; b < 2; ++b)
#pragma unroll
                for (int m = 0; m < 4; ++m)
#pragma unroll
                    for (int n = 0; n < 2; ++n) acc[a][b][m][n] = (f32x4){0.f, 0.f, 0.f, 0.f};
        cur = nxt; cA = nA; cB = nB; ++ui;
    }
    PG8_WAIT_V(0);
    if (wr == 0) PG8_BAR;
    PG8_BAR;
    if constexpr (Epi::AFTER_DRAIN) { E.fused(acc, cur, wr, wc, fr, fq, lds, wid, lane); S.done(cur); }
    PG8_STAMP();
    if (STAMP && wid == 0) { stamps[lane] = lane < nts ? (((unsigned long long)(unsigned)ts_hi << 32) | (unsigned)ts_lo) : 0ull;
        if (lane == 62) stamps[62] = rt_entry; if (lane == 63) stamps[63] = (unsigned long long)wall_clock64(); }
#undef PG8_STAMP
#undef PG8_SA
#undef PG8_SB
#undef PG8_STAGE
#undef PG8_LDA
#undef PG8_LDB
#undef PG8_MMA
#undef PG8_WAIT_V
#undef PG8_WAIT_L
#undef PG8_BAR
#undef PG8_SCHED
}

struct EpiFFN {
    static constexpr bool PERM = true, AFTER_DRAIN = false;
    bf16_t* H; const float* cw; const float* cb;
    __device__ __forceinline__ void operator()(const f32x4 (&acc)[2][2][4][2], const Unit& u, int wr, int wc, int fr, int fq) const {
        const int batch = u.pm / 17, jj = u.pm % 17, col0 = u.pn * 128 + wc * 32 + 8 * fq;
        const int lane = (int)(threadIdx.x & 63u), src1 = (lane & 48) | ((lane - 1) & 15), src2 = (lane & 48) | ((lane - 2) & 15);
#pragma unroll
        for (int n = 0; n < 2; ++n) { const int col = col0 + 4 * n;
            f32x4 wg[3], wv[3];
#pragma unroll
            for (int tp = 0; tp < 3; ++tp) { wg[tp] = *(const f32x4*)(cw + tp * 5632 + col); wv[tp] = *(const f32x4*)(cw + tp * 5632 + 2816 + col); }
            const f32x4 bg = *(const f32x4*)(cb + col), bvv = *(const f32x4*)(cb + 2816 + col);
#pragma unroll
            for (int ai = 0; ai < 2; ++ai) { const int gbase = 248 * jj + 62 * (2 * ai + wr);
                f32x4 q1g = {0.f, 0.f, 0.f, 0.f}, q2g = q1g, q1v = q1g, q2v = q1g;
#pragma unroll
                for (int m = 0; m < 4; ++m) { const f32x4 g0 = acc[ai][0][m][n], v0 = acc[ai][1][m][n]; f32x4 r1g, r2g, r1v, r2v;
#pragma unroll
                    for (int j = 0; j < 4; ++j) { r1g[j] = __shfl(g0[j], src1); r2g[j] = __shfl(g0[j], src2); r1v[j] = __shfl(v0[j], src1); r2v[j] = __shfl(v0[j], src2); }
                    const int lr = 16 * m + fr, tok = gbase + lr - 2;
                    f32x4 p1g = (fr >= 1) ? r1g : q1g, p2g = (fr >= 2) ? r2g : q2g, p1v = (fr >= 1) ? r1v : q1v, p2v = (fr >= 2) ? r2v : q2v;
                    const f32x4 z = {0.f, 0.f, 0.f, 0.f};
                    if (tok < 1) { p1g = z; p1v = z; }
                    if (tok < 2) { p2g = z; p2v = z; }
                    const f32x4 gate = bg + wg[0] * p2g + wg[1] * p1g + wg[2] * g0, val = bvv + wv[0] * p2v + wv[1] * p1v + wv[2] * v0;
                    if (lr >= 2 && tok < 4096) { float o4[4];
#pragma unroll
                        for (int j = 0; j < 4; ++j) { const float x = gate[j]; const float uu = 0.7978845608028654f * (x + 0.044715f * x * x * x);
                            const float th = 1.f - 2.f * __builtin_amdgcn_rcpf(1.f + __expf(2.f * uu)); o4[j] = 0.5f * x * (1.f + th) * val[j]; }
                        typedef unsigned u32x2e __attribute__((ext_vector_type(2))); u32x2e w; w.x = cvt_pk_bf16(o4[0], o4[1]); w.y = cvt_pk_bf16(o4[2], o4[3]);
                        *(u32x2e*)(H + ((size_t)batch * 4096 + tok) * 2816 + col) = w; }
                    q1g = r1g; q2g = r2g; q1v = r1v; q2v = r2v; } } }
    }
};
template <class Epi, class Sched, bool STAMP = false>
__device__ __forceinline__ void gemm_phase_ffn(PG8_LAS unsigned char* lds, const Gemm g, const Sched& S, const Epi& E, unsigned long long* stamps) {
    const int tid = threadIdx.x, wid = __builtin_amdgcn_readfirstlane(tid >> 6), lane = tid & 63, wr = wid >> 2, wc = wid & 3, fr = lane & 15, fq = lane >> 4;
    const int K = g.K, nt = K / BK;
    int ts_lo = 0, ts_hi = 0, nts = 0; const unsigned long long rt_entry = STAMP ? (unsigned long long)wall_clock64() : 0ull;
#define PG8_STAMP() do { if (STAMP && wid == 0 && nts < 64) { const unsigned long long _c = (unsigned long long)clock64(); \
        ts_lo = (lane == nts) ? (int)(unsigned)_c : ts_lo; ts_hi = (lane == nts) ? (int)(unsigned)(_c >> 32) : ts_hi; ++nts; } } while (0)
    PG8_STAMP();
    unsigned voffA[2], voffB[2];
#pragma unroll
    for (int i = 0; i < 2; ++i) { int R, C; stage_rc(tid * 16 + i * 8192, R, C); const int Rb = Epi::PERM ? ((R & ~31) + perm32(R & 31)) : R;
        voffA[i] = (unsigned)((62 * (R >> 6) + (R & 63)) * K + C) * 2u; voffB[i] = (unsigned)(Rb * K + C) * 2u; }
    const size_t kstep = (size_t)(BK * 2);
    const size_t hstepA = (size_t)124 * K * 2, hstepB = (size_t)2816 * K * 2;
#define PG8_ABASE(pm_) ((const char*)g.A + ((long)((pm_) / 17) * 4096 + 248L * ((pm_) % 17) - 2L) * (long)K * 2L)
#define PG8_BBASE(pn_) ((const char*)g.Bt + (size_t)(pn_) * HALF * K * 2)
    const unsigned ldsw = (unsigned)wid * 1024u;
    const int aoff = lds_byte(wr * 64 + fr, fq * 8), boff = lds_byte(wc * 32 + fr, fq * 8);
#define PG8_SA(b, h) (((b) * 2 + (h)) * HTB)
#define PG8_SB(b, h) ((4 + (b) * 2 + (h)) * HTB)
#define PG8_STAGE(bufoff, gbase, voff) do { _Pragma("unroll") for (int _i = 0; _i < 2; ++_i) \
        __builtin_amdgcn_global_load_lds((const unsigned*)((const char*)(gbase) + (voff)[_i]), (PG8_LAS unsigned*)(lds + (bufoff) + ldsw + _i * 8192), 16, 0, 0); } while (0)
#define PG8_LDA(dst, b, h) do { _Pragma("unroll") for (int m = 0; m < 4; ++m) _Pragma("unroll") for (int k = 0; k < 2; ++k) dst[m][k] = *(const PG8_LAS bf16x8*)(lds + PG8_SA(b, h) + aoff + m * 2048 + k * 1024); } while (0)
#define PG8_LDB(dst, b, h) do { _Pragma("unroll") for (int n = 0; n < 2; ++n) _Pragma("unroll") for (int k = 0; k < 2; ++k) dst[n][k] = *(const PG8_LAS bf16x8*)(lds + PG8_SB(b, h) + boff + n * 2048 + k * 1024); } while (0)
#define PG8_MMA(ai, bj, At, Bt) do { __builtin_amdgcn_s_setprio(1); _Pragma("unroll") for (int m = 0; m < 4; ++m) _Pragma("unroll") for (int n = 0; n < 2; ++n) _Pragma("unroll") for (int k = 0; k < 2; ++k) \
        acc[ai][bj][m][n] = __builtin_amdgcn_mfma_f32_16x16x32_bf16(Bt[n][k], At[m][k], acc[ai][bj][m][n], 0, 0, 0); __builtin_amdgcn_s_setprio(0); } while (0)
#define PG8_WAIT_V(n) asm volatile("s_waitcnt vmcnt(" #n ")" ::: "memory")
#define PG8_WAIT_L(n) asm volatile("s_waitcnt lgkmcnt(" #n ")" ::: "memory")
#define PG8_BAR __builtin_amdgcn_s_barrier()
#define PG8_SCHED __builtin_amdgcn_sched_barrier(0)
    Unit cur, nxt; int ui = 0;
    if (!S.next(0, cur)) return;
    f32x4 acc[2][2][4][2];
#pragma unroll
    for (int a = 0; a < 2; ++a)
#pragma unroll
        for (int b = 0; b < 2; ++b)
#pragma unroll
            for (int m = 0; m < 4; ++m)
#pragma unroll
                for (int n = 0; n < 2; ++n) acc[a][b][m][n] = (f32x4){0.f, 0.f, 0.f, 0.f};
    bf16x8 At[4][2], B0[2][2], B1[2][2];
    const char* cA = PG8_ABASE(cur.pm); const char* cB = PG8_BBASE(cur.pn);
    S.a_ready(cur);
    PG8_STAGE(PG8_SB(0, 0), cB, voffB); PG8_STAGE(PG8_SA(0, 0), cA, voffA); PG8_STAGE(PG8_SB(0, 1), cB + hstepB, voffB); PG8_STAGE(PG8_SA(0, 1), cA + hstepA, voffA);
    if (wr == 1) PG8_BAR;
    PG8_WAIT_V(4); PG8_BAR;
    PG8_STAGE(PG8_SB(1, 0), cB + kstep, voffB); PG8_STAGE(PG8_SA(1, 0), cA + kstep, voffA); PG8_STAGE(PG8_SB(1, 1), cB + hstepB + kstep, voffB);
    PG8_WAIT_V(6); PG8_BAR;
    PG8_STAMP();
    for (;;) {
        const bool has_next = S.next(ui + 1, nxt);
        const char* nA = has_next ? PG8_ABASE(nxt.pm) : cA; const char* nB = has_next ? PG8_BBASE(nxt.pn) : cB;
        for (int t = 0; t < nt; t += 2) {
            const bool last = (t == nt - 2);
            const char* a1 = cA + (size_t)(t + 1) * kstep;
            const char* a2 = last ? nA : cA + (size_t)(t + 2) * kstep; const char* b2 = last ? nB : cB + (size_t)(t + 2) * kstep;
            const char* a3 = a2 + kstep; const char* b3 = b2 + kstep;
            if (last && has_next) S.a_ready(nxt);
            PG8_LDB(B0, 0, 0); PG8_SCHED; PG8_LDA(At, 0, 0); PG8_STAGE(PG8_SA(1, 1), a1 + hstepA, voffA);
            PG8_WAIT_L(8); PG8_BAR; PG8_WAIT_L(0); PG8_MMA(0, 0, At, B0); PG8_BAR; PG8_SCHED;
            PG8_LDB(B1, 0, 1); PG8_STAGE(PG8_SB(0, 0), b2, voffB);
            PG8_BAR; PG8_WAIT_L(0); PG8_MMA(0, 1, At, B1); PG8_BAR;
            PG8_LDA(At, 0, 1); PG8_STAGE(PG8_SA(0, 0), a2, voffA);
            PG8_BAR; PG8_WAIT_L(0); PG8_MMA(1, 0, At, B0); PG8_BAR; PG8_SCHED;
            PG8_STAGE(PG8_SB(0, 1), b2 + hstepB, voffB);
            PG8_WAIT_V(6); PG8_BAR; PG8_MMA(1, 1, At, B1); PG8_BAR;
            PG8_LDB(B0, 1, 0); PG8_SCHED; PG8_LDA(At, 1, 0); PG8_STAGE(PG8_SA(0, 1), a2 + hstepA, voffA);
            PG8_WAIT_L(8); PG8_BAR; PG8_WAIT_L(0); PG8_MMA(0, 0, At, B0); PG8_BAR; PG8_SCHED;
            PG8_LDB(B1, 1, 1); PG8_STAGE(PG8_SB(1, 0), b3, voffB);
            PG8_BAR; PG8_WAIT_L(0); PG8_MMA(0, 1, At, B1); PG8_BAR;
            PG8_LDA(At, 1, 1); PG8_STAGE(PG8_SA(1, 0), a3, voffA);
            PG8_BAR; PG8_WAIT_L(0); PG8_MMA(1, 0, At, B0); PG8_BAR; PG8_SCHED;
            PG8_STAGE(PG8_SB(1, 1), b3 + hstepB, voffB);
            PG8_WAIT_V(6); PG8_BAR; PG8_MMA(1, 1, At, B1); PG8_BAR;
        }
        PG8_STAMP();
        if constexpr (!Epi::AFTER_DRAIN) { E(acc, cur, wr, wc, fr, fq); S.done(cur); }
        PG8_STAMP();
        if (!has_next) break;
#pragma unroll
        for (int a = 0; a < 2; ++a)
#pragma unroll
            for (int b = 0; b < 2; ++b)
#pragma unroll
                for (int m = 0; m < 4; ++m)
#pragma unroll
                    for (int n = 0; n < 2; ++n) acc[a][b][m][n] = (f32x4){0.f, 0.f, 0.f, 0.f};
        cur = nxt; cA = nA; cB = nB; ++ui;
    }
    PG8_WAIT_V(0);
    if (wr == 0) PG8_BAR;
    PG8_BAR;
    if constexpr (Epi::AFTER_DRAIN) { E.fused(acc, cur, wr, wc, fr, fq, lds, wid, lane); S.done(cur); }
    PG8_STAMP();
    if (STAMP && wid == 0) { stamps[lane] = lane < nts ? (((unsigned long long)(unsigned)ts_hi << 32) | (unsigned)ts_lo) : 0ull;
        if (lane == 62) stamps[62] = rt_entry; if (lane == 63) stamps[63] = (unsigned long long)wall_clock64(); }
#undef PG8_STAMP
#undef PG8_SA
#undef PG8_SB
#undef PG8_STAGE
#undef PG8_LDA
#undef PG8_LDB
#undef PG8_MMA
#undef PG8_WAIT_V
#undef PG8_WAIT_L
#undef PG8_BAR
#undef PG8_SCHED
#undef PG8_ABASE
#undef PG8_BBASE
}

}

using pg8::bf16_t; using pg8::bf16x8; using pg8::f32x4; using pg8::f32x2_nat;
#define LAS __attribute__((address_space(3)))
#ifndef N_LAUNCH_MODE
#define N_LAUNCH_MODE 0
#endif
constexpr int T = 32768, D = 1024, SEQ = 4096, NMEMR = 2048, DIN = 4104, NP = 4096, DFF = 2816, NUP = 5632, TH = 16384;
constexpr float ALPHA = 1.189207115002721f, LN_EPS = 1e-5f;
constexpr int HQ = 0, HF = 512, HI = 1024, HG = 1536, MQ = 2048, MK = 2560, MV = 3072, MO = 3584;
constexpr size_t MiB = 1ull << 20;
constexpr size_t WS_WIN = 0, WS_WOUT = 8 * MiB, WS_WQ = 10 * MiB, WS_WKV = 12 * MiB, WS_WO = 16 * MiB, WS_WUP = 18 * MiB, WS_WDN = 29 * MiB,
                 WS_GATES = 35 * MiB, WS_MEMB = 36 * MiB, WS_KB = 40 * MiB, WS_VT = 44 * MiB,
                 WS_XB = 50 * MiB  , WS_PROJ = 114 * MiB, WS_X1 = 114 * MiB, WS_X1B = 242 * MiB  , WS_QB = 306 * MiB,
                 WS_UB = 50 * MiB, WS_HB = 306 * MiB, WS_Y = 370 * MiB, WS_BAR = 49 * MiB;
constexpr size_t WS_ST1 = 483 * MiB, WS_ST2 = WS_ST1 + 256 * 1024, WS_CV = WS_ST1 + 512 * 1024;
constexpr int LDS_BYTES = 144 * 1024;
constexpr int NPH = 16;
struct Args { const float* in[23]; float* out; unsigned char* ws; int ph_lo, ph_hi; };

#define WAVE_LDS_SYNC() asm volatile("s_waitcnt lgkmcnt(0)" ::: "memory")
__device__ __forceinline__ unsigned pk2(float a, float b) { return pg8::cvt_pk_bf16(a, b); }
__device__ __forceinline__ bf16_t f2bf(float a) { return (bf16_t)(pk2(a, a) & 0xffffu); }
__device__ __forceinline__ float bf2f(bf16_t u) { return __uint_as_float(((unsigned)u) << 16); }
__device__ __forceinline__ float bflo(unsigned u) { return __uint_as_float(u << 16); }
__device__ __forceinline__ float bfhi(unsigned u) { return __uint_as_float(u & 0xffff0000u); }
__device__ __forceinline__ float wave_sum(float v) {
#pragma unroll
    for (int o = 1; o < 64; o <<= 1) v += __shfl_xor(v, o);
    return v;
}
__device__ __forceinline__ float sigm(float x) { return __builtin_amdgcn_rcpf(1.f + __expf(-x)); }
__device__ __forceinline__ float gelu_tanh(float x) { const float u = 0.7978845608028654f * (x + 0.044715f * x * x * x); const float th = 1.f - 2.f * __builtin_amdgcn_rcpf(1.f + __expf(2.f * u)); return 0.5f * x * (1.f + th); }

__device__ __forceinline__ void transpose_item(const float* W, int ldw, int K, int N, bf16_t* WT, LAS float* scr, int item, int lane, const float* gsc = nullptr, const float* bsc = nullptr, float* c1 = nullptr, float* c2 = nullptr) {
    const int nblk = N / 32, kb = item / nblk, nb = item % nblk, k0 = 64 * kb, n0 = 32 * nb;
    if (gsc) {
        float s1 = 0.f, s2 = 0.f;
#pragma unroll 8
        for (int i = 0; i < 32; ++i) { const int kk = 2 * i + (lane >> 5); const float wv = W[(size_t)(k0 + kk) * ldw + n0 + (lane & 31)]; const float gw = wv * gsc[k0 + kk];
            s1 += gw; s2 += wv * bsc[k0 + kk]; scr[kk * 33 + (lane & 31)] = gw; }
        s1 += __shfl_xor(s1, 32); s2 += __shfl_xor(s2, 32);
        if (lane < 32) { atomicAdd(c1 + n0 + lane, s1); atomicAdd(c2 + n0 + lane, s2); }
    } else {
#pragma unroll 8
    for (int i = 0; i < 32; ++i) { const int kk = 2 * i + (lane >> 5); scr[kk * 33 + (lane & 31)] = W[(size_t)(k0 + kk) * ldw + n0 + (lane & 31)]; }
    }
    WAVE_LDS_SYNC();
    const int c = lane & 7;
#pragma unroll
    for (int j = 0; j < 4; ++j) { const int n = (lane >> 3) + 8 * j; const LAS float* s = scr + (8 * c) * 33 + n;
        uint4 o; o.x = pk2(s[0 * 33], s[1 * 33]); o.y = pk2(s[2 * 33], s[3 * 33]); o.z = pk2(s[4 * 33], s[5 * 33]); o.w = pk2(s[6 * 33], s[7 * 33]);
        *(uint4*)(WT + (size_t)(n0 + n) * K + k0 + 8 * c) = o; }
    WAVE_LDS_SYNC();
}
__device__ __forceinline__ void p0_prep(const Args& a, LAS unsigned char* lds, int tid, int wave, int lane, int gw, int NGW) {
    unsigned char* ws = a.ws;
    LAS float* wgT = (LAS float*)lds;
    LAS float* scr = (LAS float*)(lds + 32768 + wave * 8448);
    const float* w_in = a.in[2];
    for (int e = tid; e < 8192; e += 512) { const int k = e >> 3, c = e & 7; wgT[c * 1024 + k] = w_in[(size_t)k * DIN + 4096 + c]; }
    __syncthreads();
    constexpr int I_IN = 16 * 128, I_KV = 16 * 64;
    for (int it = gw; it < I_IN + I_KV; it += NGW) {
        if (it < I_IN) transpose_item(a.in[2], DIN, D, NP, (bf16_t*)(ws + WS_WIN), scr, it, lane);
        else transpose_item(a.in[13], 2 * D, D, 2 * D, (bf16_t*)(ws + WS_WKV), scr, it - I_IN, lane);
    }
    for (int i = (gw * 64 + lane); i < (512 * 1024 + 64 * 1024) / 16; i += NGW * 64) ((uint4*)(ws + WS_ST1))[i] = make_uint4(0u, 0u, 0u, 0u);
    const float* x = a.in[0]; const float* b_in = a.in[3];
    bf16_t* xb = (bf16_t*)(ws + WS_XB); float* gates = (float*)(ws + WS_GATES);
    f32x4 xn[4];
    if (gw < T) {
#pragma unroll
        for (int j = 0; j < 4; ++j) xn[j] = ((const f32x4*)(x + (size_t)gw * D) + lane)[64 * j]; }
    for (int m = gw; m < T; m += NGW) {
        uint2* xo = (uint2*)(xb + (size_t)m * D) + lane;
        f32x4 xc[4];
#pragma unroll
        for (int j = 0; j < 4; ++j) xc[j] = xn[j];
        if (m + NGW < T) {
#pragma unroll
            for (int j = 0; j < 4; ++j) xn[j] = ((const f32x4*)(x + (size_t)(m + NGW) * D) + lane)[64 * j]; }
        float g[8];
#pragma unroll
        for (int c = 0; c < 8; ++c) g[c] = 0.f;
#pragma unroll
        for (int j = 0; j < 4; ++j) { const f32x4 v = xc[j]; uint2 o; o.x = pk2(v[0], v[1]); o.y = pk2(v[2], v[3]); xo[64 * j] = o;
#pragma unroll
            for (int c = 0; c < 8; ++c) { const f32x4 w = *(const LAS f32x4*)(wgT + c * 1024 + 4 * (lane + 64 * j)); g[c] += (v[0] * w[0] + v[1] * w[1]) + (v[2] * w[2] + v[3] * w[3]); } }
#pragma unroll
        for (int c = 0; c < 8; ++c) g[c] = wave_sum(g[c]);
        float r = g[0];
#pragma unroll
        for (int c = 1; c < 8; ++c) r = (lane == c) ? g[c] : r;
        if (lane < 8) gates[(size_t)m * 8 + lane] = r + b_in[4096 + lane];
    }
    const float* mem = a.in[1]; bf16_t* memb = (bf16_t*)(ws + WS_MEMB);
    for (int m = gw; m < NMEMR; m += NGW) {
        const f32x4* xr = (const f32x4*)(mem + (size_t)m * D) + lane; uint2* xo = (uint2*)(memb + (size_t)m * D) + lane;
#pragma unroll
        for (int j = 0; j < 4; ++j) { const f32x4 v = xr[64 * j]; uint2 o; o.x = pk2(v[0], v[1]); o.y = pk2(v[2], v[3]); xo[64 * j] = o; }
    }
}

__device__ __forceinline__ void late_prep(const Args& a, LAS unsigned char* lds, int wave, int lane, int gw2, int NGW2) {
    unsigned char* ws = a.ws; LAS float* scr = (LAS float*)(lds + 32768 + wave * 8448);
    constexpr int I_SQ = 16 * 32, I_UP = 16 * 176, I_DN = 44 * 32;
    for (int it = gw2; it < 3 * I_SQ + I_UP + I_DN; it += NGW2) {
        int r = it;
        if (r < I_SQ) { transpose_item(a.in[9], D, D, D, (bf16_t*)(ws + WS_WOUT), scr, r, lane); continue; } r -= I_SQ;
        if (r < I_SQ) { transpose_item(a.in[12], D, D, D, (bf16_t*)(ws + WS_WQ), scr, r, lane, a.in[10], a.in[11], (float*)(ws + WS_CV), (float*)(ws + WS_CV) + 1024); continue; } r -= I_SQ;
        if (r < I_SQ) { transpose_item(a.in[14], D, D, D, (bf16_t*)(ws + WS_WO), scr, r, lane); continue; } r -= I_SQ;
        if (r < I_UP) { transpose_item(a.in[17], NUP, D, NUP, (bf16_t*)(ws + WS_WUP), scr, r, lane); continue; } r -= I_UP;
        transpose_item(a.in[20], D, DFF, D, (bf16_t*)(ws + WS_WDN), scr, r, lane);
    }
}
__device__ __forceinline__ void hgrn2_rec(const Args& a, int b, int h, LAS float* lds, int tid, int wave, int lane) {
    const bf16_t* projb = (const bf16_t*)(a.ws + WS_PROJ); bf16_t* y = (bf16_t*)(a.ws + WS_Y);
    const float* lbl = a.in[4]; const float* nw = a.in[5];
    LAS float* sq = lds; LAS float* sf = lds + 2048; LAS float* sv = lds + 4096; LAS float* spart = lds + 6144;
    const int v = tid & 127, g = tid >> 7;
    const float l0 = lbl[h * 128 + v], l1 = lbl[512 + h * 128 + v]; const float lb = 1.f / (1.f + __expf(l1 - l0));
    float S[32];
#pragma unroll
    for (int i = 0; i < 32; ++i) S[i] = 0.f;
    for (int t0 = 0; t0 < SEQ; t0 += 16) {
#pragma unroll
        for (int i = 0; i < 4; ++i) { const int tt = g + 4 * i; const bf16_t* pr = projb + (size_t)(b * SEQ + t0 + tt) * NP + h * 128 + v;
            const float hq = bf2f(pr[HQ]), hf = bf2f(pr[HF]), hi = bf2f(pr[HI]);
            sq[tt * 128 + v] = hq * sigm(hq); sf[tt * 128 + v] = lb + (1.f - lb) * sigm(hf); sv[tt * 128 + v] = hi; }
        __syncthreads();
        for (int tt = 0; tt < 16; ++tt) { const float vv = sv[tt * 128 + v]; float part = 0.f;
#pragma unroll
            for (int i = 0; i < 32; i += 4) { const f32x4 f4 = *(const LAS f32x4*)(sf + tt * 128 + g * 32 + i), q4 = *(const LAS f32x4*)(sq + tt * 128 + g * 32 + i);
#pragma unroll
                for (int jj = 0; jj < 4; ++jj) { S[i + jj] = f4[jj] * S[i + jj] + (1.f - f4[jj]) * vv; part += q4[jj] * S[i + jj]; } }
            spart[(tt * 4 + g) * 128 + v] = part; }
        __syncthreads();
#pragma unroll
        for (int q = 0; q < 2; ++q) { const int tt = 2 * wave + q; const size_t row = (size_t)(b * SEQ + t0 + tt);
            float o0 = 0.f, o1 = 0.f;
#pragma unroll
            for (int gg = 0; gg < 4; ++gg) { o0 += spart[(tt * 4 + gg) * 128 + lane]; o1 += spart[(tt * 4 + gg) * 128 + lane + 64]; }
            const float rstd = rsqrtf(wave_sum(o0 * o0 + o1 * o1) * (1.f / 128.f) + LN_EPS);
            const float g0 = bf2f(projb[row * NP + HG + h * 128 + lane]), g1 = bf2f(projb[row * NP + HG + h * 128 + lane + 64]);
            y[row * D + h * 128 + lane] = f2bf(o0 * rstd * nw[h * 128 + lane] * (g0 * sigm(g0)));
            y[row * D + h * 128 + lane + 64] = f2bf(o1 * rstd * nw[h * 128 + lane + 64] * (g1 * sigm(g1))); }
    }
}
__device__ __forceinline__ void mlstm_rec(const Args& a, int b, int h, LAS float* lds, int tid, int wave, int lane) {
    const bf16_t* projb = (const bf16_t*)(a.ws + WS_PROJ); bf16_t* y = (bf16_t*)(a.ws + WS_Y); const float* gates = (const float*)(a.ws + WS_GATES);
    const float* cw = a.in[6]; const float* cb = a.in[7]; const float* nw = a.in[8];
    LAS float* sq = lds; LAS float* sk = lds + 2048; LAS float* sv = lds + 4096; LAS float* spart = lds + 6144;
    LAS float* sgi = lds + 6144 + 16 * 4 * 132; LAS float* sgf = sgi + 16; LAS float* smt = sgf + 16;
    const int v = tid & 127, g = tid >> 7;
    float cwq[4], cwk[4];
#pragma unroll
    for (int j = 0; j < 4; ++j) { cwq[j] = cw[j * 1024 + h * 128 + v]; cwk[j] = cw[j * 1024 + 512 + h * 128 + v]; }
    const float cbq = cb[h * 128 + v], cbk = cb[512 + h * 128 + v];
    float C[32], nn[32];
#pragma unroll
    for (int i = 0; i < 32; ++i) { C[i] = 0.f; nn[i] = 0.f; }
    float mrun = -1e30f;
    for (int t0 = 0; t0 < SEQ; t0 += 16) {
#pragma unroll
        for (int i = 0; i < 4; ++i) { const int tt = g + 4 * i, t = t0 + tt; const bf16_t* pr = projb + (size_t)(b * SEQ + t) * NP + h * 128 + v;
            float aq = cbq, ak = cbk;
#pragma unroll
            for (int j = 0; j < 4; ++j) { const int ts = t - 3 + j; if (ts >= 0) { const bf16_t* ps = pr - (size_t)(3 - j) * NP; aq += bf2f(ps[MQ]) * cwq[j]; ak += bf2f(ps[MK]) * cwk[j]; } }
            sq[tt * 128 + v] = aq * sigm(aq) * 0.08838834764831845f; sk[tt * 128 + v] = ak * sigm(ak); sv[tt * 128 + v] = bf2f(pr[MV]); }
        if (tid < 16) { const size_t row = (size_t)(b * SEQ + t0 + tid); const float mi = gates[row * 8 + h], mf = gates[row * 8 + 4 + h];
            sgi[tid] = mi; sgf[tid] = fminf(mf, 0.f) - log1pf(__expf(-fabsf(mf))); }
        __syncthreads();
        for (int tt = 0; tt < 16; ++tt) { const float vv = sv[tt * 128 + v];
            const float it = sgi[tt], lf = sgf[tt]; const float mnew = fmaxf(lf + mrun, it); const float fp = __expf(lf + mrun - mnew), ip = __expf(it - mnew); mrun = mnew;
            float part = 0.f, dpart = 0.f; const float iv = ip * vv;
#pragma unroll
            for (int i = 0; i < 32; i += 4) { const f32x4 k4 = *(const LAS f32x4*)(sk + tt * 128 + g * 32 + i), q4 = *(const LAS f32x4*)(sq + tt * 128 + g * 32 + i);
#pragma unroll
                for (int jj = 0; jj < 4; ++jj) { C[i + jj] = fp * C[i + jj] + iv * k4[jj]; nn[i + jj] = fp * nn[i + jj] + ip * k4[jj]; part += q4[jj] * C[i + jj]; dpart += q4[jj] * nn[i + jj]; } }
            spart[(tt * 4 + g) * 132 + v] = part; if (v == 0) spart[(tt * 4 + g) * 132 + 128] = dpart; if (tid == 0) smt[tt] = mnew; }
        __syncthreads();
#pragma unroll
        for (int q = 0; q < 2; ++q) { const int tt = 2 * wave + q; const size_t row = (size_t)(b * SEQ + t0 + tt);
            float o0 = 0.f, o1 = 0.f, den = 0.f;
#pragma unroll
            for (int gg = 0; gg < 4; ++gg) { o0 += spart[(tt * 4 + gg) * 132 + lane]; o1 += spart[(tt * 4 + gg) * 132 + lane + 64]; den += spart[(tt * 4 + gg) * 132 + 128]; }
            const float dn = 1.f / fmaxf(fabsf(den), __expf(-smt[tt]));
            o0 *= dn; o1 *= dn;
            const float mean = wave_sum(o0 + o1) * (1.f / 128.f); const float d0 = o0 - mean, d1 = o1 - mean;
            const float rstd = rsqrtf(wave_sum(d0 * d0 + d1 * d1) * (1.f / 128.f) + LN_EPS);
            const float g0 = bf2f(projb[row * NP + MO + h * 128 + lane]), g1 = bf2f(projb[row * NP + MO + h * 128 + lane + 64]);
            y[row * D + 512 + h * 128 + lane] = f2bf(sigm(g0) * d0 * rstd * nw[h * 128 + lane]);
            y[row * D + 512 + h * 128 + lane + 64] = f2bf(sigm(g1) * d1 * rstd * nw[h * 128 + lane + 64]); }
    }
}

constexpr int P128 = 136, P64 = 72;
typedef unsigned u32x2 __attribute__((ext_vector_type(2)));
typedef unsigned u32x4n __attribute__((ext_vector_type(4)));
__device__ __forceinline__ u32x2 pack4(float a, float b, float c, float d) { u32x2 r; r.x = pk2(a, b); r.y = pk2(c, d); return r; }
__device__ __forceinline__ void unpack4(u32x2 u, float (&o)[4]) { o[0] = bflo(u.x); o[1] = bfhi(u.x); o[2] = bflo(u.y); o[3] = bfhi(u.y); }
#define MFMA16(a, b, c) __builtin_amdgcn_mfma_f32_16x16x32_bf16(a, b, c, 0, 0, 0)
#define LDFRAG(base, row, pitch, ks) (*(const LAS bf16x8*)((base) + (row) * (pitch) + (ks) * 32 + quad * 8))

__device__ __forceinline__ void hgrn2_chunk(const Args& a, int b, int h, LAS unsigned char* lds, int tid, int w, int lane) {
    const bf16_t* projb = (const bf16_t*)(a.ws + WS_PROJ); bf16_t* y = (bf16_t*)(a.ws + WS_Y);
    const float* lbl = a.in[4]; const float* nw = a.in[5];
    LAS bf16_t* QD = (LAS bf16_t*)lds; LAS bf16_t* KD = QD + 64 * P128; LAS bf16_t* QB = KD + 64 * P128;
    LAS bf16_t* KLT = QB + 64 * P128; LAS bf16_t* VT = KLT + 128 * P64; LAS bf16_t* ATT = VT + 128 * P64; LAS bf16_t* ST = ATT + 64 * P64;
    LAS float* NRM = (LAS float*)(ST + 128 * P128);
    const int tg = lane >> 2, dg = lane & 3, quad = lane >> 4, r16 = lane & 15;
    const int tt = w >> 1, vh = w & 1;
    for (int e = tid; e < 128 * P128 / 2; e += 512) ((LAS unsigned*)ST)[e] = 0u;
    LAS float* NWL = NRM + 128;
    if (tid < 128) NWL[tid] = nw[h * 128 + tid];
    float lb[4];
#pragma unroll
    for (int k = 0; k < 4; ++k) { const int d = h * 128 + 16 * w + 4 * dg + k; lb[k] = __builtin_amdgcn_rcpf(1.f + __expf(lbl[512 + d] - lbl[d])); }
    f32x4 Sacc[8];
#pragma unroll
    for (int i = 0; i < 8; ++i) Sacc[i] = (f32x4){0.f, 0.f, 0.f, 0.f};
    const size_t rowbase = (size_t)b * SEQ;
    const bf16_t* pcol = projb + h * 128 + 16 * w + 4 * dg;
    const bf16_t* pgat = projb + HG + h * 128 + 64 * vh + 4 * quad;
    u32x2 rq[4], rf[4], rv[4], rg[4];
#pragma unroll
    for (int i = 0; i < 4; ++i) { const bf16_t* p = pcol + (rowbase + 4 * tg + i) * NP; rq[i] = *(const u32x2*)(p + HQ); rf[i] = *(const u32x2*)(p + HF); rv[i] = *(const u32x2*)(p + HI); }
#pragma unroll
    for (int vt = 0; vt < 4; ++vt) rg[vt] = *(const u32x2*)(pgat + (rowbase + 16 * tt + r16) * NP + 16 * vt);
    __syncthreads();
    for (int c = 0; c < 64; ++c) {
        float q[4][4], lf[4][4], kk[4][4], vv[4][4]; u32x2 rgc[4];
#pragma unroll
        for (int i = 0; i < 4; ++i) { float hq[4], hf[4]; unpack4(rq[i], hq); unpack4(rf[i], hf); unpack4(rv[i], vv[i]);
#pragma unroll
            for (int k = 0; k < 4; ++k) { q[i][k] = hq[k]; const float f = lb[k] + (1.f - lb[k]) * sigm(hf[k]); lf[i][k] = __logf(f); kk[i][k] = 1.f - f; } }
#pragma unroll
        for (int vt = 0; vt < 4; ++vt) rgc[vt] = rg[vt];
        float bref[4], blast[4], dec[4];
#pragma unroll
        for (int k = 0; k < 4; ++k) {
            lf[1][k] += lf[0][k]; lf[2][k] += lf[1][k]; lf[3][k] += lf[2][k];
            const float tot = lf[3][k]; float run = tot;
#pragma unroll
            for (int off = 4; off < 64; off <<= 1) { const float t2 = __shfl_up(run, off); if (lane >= off) run += t2; }
            const float excl = run - tot;
#pragma unroll
            for (int i = 0; i < 4; ++i) lf[i][k] += excl;
            bref[k] = __shfl(lf[3][k], 28 + dg); blast[k] = __shfl(lf[3][k], 60 + dg);
        }
#pragma unroll
        for (int j = 0; j < 4; ++j) { float e = __expf(blast[0]); e = (j == 1) ? __expf(blast[1]) : e; e = (j == 2) ? __expf(blast[2]) : e; e = (j == 3) ? __expf(blast[3]) : e; dec[j] = __shfl(e, 60 + quad); }
        {
            float eref[4], elast[4];
#pragma unroll
            for (int k = 0; k < 4; ++k) { eref[k] = __expf(bref[k]); elast[k] = __expf(blast[k] - bref[k]); }
            float kl[4][4];
#pragma unroll
            for (int i = 0; i < 4; ++i) { float qd[4], kd[4], qb[4];
#pragma unroll
                for (int k = 0; k < 4; ++k) { const float e1 = __expf(lf[i][k] - bref[k]), e2 = __expf(bref[k] - lf[i][k]);
                    qd[k] = q[i][k] * e1; kd[k] = kk[i][k] * e2; qb[k] = qd[k] * eref[k]; kl[i][k] = kd[k] * elast[k]; }
                const int off = (4 * tg + i) * P128 + 16 * w + 4 * dg;
                *(LAS u32x2*)(QD + off) = pack4(qd[0], qd[1], qd[2], qd[3]); *(LAS u32x2*)(KD + off) = pack4(kd[0], kd[1], kd[2], kd[3]); *(LAS u32x2*)(QB + off) = pack4(qb[0], qb[1], qb[2], qb[3]); }
#pragma unroll
            for (int k = 0; k < 4; ++k) { const int off = (16 * w + 4 * dg + k) * P64 + 4 * tg;
                *(LAS u32x2*)(KLT + off) = pack4(kl[0][k], kl[1][k], kl[2][k], kl[3][k]); *(LAS u32x2*)(VT + off) = pack4(vv[0][k], vv[1][k], vv[2][k], vv[3][k]); }
        }
        __syncthreads();
        { const int cn = (c + 1 < 64) ? c + 1 : 63;
#pragma unroll
            for (int i = 0; i < 4; ++i) { const bf16_t* p = pcol + (rowbase + cn * 64 + 4 * tg + i) * NP; rq[i] = *(const u32x2*)(p + HQ); rf[i] = *(const u32x2*)(p + HF); rv[i] = *(const u32x2*)(p + HI); }
#pragma unroll
            for (int vt = 0; vt < 4; ++vt) rg[vt] = *(const u32x2*)(pgat + (rowbase + cn * 64 + 16 * tt + r16) * NP + 16 * vt); }
        {
            bf16x8 qf[4];
#pragma unroll
            for (int ks = 0; ks < 4; ++ks) qf[ks] = LDFRAG(QD, 16 * tt + r16, P128, ks);
#pragma unroll
            for (int si = 0; si < 2; ++si) { const int st = 2 * vh + si; f32x4 acc = {0.f, 0.f, 0.f, 0.f};
                if (st <= tt) {
#pragma unroll
                    for (int ks = 0; ks < 4; ++ks) { const bf16x8 kf = LDFRAG(KD, 16 * st + r16, P128, ks); acc = MFMA16(kf, qf[ks], acc); }
                    const int t = 16 * tt + r16, s0 = 16 * st + 4 * quad;
#pragma unroll
                    for (int j = 0; j < 4; ++j) acc[j] = (s0 + j <= t) ? acc[j] : 0.f;
                }
                *(LAS u32x2*)(ATT + (16 * tt + r16) * P64 + 16 * st + 4 * quad) = pack4(acc[0], acc[1], acc[2], acc[3]); }
        }
        __syncthreads();
        f32x4 o[4];
        {
            bf16x8 af[2], qbf[4];
#pragma unroll
            for (int ks = 0; ks < 2; ++ks) af[ks] = LDFRAG(ATT, 16 * tt + r16, P64, ks);
#pragma unroll
            for (int ks = 0; ks < 4; ++ks) qbf[ks] = LDFRAG(QB, 16 * tt + r16, P128, ks);
            float ss = 0.f;
#pragma unroll
            for (int vt = 0; vt < 4; ++vt) { const int v0 = 64 * vh + 16 * vt; f32x4 acc = {0.f, 0.f, 0.f, 0.f};
#pragma unroll
                for (int ks = 0; ks < 2; ++ks) acc = MFMA16(LDFRAG(VT, v0 + r16, P64, ks), af[ks], acc);
#pragma unroll
                for (int ks = 0; ks < 4; ++ks) acc = MFMA16(LDFRAG(ST, v0 + r16, P128, ks), qbf[ks], acc);
                o[vt] = acc; ss += (acc[0] * acc[0] + acc[1] * acc[1]) + (acc[2] * acc[2] + acc[3] * acc[3]); }
            ss += __shfl_xor(ss, 16); ss += __shfl_xor(ss, 32);
            if (quad == 0) NRM[(16 * tt + r16) * 2 + vh] = ss;
            bf16x8 klf[2];
#pragma unroll
            for (int ks = 0; ks < 2; ++ks) klf[ks] = LDFRAG(KLT, 16 * w + r16, P64, ks);
#pragma unroll
            for (int v8 = 0; v8 < 8; ++v8) { f32x4 acc = Sacc[v8];
#pragma unroll
                for (int j = 0; j < 4; ++j) acc[j] *= dec[j];
#pragma unroll
                for (int ks = 0; ks < 2; ++ks) acc = MFMA16(klf[ks], LDFRAG(VT, 16 * v8 + r16, P64, ks), acc);
                Sacc[v8] = acc; }
        }
        __syncthreads();
#pragma unroll
        for (int v8 = 0; v8 < 8; ++v8) *(LAS u32x2*)(ST + (16 * v8 + r16) * P128 + 16 * w + 4 * quad) = pack4(Sacc[v8][0], Sacc[v8][1], Sacc[v8][2], Sacc[v8][3]);
        {
            const int t = 16 * tt + r16; const float rstd = __builtin_amdgcn_rsqf((NRM[t * 2] + NRM[t * 2 + 1]) * (1.f / 128.f) + LN_EPS);
            bf16_t* yp = y + (rowbase + c * 64 + t) * D + h * 128 + 64 * vh + 4 * quad;
#pragma unroll
            for (int vt = 0; vt < 4; ++vt) { float r[4], gt[4]; unpack4(rgc[vt], gt); const f32x4 nv = *(const LAS f32x4*)(NWL + 64 * vh + 16 * vt + 4 * quad);
#pragma unroll
                for (int j = 0; j < 4; ++j) r[j] = o[vt][j] * rstd * nv[j] * gt[j];
                *(u32x2*)(yp + 16 * vt) = pack4(r[0], r[1], r[2], r[3]); }
        }
    }
    __syncthreads();
}

__device__ __forceinline__ void mlstm_chunk(const Args& a, int b, int h, LAS unsigned char* lds, int tid, int w, int lane) {
    const bf16_t* projb = (const bf16_t*)(a.ws + WS_PROJ); bf16_t* y = (bf16_t*)(a.ws + WS_Y); const float* gates = (const float*)(a.ws + WS_GATES);
    const float* cw = a.in[6]; const float* cb = a.in[7]; const float* nw = a.in[8];
    LAS bf16_t* QM = (LAS bf16_t*)lds; LAS bf16_t* KM = QM + 64 * P128; LAS bf16_t* QW = KM + 64 * P128;
    LAS bf16_t* KLT = QW + 64 * P128; LAS bf16_t* VT = KLT + 128 * P64; LAS bf16_t* ATT = VT + 144 * P64; LAS bf16_t* ST = ATT + 64 * P64;
    LAS float* NRM = (LAS float*)(ST + 144 * P128);
    const int tg = lane >> 2, dg = lane & 3, quad = lane >> 4, r16 = lane & 15;
    const int tt = w >> 1, vh = w & 1;
    for (int e = tid; e < 144 * P128 / 2; e += 512) ((LAS unsigned*)ST)[e] = 0u;
    for (int e = tid; e < 16 * P64 / 2; e += 512) ((LAS unsigned*)(VT + 128 * P64))[e] = (e < P64 / 2) ? 0x3F803F80u : 0u;
    LAS float* NWL = NRM + 256 + 1280;
    if (tid < 128) NWL[tid] = nw[h * 128 + tid];
    LAS float* CWT = NRM + 256;
    for (int e = tid; e < 1280; e += 512) { const int r = e >> 7, d = e & 127; CWT[e] = (r < 4) ? cw[r * 1024 + h * 128 + d] : (r < 8) ? cw[(r - 4) * 1024 + 512 + h * 128 + d] : (r == 8) ? cb[h * 128 + d] : cb[512 + h * 128 + d]; }
    f32x4 Cacc[9];
#pragma unroll
    for (int i = 0; i < 9; ++i) Cacc[i] = (f32x4){0.f, 0.f, 0.f, 0.f};
    float m_st = -1e30f;
    const size_t rowbase = (size_t)b * SEQ;
    const bf16_t* pcol = projb + h * 128 + 16 * w + 4 * dg;
    const bf16_t* pgat = projb + MO + h * 128 + 64 * vh + 4 * quad;
    u32x2 rq[7], rk[7], rv[4], rg[4]; float rmi, rmf;
#pragma unroll
    for (int i = 0; i < 7; ++i) { const int t = 4 * tg + i - 3; if (t >= 0) { const bf16_t* p = pcol + (rowbase + t) * NP; rq[i] = *(const u32x2*)(p + MQ); rk[i] = *(const u32x2*)(p + MK); } else { rq[i] = (u32x2){0u, 0u}; rk[i] = (u32x2){0u, 0u}; } }
#pragma unroll
    for (int i = 0; i < 4; ++i) rv[i] = *(const u32x2*)(pcol + (rowbase + 4 * tg + i) * NP + MV);
#pragma unroll
    for (int vt = 0; vt < 4; ++vt) rg[vt] = *(const u32x2*)(pgat + (rowbase + 16 * tt + r16) * NP + 16 * vt);
    rmi = gates[(rowbase + lane) * 8 + h]; rmf = gates[(rowbase + lane) * 8 + 4 + h];
    __syncthreads();
    for (int c = 0; c < 64; ++c) {
        const float mi = rmi, lfs = fminf(rmf, 0.f) - log1pf(__expf(-fabsf(rmf)));
        float bs = lfs;
#pragma unroll
        for (int off = 1; off < 64; off <<= 1) { const float t2 = __shfl_up(bs, off); if (lane >= off) bs += t2; }
        const float gsum = __shfl(bs, 63);
        const float imb = mi - bs; float pm = imb;
#pragma unroll
        for (int off = 1; off < 64; off <<= 1) { const float t2 = __shfl_up(pm, off); if (lane >= off) pm = fmaxf(pm, t2); }
        const float inter = bs + m_st, m_t = fmaxf(inter, pm + bs);
        const float w_inter = __expf(inter - m_t);
        const float m_new = fmaxf(gsum + m_st, gsum + __shfl(pm, 63));
        const float decay = __expf(gsum + m_st - m_new), aexp = __expf(gsum + imb - m_new);
        const float bm = bs - m_t;
        float qv[4][4], kv[4][4], vv[4][4]; u32x2 rgc[4];
        {
            const LAS float* cwp = CWT + 16 * w + 4 * dg;
            { float xq[7][4]; f32x4 wq[4];
#pragma unroll
                for (int i = 0; i < 7; ++i) unpack4(rq[i], xq[i]);
#pragma unroll
                for (int j = 0; j < 4; ++j) wq[j] = *(const LAS f32x4*)(cwp + j * 128);
                const f32x4 bq = *(const LAS f32x4*)(cwp + 8 * 128);
#pragma unroll
                for (int i = 0; i < 4; ++i)
#pragma unroll
                    for (int k = 0; k < 4; ++k) { float aq = bq[k];
#pragma unroll
                        for (int j = 0; j < 4; ++j) aq += xq[i + j][k] * wq[j][k];
                        qv[i][k] = aq * sigm(aq) * 0.08838834764831845f; } }
            { float xk[7][4]; f32x4 wk[4];
#pragma unroll
                for (int i = 0; i < 7; ++i) unpack4(rk[i], xk[i]);
#pragma unroll
                for (int j = 0; j < 4; ++j) wk[j] = *(const LAS f32x4*)(cwp + (4 + j) * 128);
                const f32x4 bk = *(const LAS f32x4*)(cwp + 9 * 128);
#pragma unroll
                for (int i = 0; i < 4; ++i)
#pragma unroll
                    for (int k = 0; k < 4; ++k) { float ak = bk[k];
#pragma unroll
                        for (int j = 0; j < 4; ++j) ak += xk[i + j][k] * wk[j][k];
                        kv[i][k] = ak * sigm(ak); } }
#pragma unroll
            for (int i = 0; i < 4; ++i) unpack4(rv[i], vv[i]);
#pragma unroll
            for (int vt = 0; vt < 4; ++vt) rgc[vt] = rg[vt];
        }
        {
            float wi[4], ae[4];
#pragma unroll
            for (int i = 0; i < 4; ++i) { wi[i] = __shfl(w_inter, 4 * tg + i); ae[i] = __shfl(aexp, 4 * tg + i); }
#pragma unroll
            for (int i = 0; i < 4; ++i) { const int off = (4 * tg + i) * P128 + 16 * w + 4 * dg;
                *(LAS u32x2*)(QM + off) = pack4(qv[i][0], qv[i][1], qv[i][2], qv[i][3]); *(LAS u32x2*)(KM + off) = pack4(kv[i][0], kv[i][1], kv[i][2], kv[i][3]);
                *(LAS u32x2*)(QW + off) = pack4(qv[i][0] * wi[i], qv[i][1] * wi[i], qv[i][2] * wi[i], qv[i][3] * wi[i]); }
#pragma unroll
            for (int k = 0; k < 4; ++k) { const int off = (16 * w + 4 * dg + k) * P64 + 4 * tg;
                *(LAS u32x2*)(KLT + off) = pack4(kv[0][k] * ae[0], kv[1][k] * ae[1], kv[2][k] * ae[2], kv[3][k] * ae[3]); *(LAS u32x2*)(VT + off) = pack4(vv[0][k], vv[1][k], vv[2][k], vv[3][k]); }
        }
        __syncthreads();
        { const int cn = (c + 1 < 64) ? c + 1 : 63; const size_t rb = rowbase + cn * 64;
#pragma unroll
            for (int i = 0; i < 7; ++i) { const bf16_t* p = pcol + (rb + 4 * tg + i - 3) * NP; rq[i] = *(const u32x2*)(p + MQ); rk[i] = *(const u32x2*)(p + MK); }
#pragma unroll
            for (int i = 0; i < 4; ++i) rv[i] = *(const u32x2*)(pcol + (rb + 4 * tg + i) * NP + MV);
#pragma unroll
            for (int vt = 0; vt < 4; ++vt) rg[vt] = *(const u32x2*)(pgat + (rb + 16 * tt + r16) * NP + 16 * vt);
            rmi = gates[(rb + lane) * 8 + h]; rmf = gates[(rb + lane) * 8 + 4 + h]; }
        {
            bf16x8 qf[4];
#pragma unroll
            for (int ks = 0; ks < 4; ++ks) qf[ks] = LDFRAG(QM, 16 * tt + r16, P128, ks);
            const float bmt = __shfl(bm, 16 * tt + r16);
#pragma unroll
            for (int si = 0; si < 2; ++si) { const int st = 2 * vh + si; f32x4 acc = {0.f, 0.f, 0.f, 0.f};
                if (st <= tt) {
#pragma unroll
                    for (int ks = 0; ks < 4; ++ks) { const bf16x8 kf = LDFRAG(KM, 16 * st + r16, P128, ks); acc = MFMA16(kf, qf[ks], acc); }
                    const int t = 16 * tt + r16, s0 = 16 * st + 4 * quad;
#pragma unroll
                    for (int j = 0; j < 4; ++j) { const float ims = __shfl(imb, s0 + j); acc[j] = (s0 + j <= t) ? acc[j] * __expf(bmt + ims) : 0.f; }
                }
                *(LAS u32x2*)(ATT + (16 * tt + r16) * P64 + 16 * st + 4 * quad) = pack4(acc[0], acc[1], acc[2], acc[3]); }
        }
        __syncthreads();
        f32x4 o[4];
        {
            bf16x8 af[2], qwf[4];
#pragma unroll
            for (int ks = 0; ks < 2; ++ks) af[ks] = LDFRAG(ATT, 16 * tt + r16, P64, ks);
#pragma unroll
            for (int ks = 0; ks < 4; ++ks) qwf[ks] = LDFRAG(QW, 16 * tt + r16, P128, ks);
            f32x4 ae4 = {0.f, 0.f, 0.f, 0.f};
#pragma unroll
            for (int ks = 0; ks < 2; ++ks) ae4 = MFMA16(LDFRAG(VT, 128 + r16, P64, ks), af[ks], ae4);
#pragma unroll
            for (int ks = 0; ks < 4; ++ks) ae4 = MFMA16(LDFRAG(ST, 128 + r16, P128, ks), qwf[ks], ae4);
            const float den = __shfl(ae4[0], r16);
            const float mt_t = __shfl(m_t, 16 * tt + r16);
            const float dn = __builtin_amdgcn_rcpf(fmaxf(fabsf(den), __expf(-mt_t)));
            float s1 = 0.f, s2 = 0.f;
#pragma unroll
            for (int vt = 0; vt < 4; ++vt) { const int v0 = 64 * vh + 16 * vt; f32x4 acc = {0.f, 0.f, 0.f, 0.f};
#pragma unroll
                for (int ks = 0; ks < 2; ++ks) acc = MFMA16(LDFRAG(VT, v0 + r16, P64, ks), af[ks], acc);
#pragma unroll
                for (int ks = 0; ks < 4; ++ks) acc = MFMA16(LDFRAG(ST, v0 + r16, P128, ks), qwf[ks], acc);
                acc = acc * dn; o[vt] = acc; s1 += (acc[0] + acc[1]) + (acc[2] + acc[3]); s2 += (acc[0] * acc[0] + acc[1] * acc[1]) + (acc[2] * acc[2] + acc[3] * acc[3]); }
            s1 += __shfl_xor(s1, 16); s1 += __shfl_xor(s1, 32); s2 += __shfl_xor(s2, 16); s2 += __shfl_xor(s2, 32);
            if (quad == 0) { NRM[(16 * tt + r16) * 4 + 2 * vh] = s1; NRM[(16 * tt + r16) * 4 + 2 * vh + 1] = s2; }
            bf16x8 klf[2];
#pragma unroll
            for (int ks = 0; ks < 2; ++ks) klf[ks] = LDFRAG(KLT, 16 * w + r16, P64, ks);
#pragma unroll
            for (int v9 = 0; v9 < 9; ++v9) { f32x4 acc = Cacc[v9] * decay;
#pragma unroll
                for (int ks = 0; ks < 2; ++ks) acc = MFMA16(klf[ks], LDFRAG(VT, 16 * v9 + r16, P64, ks), acc);
                Cacc[v9] = acc; }
        }
        __syncthreads();
#pragma unroll
        for (int v9 = 0; v9 < 9; ++v9) *(LAS u32x2*)(ST + (16 * v9 + r16) * P128 + 16 * w + 4 * quad) = pack4(Cacc[v9][0], Cacc[v9][1], Cacc[v9][2], Cacc[v9][3]);
        {
            const int t = 16 * tt + r16; const float mean = (NRM[t * 4] + NRM[t * 4 + 2]) * (1.f / 128.f); const float var = fmaxf((NRM[t * 4 + 1] + NRM[t * 4 + 3]) * (1.f / 128.f) - mean * mean, 0.f);
            const float rstd = __builtin_amdgcn_rsqf(var + LN_EPS);
            bf16_t* yp = y + (rowbase + c * 64 + t) * D + 512 + h * 128 + 64 * vh + 4 * quad;
#pragma unroll
            for (int vt = 0; vt < 4; ++vt) { float r[4], gt[4]; unpack4(rgc[vt], gt); const f32x4 nv = *(const LAS f32x4*)(NWL + 64 * vh + 16 * vt + 4 * quad);
#pragma unroll
                for (int j = 0; j < 4; ++j) r[j] = gt[j] * (o[vt][j] - mean) * rstd * nv[j];
                *(u32x2*)(yp + 16 * vt) = pack4(r[0], r[1], r[2], r[3]); }
        }
        m_st = m_new;
    }
    __syncthreads();
}

__device__ __forceinline__ unsigned xcc_id() { return (unsigned)__builtin_amdgcn_s_getreg((3 << 11) | 20) & 0xFu; }
__device__ __forceinline__ void grid_bar(unsigned* bar, unsigned xcc, unsigned nxb, unsigned nx, unsigned round) {
    asm volatile("s_waitcnt vmcnt(0)" ::: "memory");
    __syncthreads();
    if (threadIdx.x == 0) {
        const unsigned prev = __hip_atomic_fetch_add(bar + 64 * (1 + xcc), 1u, __ATOMIC_RELAXED, __HIP_MEMORY_SCOPE_AGENT);
        if (prev + 1u == round * nxb) {
            __builtin_amdgcn_fence(__ATOMIC_RELEASE, "agent");
            asm volatile("s_waitcnt vmcnt(0)" ::: "memory");
            __hip_atomic_fetch_add(bar, 1u, __ATOMIC_RELAXED, __HIP_MEMORY_SCOPE_AGENT);
        }
        while (__hip_atomic_load(bar, __ATOMIC_RELAXED, __HIP_MEMORY_SCOPE_AGENT) < round * nx) __builtin_amdgcn_s_sleep(1);
        __builtin_amdgcn_fence(__ATOMIC_ACQUIRE, "agent");
        asm volatile("s_waitcnt vmcnt(0)" ::: "memory");
    }
    __syncthreads();
}
constexpr size_t WS_ATH = 434 * MiB, WS_ATM = 450 * MiB, WS_DECH = 466 * MiB, WS_SCM = 467 * MiB;
__device__ __forceinline__ void hgrn2_pre(const Args& a, int b, int h, int c, LAS unsigned char* lds, int tid, int w, int lane) {
    const bf16_t* projb = (const bf16_t*)(a.ws + WS_PROJ); const float* lbl = a.in[4];
    bf16_t* QBH = (bf16_t*)a.out; bf16_t* KLH = QBH + (size_t)T * 512; bf16_t* ATH = (bf16_t*)(a.ws + WS_ATH); float* DECH = (float*)(a.ws + WS_DECH);
    LAS bf16_t* QD = (LAS bf16_t*)lds; LAS bf16_t* KD = QD + 64 * P128;
    const int tg = lane >> 2, dg = lane & 3, quad = lane >> 4, r16 = lane & 15, tt = w >> 1, vh = w & 1;
    const size_t item = (size_t)((b * 4 + h) * 64 + c), row0 = (size_t)b * SEQ + c * 64;
    float lb[4];
#pragma unroll
    for (int k = 0; k < 4; ++k) { const int d = h * 128 + 16 * w + 4 * dg + k; lb[k] = __builtin_amdgcn_rcpf(1.f + __expf(lbl[512 + d] - lbl[d])); }
    const bf16_t* pcol = projb + h * 128 + 16 * w + 4 * dg;
    float q[4][4], lf[4][4], kk[4][4];
#pragma unroll
    for (int i = 0; i < 4; ++i) { const bf16_t* p = pcol + (row0 + 4 * tg + i) * NP; float hq[4], hf[4]; unpack4(*(const u32x2*)(p + HQ), hq); unpack4(*(const u32x2*)(p + HF), hf);
#pragma unroll
        for (int k = 0; k < 4; ++k) { q[i][k] = hq[k]; const float f = lb[k] + (1.f - lb[k]) * sigm(hf[k]); lf[i][k] = __logf(f); kk[i][k] = 1.f - f; } }
    float bref[4], blast[4];
#pragma unroll
    for (int k = 0; k < 4; ++k) {
        lf[1][k] += lf[0][k]; lf[2][k] += lf[1][k]; lf[3][k] += lf[2][k];
        const float tot = lf[3][k]; float run = tot;
#pragma unroll
        for (int off = 4; off < 64; off <<= 1) { const float t2 = __shfl_up(run, off); if (lane >= off) run += t2; }
        const float excl = run - tot;
#pragma unroll
        for (int i = 0; i < 4; ++i) lf[i][k] += excl;
        bref[k] = __shfl(lf[3][k], 28 + dg); blast[k] = __shfl(lf[3][k], 60 + dg);
    }
    {
        float eref[4], elast[4];
#pragma unroll
        for (int k = 0; k < 4; ++k) { eref[k] = __expf(bref[k]); elast[k] = __expf(blast[k] - bref[k]); }
        if (tg == 15) *(f32x4*)(DECH + item * 128 + 16 * w + 4 * dg) = (f32x4){__expf(blast[0]), __expf(blast[1]), __expf(blast[2]), __expf(blast[3])};
        float kl[4][4];
#pragma unroll
        for (int i = 0; i < 4; ++i) { float qd[4], kd[4], qb[4];
#pragma unroll
            for (int k = 0; k < 4; ++k) { const float e1 = __expf(lf[i][k] - bref[k]), e2 = __expf(bref[k] - lf[i][k]);
                qd[k] = q[i][k] * e1; kd[k] = kk[i][k] * e2; qb[k] = qd[k] * eref[k]; kl[i][k] = kd[k] * elast[k]; }
            const int off = (4 * tg + i) * P128 + 16 * w + 4 * dg;
            *(LAS u32x2*)(QD + off) = pack4(qd[0], qd[1], qd[2], qd[3]); *(LAS u32x2*)(KD + off) = pack4(kd[0], kd[1], kd[2], kd[3]);
            *(u32x2*)(QBH + (row0 + 4 * tg + i) * 512 + h * 128 + 16 * w + 4 * dg) = pack4(qb[0], qb[1], qb[2], qb[3]); }
#pragma unroll
        for (int k = 0; k < 4; ++k) *(u32x2*)(KLH + item * 8192 + (16 * w + 4 * dg + k) * 64 + 4 * tg) = pack4(kl[0][k], kl[1][k], kl[2][k], kl[3][k]);
    }
    __syncthreads();
    {
        bf16x8 qf[4];
#pragma unroll
        for (int ks = 0; ks < 4; ++ks) qf[ks] = LDFRAG(QD, 16 * tt + r16, P128, ks);
#pragma unroll
        for (int si = 0; si < 2; ++si) { const int st = 2 * vh + si; f32x4 acc = {0.f, 0.f, 0.f, 0.f};
            if (st <= tt) {
#pragma unroll
                for (int ks = 0; ks < 4; ++ks) { const bf16x8 kf = LDFRAG(KD, 16 * st + r16, P128, ks); acc = MFMA16(kf, qf[ks], acc); }
                const int t = 16 * tt + r16, s0 = 16 * st + 4 * quad;
#pragma unroll
                for (int j = 0; j < 4; ++j) acc[j] = (s0 + j <= t) ? acc[j] : 0.f;
            }
            *(u32x2*)(ATH + item * 4096 + (16 * tt + r16) * 64 + 16 * st + 4 * quad) = pack4(acc[0], acc[1], acc[2], acc[3]); }
    }
    __syncthreads();
}
__device__ __forceinline__ void mlstm_pre(const Args& a, int b, int h, int c, LAS unsigned char* lds, int tid, int w, int lane) {
    const bf16_t* projb = (const bf16_t*)(a.ws + WS_PROJ); const float* gates = (const float*)(a.ws + WS_GATES);
    const float* cw = a.in[6]; const float* cb = a.in[7];
    bf16_t* QMM = (bf16_t*)a.out + (size_t)T * 1024; bf16_t* KLM = QMM + (size_t)T * 512; bf16_t* ATM = (bf16_t*)(a.ws + WS_ATM); float* SCM = (float*)(a.ws + WS_SCM);
    LAS bf16_t* QM = (LAS bf16_t*)lds; LAS bf16_t* KM = QM + 64 * P128;
    const int tg = lane >> 2, dg = lane & 3, quad = lane >> 4, r16 = lane & 15, tt = w >> 1, vh = w & 1;
    const size_t item = (size_t)((b * 4 + h) * 64 + c), row0 = (size_t)b * SEQ + c * 64;
    const float mi = gates[(row0 + lane) * 8 + h], mf = gates[(row0 + lane) * 8 + 4 + h];
    float bs = fminf(mf, 0.f) - log1pf(__expf(-fabsf(mf)));
#pragma unroll
    for (int off = 1; off < 64; off <<= 1) { const float t2 = __shfl_up(bs, off); if (lane >= off) bs += t2; }
    const float imb = mi - bs; float pm = imb;
#pragma unroll
    for (int off = 1; off < 64; off <<= 1) { const float t2 = __shfl_up(pm, off); if (lane >= off) pm = fmaxf(pm, t2); }
    const float pm63 = __shfl(pm, 63);
    if (w == 0) { f32x2_nat o2 = {bs, pm}; *(f32x2_nat*)(SCM + (row0 + lane) * 8 + h * 2) = o2; }
    const float aloc = __expf(imb - pm63);
    const bf16_t* pcol = projb + h * 128 + 16 * w + 4 * dg; const int ch = h * 128 + 16 * w + 4 * dg;
    float qv[4][4], kv[4][4];
    {
        float xq[7][4], xk[7][4];
#pragma unroll
        for (int i = 0; i < 7; ++i) { const int tpos = c * 64 + 4 * tg + i - 3;
            if (tpos >= 0) { const bf16_t* p = pcol + ((size_t)b * SEQ + tpos) * NP; unpack4(*(const u32x2*)(p + MQ), xq[i]); unpack4(*(const u32x2*)(p + MK), xk[i]); }
            else {
#pragma unroll
                for (int k = 0; k < 4; ++k) { xq[i][k] = 0.f; xk[i][k] = 0.f; } } }
        f32x4 wq[4], wk[4];
#pragma unroll
        for (int j = 0; j < 4; ++j) { wq[j] = *(const f32x4*)(cw + j * 1024 + ch); wk[j] = *(const f32x4*)(cw + j * 1024 + 512 + ch); }
        const f32x4 bq = *(const f32x4*)(cb + ch), bk = *(const f32x4*)(cb + 512 + ch);
#pragma unroll
        for (int i = 0; i < 4; ++i)
#pragma unroll
            for (int k = 0; k < 4; ++k) { float aq = bq[k], ak = bk[k];
#pragma unroll
                for (int j = 0; j < 4; ++j) { aq += xq[i + j][k] * wq[j][k]; ak += xk[i + j][k] * wk[j][k]; }
                qv[i][k] = aq * sigm(aq) * 0.08838834764831845f; kv[i][k] = ak * sigm(ak); }
    }
    {
        float ae[4];
#pragma unroll
        for (int i = 0; i < 4; ++i) ae[i] = __shfl(aloc, 4 * tg + i);
#pragma unroll
        for (int i = 0; i < 4; ++i) { const int off = (4 * tg + i) * P128 + 16 * w + 4 * dg; const u32x2 qp = pack4(qv[i][0], qv[i][1], qv[i][2], qv[i][3]);
            *(LAS u32x2*)(QM + off) = qp; *(LAS u32x2*)(KM + off) = pack4(kv[i][0], kv[i][1], kv[i][2], kv[i][3]);
            *(u32x2*)(QMM + (row0 + 4 * tg + i) * 512 + h * 128 + 16 * w + 4 * dg) = qp; }
#pragma unroll
        for (int k = 0; k < 4; ++k) *(u32x2*)(KLM + item * 8192 + (16 * w + 4 * dg + k) * 64 + 4 * tg) = pack4(kv[0][k] * ae[0], kv[1][k] * ae[1], kv[2][k] * ae[2], kv[3][k] * ae[3]);
    }
    __syncthreads();
    {
        bf16x8 qf[4];
#pragma unroll
        for (int ks = 0; ks < 4; ++ks) qf[ks] = LDFRAG(QM, 16 * tt + r16, P128, ks);
        const float pmt = __shfl(pm, 16 * tt + r16);
#pragma unroll
        for (int si = 0; si < 2; ++si) { const int st = 2 * vh + si; f32x4 acc = {0.f, 0.f, 0.f, 0.f};
            if (st <= tt) {
#pragma unroll
                for (int ks = 0; ks < 4; ++ks) { const bf16x8 kf = LDFRAG(KM, 16 * st + r16, P128, ks); acc = MFMA16(kf, qf[ks], acc); }
                const int t = 16 * tt + r16, s0 = 16 * st + 4 * quad;
#pragma unroll
                for (int j = 0; j < 4; ++j) { const float ims = __shfl(imb, s0 + j); acc[j] = (s0 + j <= t) ? acc[j] * __expf(ims - pmt) : 0.f; }
            }
            *(u32x2*)(ATM + item * 4096 + (16 * tt + r16) * 64 + 16 * st + 4 * quad) = pack4(acc[0], acc[1], acc[2], acc[3]); }
    }
    __syncthreads();
}
template <int KIND> __device__ __forceinline__ void scan_loop(const Args& a, int b, int h, LAS unsigned char* lds, int tid, int w, int lane, unsigned* bar, unsigned xcc, unsigned nxb, unsigned nx, unsigned& bround) {
    constexpr int NV = KIND ? 144 : 128, NVT = NV / 16;
    const bf16_t* projb = (const bf16_t*)(a.ws + WS_PROJ); bf16_t* y = (bf16_t*)(a.ws + WS_Y);
    const bf16_t* QBG = KIND ? (const bf16_t*)a.out + (size_t)T * 1024 : (const bf16_t*)a.out; const bf16_t* KLG = QBG + (size_t)T * 512;
    const bf16_t* ATG = (const bf16_t*)(a.ws + (KIND ? WS_ATM : WS_ATH)); const float* DECH = (const float*)(a.ws + WS_DECH); const float* SCM = (const float*)(a.ws + WS_SCM);
    const float* nw = KIND ? a.in[8] : a.in[5];
    LAS bf16_t* QB = (LAS bf16_t*)lds; LAS bf16_t* ATT = QB + 64 * P128; LAS bf16_t* KLT = ATT + 64 * P64; LAS bf16_t* VT = KLT + 128 * P64; LAS bf16_t* ST = VT + NV * P64;
    LAS float* NRM = (LAS float*)(ST + NV * P128); LAS float* NWL = NRM + 256;
    const int tg = lane >> 2, dg = lane & 3, quad = lane >> 4, r16 = lane & 15, tt = w >> 1, vh = w & 1;
    for (int e = tid; e < NV * P128 / 2; e += 512) ((LAS unsigned*)ST)[e] = 0u;
    if (KIND) for (int e = tid; e < 16 * P64 / 2; e += 512) ((LAS unsigned*)(VT + 128 * P64))[e] = (e < P64 / 2) ? 0x3F803F80u : 0u;
    if (tid < 128) NWL[tid] = nw[h * 128 + tid];
    f32x4 Sacc[10];
#pragma unroll
    for (int i = 0; i < 10; ++i) Sacc[i] = (f32x4){0.f, 0.f, 0.f, 0.f};
    float m_st = -1e30f;
    const size_t rowbase = (size_t)b * SEQ, item0 = (size_t)(b * 4 + h) * 64;
    const bf16_t* pv = projb + (KIND ? MV : HI) + h * 128 + 16 * w + 4 * dg;
    const bf16_t* pgat = projb + (KIND ? MO : HG) + h * 128 + 64 * vh + 4 * quad;
    struct PSet { u32x4n rqb[2], rat, rkl[2]; f32x4 rdec, rdec2; f32x2_nat rsc; }; u32x2 rv[4];
    PSet SA, SB; SA.rdec = SB.rdec = SA.rdec2 = SB.rdec2 = (f32x4){1.f, 1.f, 1.f, 1.f}; SA.rsc = SB.rsc = (f32x2_nat){0.f, 0.f};
#define SCAN_LOAD(P_, cc) do { const size_t rb_ = rowbase + (size_t)(cc) * 64, it_ = item0 + (cc); \
        _Pragma("unroll") for (int i = 0; i < 2; ++i) { const int e = tid + 512 * i; P_.rqb[i] = *(const u32x4n*)(QBG + (rb_ + (e >> 4)) * 512 + h * 128 + (e & 15) * 8); P_.rkl[i] = *(const u32x4n*)(KLG + it_ * 8192 + (size_t)e * 8); } \
        P_.rat = *(const u32x4n*)(ATG + it_ * 4096 + (size_t)tid * 8); \
        if (KIND) P_.rsc = *(const f32x2_nat*)(SCM + (rb_ + lane) * 8 + h * 2); else { P_.rdec = *(const f32x4*)(DECH + it_ * 128 + 32 * tt + 4 * quad); P_.rdec2 = *(const f32x4*)(DECH + it_ * 128 + 32 * tt + 16 + 4 * quad); } } while (0)
    SCAN_LOAD(SA, 0); SCAN_LOAD(SB, 1);
#pragma unroll
    for (int i = 0; i < 4; ++i) rv[i] = *(const u32x2*)(pv + (rowbase + 4 * tg + i) * NP);
    __syncthreads();
#define SCAN_STEP(P_, c) do { \
        u32x2 rgc[4]; f32x4 dec = P_.rdec, dec2 = P_.rdec2; float rt_ = 1.f, wi_ = 0.f, mt_ = 0.f, decay = 1.f, scU = 1.f, m_new = 0.f; \
_Pragma("unroll") \
        for (int i = 0; i < 2; ++i) { const int e = tid + 512 * i; *(LAS u32x4n*)(QB + (e >> 4) * P128 + (e & 15) * 8) = P_.rqb[i]; *(LAS u32x4n*)(KLT + (e >> 3) * P64 + (e & 7) * 8) = P_.rkl[i]; } \
        *(LAS u32x4n*)(ATT + (tid >> 3) * P64 + (tid & 7) * 8) = P_.rat; \
        { float vv[4][4]; \
_Pragma("unroll") \
            for (int i = 0; i < 4; ++i) unpack4(rv[i], vv[i]); \
_Pragma("unroll") \
            for (int k = 0; k < 4; ++k) *(LAS u32x2*)(VT + (16 * w + 4 * dg + k) * P64 + 4 * tg) = pack4(vv[0][k], vv[1][k], vv[2][k], vv[3][k]); } \
        if (KIND) {                                                    \
            const float bs = P_.rsc[0], pm = P_.rsc[1]; const float g = __shfl(bs, 63), amax = g + __shfl(pm, 63); \
            const float inter = bs + m_st, m_t = fmaxf(inter, pm + bs); \
            const float wi = __expf(inter - m_t), rr = __expf(bs + pm - m_t); \
            m_new = fmaxf(g + m_st, amax); decay = __expf(g + m_st - m_new); scU = __expf(amax - m_new); \
            rt_ = __shfl(rr, 16 * tt + r16); wi_ = __shfl(wi, 16 * tt + r16); mt_ = __shfl(m_t, 16 * tt + r16); \
        } \
        __syncthreads(); \
        if ((((c) & 15) == 14) && (c) < 62) grid_bar(bar, xcc, nxb, nx, ++bround);     \
        { const int cn = ((c) + 2 < 64) ? (c) + 2 : 63; SCAN_LOAD(P_, cn); { const int c1 = ((c) + 1 < 64) ? (c) + 1 : 63; _Pragma("unroll") for (int i = 0; i < 4; ++i) rv[i] = *(const u32x2*)(pv + (rowbase + (size_t)c1 * 64 + 4 * tg + i) * NP); } _Pragma("unroll") for (int vt = 0; vt < 4; ++vt) rgc[vt] = *(const u32x2*)(pgat + (rowbase + (size_t)(c) * 64 + 16 * tt + r16) * NP + 16 * vt); } \
        f32x4 o[4]; \
        { \
            bf16x8 af[2], qbf[4]; \
_Pragma("unroll") \
            for (int ks = 0; ks < 2; ++ks) af[ks] = LDFRAG(ATT, 16 * tt + r16, P64, ks); \
_Pragma("unroll") \
            for (int ks = 0; ks < 4; ++ks) qbf[ks] = LDFRAG(QB, 16 * tt + r16, P128, ks); \
            float dn = 1.f; \
            if (KIND) { f32x4 a1 = {0.f, 0.f, 0.f, 0.f}, a2 = {0.f, 0.f, 0.f, 0.f}; \
_Pragma("unroll") \
                for (int ks = 0; ks < 2; ++ks) a1 = MFMA16(LDFRAG(VT, 128 + r16, P64, ks), af[ks], a1); \
_Pragma("unroll") \
                for (int ks = 0; ks < 4; ++ks) a2 = MFMA16(LDFRAG(ST, 128 + r16, P128, ks), qbf[ks], a2); \
                const float dl = rt_ * a1[0] + wi_ * a2[0]; const float den = __shfl(dl, r16); \
                dn = __builtin_amdgcn_rcpf(fmaxf(fabsf(den), __expf(-mt_))); } \
            float s1 = 0.f, s2 = 0.f; \
_Pragma("unroll") \
            for (int vt = 0; vt < 4; ++vt) { const int v0 = 64 * vh + 16 * vt; f32x4 a1 = {0.f, 0.f, 0.f, 0.f}, a2 = {0.f, 0.f, 0.f, 0.f}; \
_Pragma("unroll") \
                for (int ks = 0; ks < 2; ++ks) a1 = MFMA16(LDFRAG(VT, v0 + r16, P64, ks), af[ks], a1); \
_Pragma("unroll") \
                for (int ks = 0; ks < 4; ++ks) a2 = MFMA16(LDFRAG(ST, v0 + r16, P128, ks), qbf[ks], a2); \
                f32x4 acc = KIND ? (a1 * rt_ + a2 * wi_) * dn : (a1 + a2); \
                o[vt] = acc; s1 += (acc[0] + acc[1]) + (acc[2] + acc[3]); s2 += (acc[0] * acc[0] + acc[1] * acc[1]) + (acc[2] * acc[2] + acc[3] * acc[3]); } \
            s1 += __shfl_xor(s1, 16); s1 += __shfl_xor(s1, 32); s2 += __shfl_xor(s2, 16); s2 += __shfl_xor(s2, 32); \
            if (quad == 0) { NRM[(16 * tt + r16) * 4 + 2 * vh] = s1; NRM[(16 * tt + r16) * 4 + 2 * vh + 1] = s2; } \
            bf16x8 klf[2][2]; \
_Pragma("unroll") \
            for (int dt2 = 0; dt2 < 2; ++dt2) { _Pragma("unroll") for (int ks = 0; ks < 2; ++ks) klf[dt2][ks] = LDFRAG(KLT, 32 * tt + 16 * dt2 + r16, P64, ks); } \
_Pragma("unroll") \
            for (int vt = 0; vt < 4; ++vt) { bf16x8 vf[2]; \
_Pragma("unroll") \
                for (int ks = 0; ks < 2; ++ks) vf[ks] = LDFRAG(VT, 64 * vh + 16 * vt + r16, P64, ks); \
_Pragma("unroll") \
                for (int dt2 = 0; dt2 < 2; ++dt2) { f32x4 u = {0.f, 0.f, 0.f, 0.f}; \
_Pragma("unroll") \
                    for (int ks = 0; ks < 2; ++ks) u = MFMA16(klf[dt2][ks], vf[ks], u); \
                    if (KIND) Sacc[dt2 * 4 + vt] = Sacc[dt2 * 4 + vt] * decay + u * scU; else Sacc[dt2 * 4 + vt] = Sacc[dt2 * 4 + vt] * (dt2 ? dec2 : dec) + u; } } \
            if (KIND && vh == 0) { bf16x8 vf[2]; \
_Pragma("unroll") \
                for (int ks = 0; ks < 2; ++ks) vf[ks] = LDFRAG(VT, 128 + r16, P64, ks); \
_Pragma("unroll") \
                for (int dt2 = 0; dt2 < 2; ++dt2) { f32x4 u = {0.f, 0.f, 0.f, 0.f}; \
_Pragma("unroll") \
                    for (int ks = 0; ks < 2; ++ks) u = MFMA16(klf[dt2][ks], vf[ks], u); \
                    Sacc[8 + dt2] = Sacc[8 + dt2] * decay + u * scU; } } \
        } \
        __syncthreads(); \
_Pragma("unroll") \
        for (int dt2 = 0; dt2 < 2; ++dt2) { \
_Pragma("unroll") \
            for (int vt = 0; vt < 4; ++vt) *(LAS u32x2*)(ST + (64 * vh + 16 * vt + r16) * P128 + 32 * tt + 16 * dt2 + 4 * quad) = pack4(Sacc[dt2 * 4 + vt][0], Sacc[dt2 * 4 + vt][1], Sacc[dt2 * 4 + vt][2], Sacc[dt2 * 4 + vt][3]); \
            if (KIND && vh == 0) *(LAS u32x2*)(ST + (128 + r16) * P128 + 32 * tt + 16 * dt2 + 4 * quad) = pack4(Sacc[8 + dt2][0], Sacc[8 + dt2][1], Sacc[8 + dt2][2], Sacc[8 + dt2][3]); } \
        { \
            const int t = 16 * tt + r16; const f32x4 nr = *(const LAS f32x4*)(NRM + t * 4); \
            const float mean = KIND ? (nr[0] + nr[2]) * (1.f / 128.f) : 0.f; const float var = fmaxf((nr[1] + nr[3]) * (1.f / 128.f) - mean * mean, 0.f); \
            const float rstd = __builtin_amdgcn_rsqf(var + LN_EPS); \
            bf16_t* yp = y + (rowbase + (c) * 64 + t) * D + (KIND ? 512 : 0) + h * 128 + 64 * vh + 4 * quad; \
_Pragma("unroll") \
            for (int vt = 0; vt < 4; ++vt) { float r[4], gt[4]; unpack4(rgc[vt], gt); const f32x4 nv = *(const LAS f32x4*)(NWL + 64 * vh + 16 * vt + 4 * quad); \
_Pragma("unroll") \
                for (int j = 0; j < 4; ++j) r[j] = gt[j] * (o[vt][j] - mean) * rstd * nv[j]; \
                *(u32x2*)(yp + 16 * vt) = pack4(r[0], r[1], r[2], r[3]); } \
        } \
        if (KIND) m_st = m_new; \
    } while (0)
    for (int c2 = 0; c2 < 64; c2 += 2) { SCAN_STEP(SA, c2); SCAN_STEP(SB, c2 + 1); }
#undef SCAN_STEP
#undef SCAN_LOAD
    __syncthreads();
}

__device__ __forceinline__ void ln_rows(const float* r, const float* gam, const float* bet, float* xo, bf16_t* xbo, int lane, int gw, int NGW) {
    const f32x4 *gp = (const f32x4*)gam + lane, *bp = (const f32x4*)bet + lane;
    for (int m = gw; m < T; m += 2 * NGW) {
        f32x4 v[2][4]; float s[2] = {0.f, 0.f};
#pragma unroll
        for (int q = 0; q < 2; ++q) { const f32x4* xr = (const f32x4*)(r + (size_t)(m + q * NGW) * D) + lane;
#pragma unroll
            for (int j = 0; j < 4; ++j) v[q][j] = xr[64 * j]; }
#pragma unroll
        for (int q = 0; q < 2; ++q)
#pragma unroll
            for (int j = 0; j < 4; ++j) s[q] += (v[q][j][0] + v[q][j][1]) + (v[q][j][2] + v[q][j][3]);
#pragma unroll
        for (int q = 0; q < 2; ++q) { const float mean = wave_sum(s[q]) * (1.f / D); float s2 = 0.f;
#pragma unroll
            for (int j = 0; j < 4; ++j) { v[q][j] = v[q][j] - mean; s2 += (v[q][j][0] * v[q][j][0] + v[q][j][1] * v[q][j][1]) + (v[q][j][2] * v[q][j][2] + v[q][j][3] * v[q][j][3]); }
            const float rstd = __builtin_amdgcn_rsqf(wave_sum(s2) * (1.f / D) + LN_EPS); const size_t mm = (size_t)(m + q * NGW);
#pragma unroll
            for (int j = 0; j < 4; ++j) { const f32x4 o = v[q][j] * rstd * gp[64 * j] + bp[64 * j];
                if (xo) ((f32x4*)(xo + mm * D) + lane)[64 * j] = o;
                if (xbo) { uint2 w; w.x = pk2(o[0], o[1]); w.y = pk2(o[2], o[3]); ((uint2*)(xbo + mm * D) + lane)[64 * j] = w; } } }
    }
}

__device__ __forceinline__ void ln_rows16(const bf16_t* r, const float* gam, const float* bet, float* xo, bf16_t* xbo, int lane, int gw, int NGW) {
    for (int m = gw; m < T; m += 2 * NGW) {
        float v[2][16]; float s[2] = {0.f, 0.f};
#pragma unroll
        for (int q = 0; q < 2; ++q) { const int mq = (m + q * NGW < T) ? m + q * NGW : m; const u32x4n* xr = (const u32x4n*)(r + (size_t)mq * D) + lane;
#pragma unroll
            for (int j = 0; j < 2; ++j) { const u32x4n w = xr[64 * j]; const unsigned ww[4] = {w.x, w.y, w.z, w.w};
#pragma unroll
                for (int i = 0; i < 4; ++i) { v[q][8 * j + 2 * i] = bflo(ww[i]); v[q][8 * j + 2 * i + 1] = bfhi(ww[i]); } } }
#pragma unroll
        for (int q = 0; q < 2; ++q)
#pragma unroll
            for (int i = 0; i < 16; ++i) s[q] += v[q][i];
#pragma unroll
        for (int q = 0; q < 2; ++q) { const float mean = wave_sum(s[q]) * (1.f / D); float s2 = 0.f;
#pragma unroll
            for (int i = 0; i < 16; ++i) { v[q][i] -= mean; s2 += v[q][i] * v[q][i]; }
            const float rstd = __builtin_amdgcn_rsqf(wave_sum(s2) * (1.f / D) + LN_EPS); const size_t mm = (size_t)(m + q * NGW); if (m + q * NGW >= T) continue;
#pragma unroll
            for (int j = 0; j < 2; ++j) { const int e0 = 8 * (lane + 64 * j); const f32x4 g0 = *(const f32x4*)(gam + e0), g1 = *(const f32x4*)(gam + e0 + 4), b0 = *(const f32x4*)(bet + e0), b1 = *(const f32x4*)(bet + e0 + 4);
                float o[8];
#pragma unroll
                for (int i = 0; i < 4; ++i) { o[i] = v[q][8 * j + i] * rstd * g0[i] + b0[i]; o[4 + i] = v[q][8 * j + 4 + i] * rstd * g1[i] + b1[i]; }
                if (xo) { *(f32x4*)(xo + mm * D + e0) = (f32x4){o[0], o[1], o[2], o[3]}; *(f32x4*)(xo + mm * D + e0 + 4) = (f32x4){o[4], o[5], o[6], o[7]}; }
                if (xbo) { u32x4n w; w.x = pk2(o[0], o[1]); w.y = pk2(o[2], o[3]); w.z = pk2(o[4], o[5]); w.w = pk2(o[6], o[7]); *(u32x4n*)(xbo + mm * D + e0) = w; } } }
    }
}

__device__ __forceinline__ void attn_phase(const bf16_t* qb, const bf16_t* kb, const bf16_t* vT, bf16_t* ao, LAS unsigned char* lds, int wave, int lane, int blk, int G) {
    LAS bf16_t* P = (LAS bf16_t*)(lds + wave * 8448);
    const int r16 = lane & 15, quad = lane >> 4;
    for (int bi = blk; bi < (T / 128) * 4; bi += G) {
        const int h = bi & 3, r0 = (bi >> 2) * 128 + wave * 16, b = r0 / SEQ;
        bf16x8 qa[8];
        const bf16_t* qp = qb + (size_t)(r0 + r16) * D + h * 256 + quad * 8;
#pragma unroll
        for (int ks = 0; ks < 8; ++ks) qa[ks] = *(const bf16x8*)(qp + ks * 32);
        f32x4 s[16];
        const bf16_t* kp = kb + (size_t)(b * 256 + r16) * D + h * 256 + quad * 8;
#pragma unroll
        for (int nt = 0; nt < 16; ++nt) { f32x4 acc = {0.f, 0.f, 0.f, 0.f};
#pragma unroll
            for (int ks = 0; ks < 8; ++ks) { const bf16x8 bfr = *(const bf16x8*)(kp + (size_t)nt * 16 * D + ks * 32); acc = __builtin_amdgcn_mfma_f32_16x16x32_bf16(qa[ks], bfr, acc, 0, 0, 0); }
            s[nt] = acc; }
        float sm[4];
#pragma unroll
        for (int j = 0; j < 4; ++j) { float mx = s[0][j];
#pragma unroll
            for (int nt = 1; nt < 16; ++nt) mx = fmaxf(mx, s[nt][j]);
            mx = fmaxf(mx, __shfl_xor(mx, 1)); mx = fmaxf(mx, __shfl_xor(mx, 2)); mx = fmaxf(mx, __shfl_xor(mx, 4)); mx = fmaxf(mx, __shfl_xor(mx, 8));
            float sum = 0.f;
#pragma unroll
            for (int nt = 0; nt < 16; ++nt) { const float p = __expf((s[nt][j] - mx) * 0.0625f); sum += p; P[(quad * 4 + j) * 264 + nt * 16 + r16] = f2bf(p); }
            sum += __shfl_xor(sum, 1); sum += __shfl_xor(sum, 2); sum += __shfl_xor(sum, 4); sum += __shfl_xor(sum, 8);
            sm[j] = 1.f / sum; }
        WAVE_LDS_SYNC();
        bf16x8 pa[8];
#pragma unroll
        for (int ks = 0; ks < 8; ++ks) pa[ks] = *(const LAS bf16x8*)(P + r16 * 264 + ks * 32 + quad * 8);
        WAVE_LDS_SYNC();
        const bf16_t* vp = vT + (size_t)(h * 256 + r16) * NMEMR + b * 256 + quad * 8;
        bf16_t* op = ao + (size_t)(r0 + quad * 4) * D + h * 256 + r16;
#pragma unroll
        for (int nt = 0; nt < 16; ++nt) { f32x4 acc = {0.f, 0.f, 0.f, 0.f};
#pragma unroll
            for (int ks = 0; ks < 8; ++ks) { const bf16x8 bfr = *(const bf16x8*)(vp + (size_t)nt * 16 * NMEMR + ks * 32); acc = __builtin_amdgcn_mfma_f32_16x16x32_bf16(pa[ks], bfr, acc, 0, 0, 0); }
#pragma unroll
            for (int j = 0; j < 4; ++j) op[(size_t)j * D + nt * 16] = f2bf(acc[j] * sm[j]); }
    }
}


__device__ __forceinline__ void attn_phase2(const bf16_t* qb, const bf16_t* kb, const bf16_t* vT, bf16_t* ao, LAS unsigned char* lds, int tid, int wave, int lane, int blk, int G) {
    constexpr int PKV = 264;
    LAS bf16_t* KV = (LAS bf16_t*)lds;
    const int r16 = lane & 15, quad = lane >> 4;
    for (int bi = blk; bi < (T / 128) * 4; bi += G) {
        const int h = bi & 3, chunk = bi >> 2, r0 = chunk * 128 + wave * 16, b = chunk >> 5;
        { const bf16_t* sp = kb + (size_t)(b * 256 + (tid >> 5)) * D + h * 256 + (tid & 31) * 8; LAS bf16_t* dp = KV + (tid >> 5) * PKV + (tid & 31) * 8;
#pragma unroll 1
            for (int q4 = 0; q4 < 4; ++q4) { u32x4n v[4];
#pragma unroll
                for (int i = 0; i < 4; ++i) v[i] = *(const u32x4n*)(sp + (size_t)(16 * i) * D);
#pragma unroll
                for (int i = 0; i < 4; ++i) *(LAS u32x4n*)(dp + (16 * i) * PKV) = v[i];
                sp += (size_t)64 * D; dp += 64 * PKV; } }
        bf16x8 qf[8];
        { const bf16_t* qp = qb + (size_t)(r0 + r16) * D + h * 256 + quad * 8;
#pragma unroll
            for (int ks = 0; ks < 8; ++ks) qf[ks] = *(const bf16x8*)(qp + ks * 32); }
        __syncthreads();
        f32x4 sc[16];
#pragma unroll
        for (int nt = 0; nt < 16; ++nt) { f32x4 acc = {0.f, 0.f, 0.f, 0.f};
#pragma unroll
            for (int ks = 0; ks < 8; ++ks) acc = MFMA16(LDFRAG(KV, nt * 16 + r16, PKV, ks), qf[ks], acc);
            sc[nt] = acc; }
        float mx = sc[0][0];
#pragma unroll
        for (int nt = 0; nt < 16; ++nt)
#pragma unroll
            for (int j = 0; j < 4; ++j) mx = fmaxf(mx, sc[nt][j]);
        mx = fmaxf(mx, __shfl_xor(mx, 16)); mx = fmaxf(mx, __shfl_xor(mx, 32));
        float sum = 0.f;
#pragma unroll
        for (int nt = 0; nt < 16; ++nt)
#pragma unroll
            for (int j = 0; j < 4; ++j) { const float pv = __expf((sc[nt][j] - mx) * 0.0625f); sc[nt][j] = pv; sum += pv; }
        sum += __shfl_xor(sum, 16); sum += __shfl_xor(sum, 32);
        const float inv = __builtin_amdgcn_rcpf(sum);
        bf16x8 pf[8];
#pragma unroll
        for (int k2 = 0; k2 < 8; ++k2) { u32x4n w; w.x = pk2(sc[2 * k2][0], sc[2 * k2][1]); w.y = pk2(sc[2 * k2][2], sc[2 * k2][3]); w.z = pk2(sc[2 * k2 + 1][0], sc[2 * k2 + 1][1]); w.w = pk2(sc[2 * k2 + 1][2], sc[2 * k2 + 1][3]);
            pf[k2] = __builtin_bit_cast(bf16x8, w); }
        __syncthreads();
        { const bf16_t* sp = vT + (size_t)(h * 256 + (tid >> 5)) * NMEMR + b * 256 + (tid & 31) * 8; LAS bf16_t* dp = KV + (tid >> 5) * PKV + (tid & 31) * 8;
#pragma unroll 1
            for (int q4 = 0; q4 < 4; ++q4) { u32x4n v[4];
#pragma unroll
                for (int i = 0; i < 4; ++i) v[i] = *(const u32x4n*)(sp + (size_t)(16 * i) * NMEMR);
#pragma unroll
                for (int i = 0; i < 4; ++i) *(LAS u32x4n*)(dp + (16 * i) * PKV) = v[i];
                sp += (size_t)64 * NMEMR; dp += 64 * PKV; } }
        __syncthreads();
        bf16_t* op = ao + (size_t)(r0 + r16) * D + h * 256 + 4 * quad;
#pragma unroll
        for (int dt = 0; dt < 16; ++dt) { f32x4 acc = {0.f, 0.f, 0.f, 0.f};
#pragma unroll
            for (int k2 = 0; k2 < 8; ++k2) { const LAS bf16_t* vp = KV + (dt * 16 + r16) * PKV + 32 * k2 + 4 * quad;
                const u32x2 lo = *(const LAS u32x2*)vp, hi = *(const LAS u32x2*)(vp + 16);
                const u32x4n av = {lo.x, lo.y, hi.x, hi.y};
                acc = MFMA16(__builtin_bit_cast(bf16x8, av), pf[k2], acc); }
            *(u32x2*)(op + dt * 16) = pack4(acc[0] * inv, acc[1] * inv, acc[2] * inv, acc[3] * inv); }
        __syncthreads();
    }
}

__device__ __forceinline__ void conv_phase(const bf16_t* ub, const float* cw, const float* cb, bf16_t* hb, int half, int gtid, int NT) {
    for (int item = gtid; item < TH * 352; item += NT) {
        const int tl = item / 352, c8 = item - tl * 352, n0 = c8 * 8, t = half * TH + tl, tpos = t & (SEQ - 1);
        float ga[8], va[8];
#pragma unroll
        for (int i = 0; i < 8; ++i) { ga[i] = cb[n0 + i]; va[i] = cb[DFF + n0 + i]; }
#pragma unroll
        for (int j = 0; j < 3; ++j) { if (tpos - 2 + j >= 0) { const bf16_t* p = ub + (size_t)(tl - 2 + j) * NUP + n0;
            const uint4 gq = *(const uint4*)p, vq = *(const uint4*)(p + DFF); const unsigned gw4[4] = {gq.x, gq.y, gq.z, gq.w}, vw4[4] = {vq.x, vq.y, vq.z, vq.w};
            const float* wg = cw + (size_t)j * NUP + n0; const float* wv = wg + DFF;
#pragma unroll
            for (int i = 0; i < 4; ++i) { ga[2 * i] += bflo(gw4[i]) * wg[2 * i]; ga[2 * i + 1] += bfhi(gw4[i]) * wg[2 * i + 1]; va[2 * i] += bflo(vw4[i]) * wv[2 * i]; va[2 * i + 1] += bfhi(vw4[i]) * wv[2 * i + 1]; } } }
        uint4 o; o.x = pk2(gelu_tanh(ga[0]) * va[0], gelu_tanh(ga[1]) * va[1]); o.y = pk2(gelu_tanh(ga[2]) * va[2], gelu_tanh(ga[3]) * va[3]);
        o.z = pk2(gelu_tanh(ga[4]) * va[4], gelu_tanh(ga[5]) * va[5]); o.w = pk2(gelu_tanh(ga[6]) * va[6], gelu_tanh(ga[7]) * va[7]);
        *(uint4*)(hb + (size_t)t * DFF + n0) = o;
    }
}

template <class Epi> __device__ __forceinline__ void run_gemm(LAS unsigned char* lds, const bf16_t* A, const bf16_t* Bt, int M, int N, int K, const Epi& E) {
    pg8::Gemm g{A, Bt, M, N, K}; pg8::StaticOrder S; S.init(M, N, (int)gridDim.x, (int)blockIdx.x);
    pg8::gemm_phase<Epi, pg8::StaticOrder, false>(lds, g, S, E, nullptr);
}
__global__ void __launch_bounds__(512, 2) fwd_megakernel(Args a) {
    extern __shared__ __attribute__((aligned(16))) unsigned char shm[];
    LAS unsigned char* lds = (LAS unsigned char*)shm;
    const int tid = threadIdx.x, lane = tid & 63, wave = __builtin_amdgcn_readfirstlane(tid >> 6);
    const int G = gridDim.x, blk = blockIdx.x, gw = blk * 8 + wave, NGW = G * 8;
    unsigned char* ws = a.ws;
    const int lo = a.ph_lo, hi = a.ph_hi;
#if N_LAUNCH_MODE == 0
    cg::grid_group grid = cg::this_grid();
    unsigned* const bar = (unsigned*)(ws + WS_BAR); const unsigned xcc = xcc_id(); unsigned nxb = 0, nx = 0, bround = 0;
    if (tid == 0) { __hip_atomic_fetch_add(bar + 64 * (17 + xcc), 1u, __ATOMIC_RELAXED, __HIP_MEMORY_SCOPE_AGENT); __hip_atomic_fetch_add(bar + 64 * 33, 1u, __ATOMIC_RELAXED, __HIP_MEMORY_SCOPE_AGENT);
        while (__hip_atomic_load(bar + 64 * 33, __ATOMIC_RELAXED, __HIP_MEMORY_SCOPE_AGENT) < (unsigned)G) __builtin_amdgcn_s_sleep(1); }
    __syncthreads();
    nxb = __hip_atomic_load(bar + 64 * (17 + xcc), __ATOMIC_RELAXED, __HIP_MEMORY_SCOPE_AGENT);
    for (int x_ = 0; x_ < 16; ++x_) nx += (__hip_atomic_load(bar + 64 * (17 + x_), __ATOMIC_RELAXED, __HIP_MEMORY_SCOPE_AGENT) != 0u) ? 1u : 0u;
    if (a.ph_hi < 0) grid.sync();
#define SEAM(k) do { if (lo <= (k) && (k) + 1 < hi) grid_bar(bar, xcc, nxb, nx, ++bround); } while (0)
#define SEAM2() do { if (hi - lo > 1) grid_bar(bar, xcc, nxb, nx, ++bround); } while (0)
#else
#define SEAM(k) do { } while (0)
#define SEAM2() do { } while (0)
#endif
#define IN(k) (lo <= (k) && (k) < hi)
    bf16_t* xb = (bf16_t*)(ws + WS_XB); bf16_t* projb = (bf16_t*)(ws + WS_PROJ);
    float* x1 = (float*)(ws + WS_X1); bf16_t* x1b = (bf16_t*)(ws + WS_X1B); bf16_t* qb = (bf16_t*)(ws + WS_QB); bf16_t* x2b = (bf16_t*)(ws + WS_X1B); bf16_t* r16b = (bf16_t*)(ws + WS_X1)  ; bf16_t* r3b = (bf16_t*)(ws + WS_XB)  ;
    bf16_t* kb = (bf16_t*)(ws + WS_KB); bf16_t* vT = (bf16_t*)(ws + WS_VT); bf16_t* memb = (bf16_t*)(ws + WS_MEMB);
    bf16_t* ub = (bf16_t*)(ws + WS_UB); bf16_t* hb = (bf16_t*)(ws + WS_HB);

    if (IN(0)) { p0_prep(a, lds, tid, wave, lane, gw, NGW); __syncthreads(); SEAM(0); }
    if (IN(1)) {
        run_gemm(lds, xb, (const bf16_t*)(ws + WS_WIN), T, NP, D, pg8::EpiB16{projb, NP, a.in[3], 0x00C3u, 0xC000u});
        __syncthreads(); SEAM(1); }
    if (IN(2)) {
        for (int it = blk; it < 1024; it += G) { const int kind = it >> 9, bh = (it >> 4) & 31, c = it & 15;
            if (kind == 0) hgrn2_pre(a, bh >> 2, bh & 3, c, lds, tid, wave, lane); else mlstm_pre(a, bh >> 2, bh & 3, c, lds, tid, wave, lane); }
        __syncthreads(); SEAM(2); }
    if (IN(3)) {
        if (blk < 32) scan_loop<0>(a, (blk >> 2) & 7, blk & 3, lds, tid, wave, lane, bar, xcc, nxb, nx, bround);
        else if (blk < 64) scan_loop<1>(a, (blk >> 2) & 7, blk & 3, lds, tid, wave, lane, bar, xcc, nxb, nx, bround);
        else {
            for (int sl = 1; sl < 4; ++sl) {
                for (int it = blk - 64; it < 1024; it += G - 64) { const int kind = it >> 9, bh = (it >> 4) & 31, c = 16 * sl + (it & 15);
                    if (kind == 0) hgrn2_pre(a, bh >> 2, bh & 3, c, lds, tid, wave, lane); else mlstm_pre(a, bh >> 2, bh & 3, c, lds, tid, wave, lane); }
                __syncthreads(); grid_bar(bar, xcc, nxb, nx, ++bround); }
            late_prep(a, lds, wave, lane, (blk - 64) * 8 + wave, (G - 64) * 8); __syncthreads();
            { pg8::Gemm g{memb, (const bf16_t*)(ws + WS_WKV), NMEMR, D, D}; pg8::StaticOrder S; S.init(NMEMR, D, G - 64, blk - 64); pg8::gemm_phase<pg8::EpiB16, pg8::StaticOrder, false>(lds, g, S, pg8::EpiB16{kb, D, nullptr, 0u, 0u}, nullptr); }
            { pg8::Gemm g{(const bf16_t*)(ws + WS_WKV) + (size_t)D * D, memb, D, NMEMR, D}; pg8::StaticOrder S; S.init(D, NMEMR, G - 64, blk - 64); pg8::gemm_phase<pg8::EpiB16, pg8::StaticOrder, false>(lds, g, S, pg8::EpiB16{vT, NMEMR, nullptr, 0u, 0u}, nullptr); }
        }
        __syncthreads();
        SEAM(3); }
    if (IN(4)) { run_gemm(lds, (const bf16_t*)(ws + WS_Y), (const bf16_t*)(ws + WS_WOUT), T, D, D, pg8::EpiResO16<false>{a.in[0], r16b, D, ALPHA, (float*)(ws + WS_ST1)}); __syncthreads(); SEAM(4); }
    if (IN(6)) { run_gemm(lds, r16b, (const bf16_t*)(ws + WS_WQ), T, D, D, pg8::EpiLNq{qb, D, (const float*)(ws + WS_ST1), (const float*)(ws + WS_CV), (const float*)(ws + WS_CV) + 1024}); __syncthreads(); SEAM(6); }
    if (IN(7)) { attn_phase2(qb, kb, vT, xb  , lds, tid, wave, lane, blk, G); __syncthreads(); SEAM(7); }
    if (IN(8)) { run_gemm(lds, xb  , (const bf16_t*)(ws + WS_WO), T, D, D, pg8::EpiResLN{r16b, (const float*)(ws + WS_ST1), a.in[10], a.in[11], r16b, D, ALPHA, nullptr}); __syncthreads(); SEAM(8); }
    if (IN(9)) { ln_rows16(r16b, a.in[15], a.in[16], nullptr, x2b, lane, gw, NGW); SEAM(9); }
    if (IN(10)) {
        pg8::Gemm g{x2b, (const bf16_t*)(ws + WS_WUP), 136 * 256, NUP, D}; pg8::StaticOrder S; S.init(136 * 256, NUP, (int)gridDim.x, (int)blockIdx.x);
        pg8::gemm_phase_ffn<pg8::EpiFFN, pg8::StaticOrder, false>(lds, g, S, pg8::EpiFFN{hb, a.in[18], a.in[19]}, nullptr);
        __syncthreads(); SEAM(10); }
    if (IN(14)) { run_gemm(lds, hb, (const bf16_t*)(ws + WS_WDN), T, D, DFF, pg8::EpiResO16<true>{x2b, r3b, D, ALPHA, nullptr}); __syncthreads(); SEAM(14); }
    if (IN(15)) { ln_rows16(r3b, a.in[21], a.in[22], a.out, nullptr, lane, gw, NGW); }
}

extern "C" void kernel_launch(void* const* d_in, const int* in_sizes, int n_in, void* d_out, int out_size, void* d_ws, size_t ws_size, hipStream_t stream) {
    static int grid = 0;
    if (grid == 0) {
        int dev = 0, cus = 0, per_cu = 0;
        hipGetDevice(&dev); hipDeviceGetAttribute(&cus, hipDeviceAttributeMultiprocessorCount, dev);
        if (hipFuncSetAttribute((const void*)fwd_megakernel, hipFuncAttributeMaxDynamicSharedMemorySize, LDS_BYTES) != hipSuccess) { fprintf(stderr, "hipFuncSetAttribute failed\n"); }
        if (hipOccupancyMaxActiveBlocksPerMultiprocessor(&per_cu, (const void*)fwd_megakernel, 512, LDS_BYTES) != hipSuccess || per_cu < 1) { fprintf(stderr, "occupancy query: %d\n", per_cu); per_cu = 1; }
        (void)hipGetLastError();
        grid = cus * per_cu;
        if (ws_size < 482 * MiB) fprintf(stderr, "workspace too small: %zu\n", ws_size);
    }
    Args a{};
    for (int i = 0; i < 23; ++i) a.in[i] = (const float*)d_in[i];
    a.out = (float*)d_out; a.ws = (unsigned char*)d_ws;
#if N_LAUNCH_MODE == 0
    (void)hipMemsetAsync((unsigned char*)d_ws + WS_BAR, 0, 64 * 34 * 4, stream);
    a.ph_lo = 0; a.ph_hi = NPH; void* args[] = {&a};
    hipError_t e = hipLaunchCooperativeKernel((const void*)fwd_megakernel, dim3(grid), dim3(512), args, LDS_BYTES, stream);
    if (e != hipSuccess) fprintf(stderr, "cooperative launch failed: %s (grid %d)\n", hipGetErrorString(e), grid);
#else
    for (int ph = 0; ph < NPH; ++ph) { a.ph_lo = ph; a.ph_hi = ph + 1; hipLaunchKernelGGL(fwd_megakernel, dim3(grid), dim3(512), LDS_BYTES, stream, a); }
#endif
}
```

```cpp
#include <hip/hip_runtime.h>
#include <hip/hip_cooperative_groups.h>
#include <cstdio>
#include <cstdint>
namespace cg = cooperative_groups;
namespace pg8 {
#define PG8_LAS __attribute__((address_space(3)))
typedef unsigned short bf16_t;
typedef short bf16x8 __attribute__((ext_vector_type(8)));
typedef float f32x4 __attribute__((ext_vector_type(4)));
typedef unsigned u32x4 __attribute__((ext_vector_type(4)));
constexpr int BM = 256, BK = 64, HALF = 128, HTB = HALF * BK * 2  , STAGE_BYTES = 8 * HTB, NXCD = 8, WGM = 8;

__host__ __device__ __forceinline__ int lds_byte(int r, int c) { const int st = (r >> 4) * 2 + (c >> 5), rr = r & 15, cc = c & 31, ob = rr * 64 + cc * 2; return st * 1024 + (ob ^ (((ob >> 9) & 1) << 5)); }
__host__ __device__ __forceinline__ void stage_rc(int b, int& R, int& C) { const int st = b / 1024, sb = b % 1024, swz = sb ^ (((sb >> 9) & 1) << 5); R = (st >> 1) * 16 + swz / 64; C = (st & 1) * 32 + (swz % 64) / 2; }
__host__ __device__ __forceinline__ int perm32(int rho) { const int n = rho >> 4, i = rho & 15; return 8 * (i >> 2) + 4 * n + (i & 3); }

struct Unit { int pm, pn; };
struct Gemm { const bf16_t* A; const bf16_t* Bt; int M, N, K; };

struct StaticOrder {
    int nM, nN, nwg, G, c;
    __host__ __device__ void init(int M, int N, int G_, int c_) { nM = M / BM; nN = N / BM; nwg = nM * nN; G = G_; c = c_; }
    __host__ __device__ bool next(int i, Unit& u) const {
        const long L = (long)i * G + c; if (L >= nwg) return false;
        int wgid = (int)L; { const int q = nwg / NXCD, r = nwg % NXCD, xcd = wgid % NXCD, off = wgid / NXCD; wgid = (xcd < r ? xcd * (q + 1) : r * (q + 1) + (xcd - r) * q) + off; }
        const int nig = WGM * nN, gid = wgid / nig, fm = gid * WGM, gsz = (nM - fm) < WGM ? (nM - fm) : WGM;
        u.pm = fm + ((wgid % nig) % gsz); u.pn = (wgid % nig) / gsz; return true;
    }
    __device__ __forceinline__ void a_ready(const Unit&) const {}
    __device__ __forceinline__ void done(const Unit&) const {}
};
typedef __bf16 bf16x2_nat __attribute__((ext_vector_type(2))); typedef float f32x2_nat __attribute__((ext_vector_type(2)));
__device__ __forceinline__ unsigned cvt_pk_bf16(float lo, float hi) { f32x2_nat v = {lo, hi}; bf16x2_nat r = __builtin_convertvector(v, bf16x2_nat); return __builtin_bit_cast(unsigned, r); }
typedef float f32x2 __attribute__((ext_vector_type(2)));
struct EpiB16 {
    static constexpr bool PERM = true, AFTER_DRAIN = false;
    bf16_t* O; int ldc; const float* bias; unsigned silu_mask, sig_mask;
    __device__ __forceinline__ void operator()(const f32x4 (&acc)[2][2][4][2], const Unit& u, int wr, int wc, int fr, int fq) const {
        const int row0 = u.pm * BM + wr * 64 + fr; const int col0 = u.pn * BM + wc * 32 + 8 * fq;
        const int act = ((silu_mask >> u.pn) & 1u) ? 1 : (((sig_mask >> u.pn) & 1u) ? 2 : 0);
        f32x4 bv[2][2];
#pragma unroll
        for (int bj = 0; bj < 2; ++bj)
#pragma unroll
            for (int n = 0; n < 2; ++n) bv[bj][n] = bias ? *(const f32x4*)(bias + col0 + bj * HALF + 4 * n) : (f32x4){0.f, 0.f, 0.f, 0.f};
#pragma unroll
        for (int ai = 0; ai < 2; ++ai)
#pragma unroll
            for (int m = 0; m < 4; ++m) { bf16_t* rowp = O + (size_t)(row0 + ai * HALF + m * 16) * ldc + col0;
#pragma unroll
                for (int bj = 0; bj < 2; ++bj) { f32x4 v0 = acc[ai][bj][m][0] + bv[bj][0], v1 = acc[ai][bj][m][1] + bv[bj][1];
                    if (act) {
#pragma unroll
                        for (int j = 0; j < 4; ++j) { const float s0 = __builtin_amdgcn_rcpf(1.f + __expf(-v0[j])), s1 = __builtin_amdgcn_rcpf(1.f + __expf(-v1[j]));
                            v0[j] = (act == 1) ? v0[j] * s0 : s0; v1[j] = (act == 1) ? v1[j] * s1 : s1; } }
                    u32x4 w; w.x = cvt_pk_bf16(v0[0], v0[1]); w.y = cvt_pk_bf16(v0[2], v0[3]); w.z = cvt_pk_bf16(v1[0], v1[1]); w.w = cvt_pk_bf16(v1[2], v1[3]);
                    *(u32x4*)(rowp + bj * HALF) = w; } }
    }
};
template <bool BASE16> struct EpiResO16 {
    static constexpr bool PERM = false, AFTER_DRAIN = false;
    const void* base; bf16_t* out; int ldc; float alpha; float* stats;
    __device__ __forceinline__ void operator()(const f32x4 (&acc)[2][2][4][2], const Unit& u, int wr, int wc, int fr, int fq) const {
        typedef unsigned u32x2e __attribute__((ext_vector_type(2)));
        const int row0 = u.pm * BM + wr * 64 + fr, col0 = u.pn * BM + wc * 32 + 4 * fq;
#pragma unroll
        for (int ai = 0; ai < 2; ++ai)
#pragma unroll
            for (int m = 0; m < 4; ++m) { const size_t off = (size_t)(row0 + ai * HALF + m * 16) * ldc + col0; float rs = 0.f, rq = 0.f;
#pragma unroll
                for (int bj = 0; bj < 2; ++bj)
#pragma unroll
                    for (int n = 0; n < 2; ++n) { f32x4 bs;
                        if (BASE16) { const u32x2e bw = *(const u32x2e*)((const bf16_t*)base + off + bj * HALF + n * 16);
                            bs = (f32x4){__uint_as_float(bw.x << 16), __uint_as_float(bw.x & 0xffff0000u), __uint_as_float(bw.y << 16), __uint_as_float(bw.y & 0xffff0000u)}; }
                        else bs = *(const f32x4*)((const float*)base + off + bj * HALF + n * 16);
                        const f32x4 v = bs * alpha + acc[ai][bj][m][n]; u32x2e w; w.x = cvt_pk_bf16(v[0], v[1]); w.y = cvt_pk_bf16(v[2], v[3]);
                        rs += (v[0] + v[1]) + (v[2] + v[3]); rq += (v[0] * v[0] + v[1] * v[1]) + (v[2] * v[2] + v[3] * v[3]);
                        *(u32x2e*)(out + off + bj * HALF + n * 16) = w; }
                if (stats) { rs += __shfl_xor(rs, 16); rs += __shfl_xor(rs, 32); rq += __shfl_xor(rq, 16); rq += __shfl_xor(rq, 32);
                    if (fq == 0) { float* sp = stats + 2 * (size_t)(row0 + ai * HALF + m * 16); atomicAdd(sp, rs); atomicAdd(sp + 1, rq); } } }
    }
};
struct EpiLNq {
    static constexpr bool PERM = true, AFTER_DRAIN = false;
    bf16_t* O; int ldc; const float* st; const float* c1; const float* c2;
    __device__ __forceinline__ void operator()(const f32x4 (&acc)[2][2][4][2], const Unit& u, int wr, int wc, int fr, int fq) const {
        const int row0 = u.pm * BM + wr * 64 + fr, col0 = u.pn * BM + wc * 32 + 8 * fq;
        f32x4 k1[2][2], k2[2][2];
#pragma unroll
        for (int bj = 0; bj < 2; ++bj)
#pragma unroll
            for (int n = 0; n < 2; ++n) { k1[bj][n] = *(const f32x4*)(c1 + col0 + bj * HALF + 4 * n); k2[bj][n] = *(const f32x4*)(c2 + col0 + bj * HALF + 4 * n); }
#pragma unroll
        for (int ai = 0; ai < 2; ++ai)
#pragma unroll
            for (int m = 0; m < 4; ++m) { const int row = row0 + ai * HALF + m * 16; const f32x2_nat sv = *(const f32x2_nat*)(st + 2 * (size_t)row);
                const float mu = sv[0] * (1.f / 1024.f), rstd = __builtin_amdgcn_rsqf(fmaxf(sv[1] * (1.f / 1024.f) - mu * mu, 0.f) + 1e-5f);
                bf16_t* rowp = O + (size_t)row * ldc + col0;
#pragma unroll
                for (int bj = 0; bj < 2; ++bj) { const f32x4 v0 = (acc[ai][bj][m][0] - k1[bj][0] * mu) * rstd + k2[bj][0], v1 = (acc[ai][bj][m][1] - k1[bj][1] * mu) * rstd + k2[bj][1];
                    u32x4 w; w.x = cvt_pk_bf16(v0[0], v0[1]); w.y = cvt_pk_bf16(v0[2], v0[3]); w.z = cvt_pk_bf16(v1[0], v1[1]); w.w = cvt_pk_bf16(v1[2], v1[3]);
                    *(u32x4*)(rowp + bj * HALF) = w; } }
    }
};
struct EpiResLN {
    static constexpr bool PERM = false, AFTER_DRAIN = false;
    const bf16_t* rsrc; const float* st; const float* gam; const float* bet; bf16_t* out; int ldc; float alpha; float* stats;
    __device__ __forceinline__ void operator()(const f32x4 (&acc)[2][2][4][2], const Unit& u, int wr, int wc, int fr, int fq) const {
        typedef unsigned u32x2e __attribute__((ext_vector_type(2)));
        const int row0 = u.pm * BM + wr * 64 + fr, col0 = u.pn * BM + wc * 32 + 4 * fq;
        f32x4 gv[2][2], bv[2][2];
#pragma unroll
        for (int bj = 0; bj < 2; ++bj)
#pragma unroll
            for (int n = 0; n < 2; ++n) { gv[bj][n] = *(const f32x4*)(gam + col0 + bj * HALF + n * 16); bv[bj][n] = *(const f32x4*)(bet + col0 + bj * HALF + n * 16); }
#pragma unroll
        for (int ai = 0; ai < 2; ++ai)
#pragma unroll
            for (int m = 0; m < 4; ++m) { const int row = row0 + ai * HALF + m * 16; const size_t off = (size_t)row * ldc + col0; const f32x2_nat sv = *(const f32x2_nat*)(st + 2 * (size_t)row);
                const float mu = sv[0] * (1.f / 1024.f), rstd = __builtin_amdgcn_rsqf(fmaxf(sv[1] * (1.f / 1024.f) - mu * mu, 0.f) + 1e-5f); float rs = 0.f, rq = 0.f;
#pragma unroll
                for (int bj = 0; bj < 2; ++bj)
#pragma unroll
                    for (int n = 0; n < 2; ++n) { const u32x2e bw = *(const u32x2e*)(rsrc + off + bj * HALF + n * 16);
                        const f32x4 rr = {__uint_as_float(bw.x << 16), __uint_as_float(bw.x & 0xffff0000u), __uint_as_float(bw.y << 16), __uint_as_float(bw.y & 0xffff0000u)};
                        const f32x4 xb_ = (rr - mu) * rstd * gv[bj][n] + bv[bj][n]; const f32x4 v = xb_ * alpha + acc[ai][bj][m][n];
                        u32x2e w; w.x = cvt_pk_bf16(v[0], v[1]); w.y = cvt_pk_bf16(v[2], v[3]);
                        rs += (v[0] + v[1]) + (v[2] + v[3]); rq += (v[0] * v[0] + v[1] * v[1]) + (v[2] * v[2] + v[3] * v[3]);
                        *(u32x2e*)(out + off + bj * HALF + n * 16) = w; }
                if (stats) { rs += __shfl_xor(rs, 16); rs += __shfl_xor(rs, 32); rq += __shfl_xor(rq, 16); rq += __shfl_xor(rq, 32);
                    if (fq == 0) { float* sp = stats + 2 * (size_t)row; atomicAdd(sp, rs); atomicAdd(sp + 1, rq); } } }
    }
};
struct EpiResB {
    static constexpr bool PERM = false, AFTER_DRAIN = false;
    const bf16_t* base; float* out; int ldc; float alpha;
    __device__ __forceinline__ void operator()(const f32x4 (&acc)[2][2][4][2], const Unit& u, int wr, int wc, int fr, int fq) const {
        const int row0 = u.pm * BM + wr * 64 + fr, col0 = u.pn * BM + wc * 32 + 4 * fq;
#pragma unroll
        for (int ai = 0; ai < 2; ++ai)
#pragma unroll
            for (int m = 0; m < 4; ++m) { const size_t off = (size_t)(row0 + ai * HALF + m * 16) * ldc + col0;
#pragma unroll
                for (int bj = 0; bj < 2; ++bj)
#pragma unroll
                    for (int n = 0; n < 2; ++n) { typedef unsigned u32x2e __attribute__((ext_vector_type(2))); const u32x2e bw = *(const u32x2e*)(base + off + bj * HALF + n * 16);
                        const f32x4 bs = {__uint_as_float(bw.x << 16), __uint_as_float(bw.x & 0xffff0000u), __uint_as_float(bw.y << 16), __uint_as_float(bw.y & 0xffff0000u)};
                        *(f32x4*)(out + off + bj * HALF + n * 16) = bs * alpha + acc[ai][bj][m][n]; } }
    }
};
struct EpiRes {
    static constexpr bool PERM = false, AFTER_DRAIN = false;
    const float* base; float* out; int ldc; float alpha;
    __device__ __forceinline__ void operator()(const f32x4 (&acc)[2][2][4][2], const Unit& u, int wr, int wc, int fr, int fq) const {
        const int row0 = u.pm * BM + wr * 64 + fr, col0 = u.pn * BM + wc * 32 + 4 * fq;
#pragma unroll
        for (int ai = 0; ai < 2; ++ai)
#pragma unroll
            for (int m = 0; m < 4; ++m) { const size_t off = (size_t)(row0 + ai * HALF + m * 16) * ldc + col0;
#pragma unroll
                for (int bj = 0; bj < 2; ++bj)
#pragma unroll
                    for (int n = 0; n < 2; ++n) { const f32x4 bs = *(const f32x4*)(base + off + bj * HALF + n * 16);
                        *(f32x4*)(out + off + bj * HALF + n * 16) = bs * alpha + acc[ai][bj][m][n]; } }
    }
};
template <class Epi, class Sched, bool STAMP = false>
__device__ __forceinline__ void gemm_phase(PG8_LAS unsigned char* lds, const Gemm g, const Sched& S, const Epi& E, unsigned long long* stamps) {
    const int tid = threadIdx.x, wid = __builtin_amdgcn_readfirstlane(tid >> 6), lane = tid & 63, wr = wid >> 2, wc = wid & 3, fr = lane & 15, fq = lane >> 4;
    const int K = g.K, nt = K / BK;
    int ts_lo = 0, ts_hi = 0, nts = 0; const unsigned long long rt_entry = STAMP ? (unsigned long long)wall_clock64() : 0ull;
#define PG8_STAMP() do { if (STAMP && wid == 0 && nts < 64) { const unsigned long long _c = (unsigned long long)clock64(); \
        ts_lo = (lane == nts) ? (int)(unsigned)_c : ts_lo; ts_hi = (lane == nts) ? (int)(unsigned)(_c >> 32) : ts_hi; ++nts; } } while (0)
    PG8_STAMP();
    unsigned voffA[2], voffB[2];
#pragma unroll
    for (int i = 0; i < 2; ++i) { int R, C; stage_rc(tid * 16 + i * 8192, R, C); const int Rb = Epi::PERM ? ((R & ~31) + perm32(R & 31)) : R;
        voffA[i] = (unsigned)(R * K + C) * 2u; voffB[i] = (unsigned)(Rb * K + C) * 2u; }
    const size_t kstep = (size_t)(BK * 2);
    const size_t hstep = (size_t)HALF * K * 2;
    const size_t tstep = 2 * hstep;
    const unsigned ldsw = (unsigned)wid * 1024u;
    const int aoff = lds_byte(wr * 64 + fr, fq * 8), boff = lds_byte(wc * 32 + fr, fq * 8);
#define PG8_SA(b, h) (((b) * 2 + (h)) * HTB)
#define PG8_SB(b, h) ((4 + (b) * 2 + (h)) * HTB)
#define PG8_STAGE(bufoff, gbase, voff) do { _Pragma("unroll") for (int _i = 0; _i < 2; ++_i) \
        __builtin_amdgcn_global_load_lds((const unsigned*)((const char*)(gbase) + (voff)[_i]), (PG8_LAS unsigned*)(lds + (bufoff) + ldsw + _i * 8192), 16, 0, 0); } while (0)
#define PG8_LDA(dst, b, h) do { _Pragma("unroll") for (int m = 0; m < 4; ++m) _Pragma("unroll") for (int k = 0; k < 2; ++k) dst[m][k] = *(const PG8_LAS bf16x8*)(lds + PG8_SA(b, h) + aoff + m * 2048 + k * 1024); } while (0)
#define PG8_LDB(dst, b, h) do { _Pragma("unroll") for (int n = 0; n < 2; ++n) _Pragma("unroll") for (int k = 0; k < 2; ++k) dst[n][k] = *(const PG8_LAS bf16x8*)(lds + PG8_SB(b, h) + boff + n * 2048 + k * 1024); } while (0)
#define PG8_MMA(ai, bj, At, Bt) do { __builtin_amdgcn_s_setprio(1); _Pragma("unroll") for (int m = 0; m < 4; ++m) _Pragma("unroll") for (int n = 0; n < 2; ++n) _Pragma("unroll") for (int k = 0; k < 2; ++k) \
        acc[ai][bj][m][n] = __builtin_amdgcn_mfma_f32_16x16x32_bf16(Bt[n][k], At[m][k], acc[ai][bj][m][n], 0, 0, 0); __builtin_amdgcn_s_setprio(0); } while (0)
#define PG8_WAIT_V(n) asm volatile("s_waitcnt vmcnt(" #n ")" ::: "memory")
#define PG8_WAIT_L(n) asm volatile("s_waitcnt lgkmcnt(" #n ")" ::: "memory")
#define PG8_BAR __builtin_amdgcn_s_barrier()
#define PG8_SCHED __builtin_amdgcn_sched_barrier(0)
    Unit cur, nxt; int ui = 0;
    if (!S.next(0, cur)) return;
    f32x4 acc[2][2][4][2];
#pragma unroll
    for (int a = 0; a < 2; ++a)
#pragma unroll
        for (int b = 0; b < 2; ++b)
#pragma unroll
            for (int m = 0; m < 4; ++m)
#pragma unroll
                for (int n = 0; n < 2; ++n) acc[a][b][m][n] = (f32x4){0.f, 0.f, 0.f, 0.f};
    bf16x8 At[4][2], B0[2][2], B1[2][2];
    const char* cA = (const char*)g.A + (size_t)cur.pm * tstep; const char* cB = (const char*)g.Bt + (size_t)cur.pn * tstep;
    S.a_ready(cur);
    PG8_STAGE(PG8_SB(0, 0), cB, voffB); PG8_STAGE(PG8_SA(0, 0), cA, voffA); PG8_STAGE(PG8_SB(0, 1), cB + hstep, voffB); PG8_STAGE(PG8_SA(0, 1), cA + hstep, voffA);
    if (wr == 1) PG8_BAR;
    PG8_WAIT_V(4); PG8_BAR;
    PG8_STAGE(PG8_SB(1, 0), cB + kstep, voffB); PG8_STAGE(PG8_SA(1, 0), cA + kstep, voffA); PG8_STAGE(PG8_SB(1, 1), cB + hstep + kstep, voffB);
    PG8_WAIT_V(6); PG8_BAR;
    PG8_STAMP();
    for (;;) {
        const bool has_next = S.next(ui + 1, nxt);
        const char* nA = has_next ? (const char*)g.A + (size_t)nxt.pm * tstep : cA; const char* nB = has_next ? (const char*)g.Bt + (size_t)nxt.pn * tstep : cB;
        for (int t = 0; t < nt; t += 2) {
            const bool last = (t == nt - 2);
            const char* a1 = cA + (size_t)(t + 1) * kstep;
            const char* a2 = last ? nA : cA + (size_t)(t + 2) * kstep; const char* b2 = last ? nB : cB + (size_t)(t + 2) * kstep;
            const char* a3 = a2 + kstep; const char* b3 = b2 + kstep;
            if (last && has_next) S.a_ready(nxt);
            PG8_LDB(B0, 0, 0); PG8_SCHED; PG8_LDA(At, 0, 0); PG8_STAGE(PG8_SA(1, 1), a1 + hstep, voffA);
            PG8_WAIT_L(8); PG8_BAR; PG8_WAIT_L(0); PG8_MMA(0, 0, At, B0); PG8_BAR; PG8_SCHED;
            PG8_LDB(B1, 0, 1); PG8_STAGE(PG8_SB(0, 0), b2, voffB);
            PG8_BAR; PG8_WAIT_L(0); PG8_MMA(0, 1, At, B1); PG8_BAR;
            PG8_LDA(At, 0, 1); PG8_STAGE(PG8_SA(0, 0), a2, voffA);
            PG8_BAR; PG8_WAIT_L(0); PG8_MMA(1, 0, At, B0); PG8_BAR; PG8_SCHED;
            PG8_STAGE(PG8_SB(0, 1), b2 + hstep, voffB);
            PG8_WAIT_V(6); PG8_BAR; PG8_MMA(1, 1, At, B1); PG8_BAR;
            PG8_LDB(B0, 1, 0); PG8_SCHED; PG8_LDA(At, 1, 0); PG8_STAGE(PG8_SA(0, 1), a2 + hstep, voffA);
            PG8_WAIT_L(8); PG8_BAR; PG8_WAIT_L(0); PG8_MMA(0, 0, At, B0); PG8_BAR; PG8_SCHED;
            PG8_LDB(B1, 1, 1); PG8_STAGE(PG8_SB(1, 0), b3, voffB);
            PG8_BAR; PG8_WAIT_L(0); PG8_MMA(0, 1, At, B1); PG8_BAR;
            PG8_LDA(At, 1, 1); PG8_STAGE(PG8_SA(1, 0), a3, voffA);
            PG8_BAR; PG8_WAIT_L(0); PG8_MMA(1, 0, At, B0); PG8_BAR; PG8_SCHED;
            PG8_STAGE(PG8_SB(1, 1), b3 + hstep, voffB);
            PG8_WAIT_V(6); PG8_BAR; PG8_MMA(1, 1, At, B1); PG8_BAR;
        }
        PG8_STAMP();
        if constexpr (!Epi::AFTER_DRAIN) { E(acc, cur, wr, wc, fr, fq); S.done(cur); }
        PG8_STAMP();
        if (!has_next) break;
#pragma unroll
        for (int a = 0; a < 2; ++a)
#pragma unroll
            for (int b = 0; b < 2; ++b)
#pragma unroll
                for (int m = 0; m < 4; ++m)
#pragma unroll
                    for (int n = 0; n < 2; ++n) acc[a][b][m][n] = (f32x4){0.f, 0.f, 0.f, 0.f};
        cur = nxt; cA = nA; cB = nB; ++ui;
    }
    PG8_WAIT_V(0);
    if (wr == 0) PG8_BAR;
    PG8_BAR;
    if constexpr (Epi::AFTER_DRAIN) { E.fused(acc, cur, wr, wc, fr, fq, lds, wid, lane); S.done(cur); }
    PG8_STAMP();
    if (STAMP && wid == 0) { stamps[lane] = lane < nts ? (((unsigned long long)(unsigned)ts_hi << 32) | (unsigned)ts_lo) : 0ull;
        if (lane == 62) stamps[62] = rt_entry; if (lane == 63) stamps[63] = (unsigned long long)wall_clock64(); }
#undef PG8_STAMP
#undef PG8_SA
#undef PG8_SB
#undef PG8_STAGE
#undef PG8_LDA
#undef PG8_LDB
#undef PG8_MMA
#undef PG8_WAIT_V
#undef PG8_WAIT_L
#undef PG8_BAR
#undef PG8_SCHED
}

struct EpiFFN {
    static constexpr bool PERM = true, AFTER_DRAIN = false;
    bf16_t* H; const float* cw; const float* cb;
    __device__ __forceinline__ void operator()(const f32x4 (&acc)[2][2][4][2], const Unit& u, int wr, int wc, int fr, int fq) const {
        const int batch = u.pm / 17, jj = u.pm % 17, col0 = u.pn * 128 + wc * 32 + 8 * fq;
        const int lane = (int)(threadIdx.x & 63u), src1 = (lane & 48) | ((lane - 1) & 15), src2 = (lane & 48) | ((lane - 2) & 15);
#pragma unroll
        for (int n = 0; n < 2; ++n) { const int col = col0 + 4 * n;
            f32x4 wg[3], wv[3];
#pragma unroll
            for (int tp = 0; tp < 3; ++tp) { wg[tp] = *(const f32x4*)(cw + tp * 5632 + col); wv[tp] = *(const f32x4*)(cw + tp * 5632 + 2816 + col); }
            const f32x4 bg = *(const f32x4*)(cb + col), bvv = *(const f32x4*)(cb + 2816 + col);
#pragma unroll
            for (int ai = 0; ai < 2; ++ai) { const int gbase = 248 * jj + 62 * (2 * ai + wr);
                f32x4 q1g = {0.f, 0.f, 0.f, 0.f}, q2g = q1g, q1v = q1g, q2v = q1g;
#pragma unroll
                for (int m = 0; m < 4; ++m) { const f32x4 g0 = acc[ai][0][m][n], v0 = acc[ai][1][m][n]; f32x4 r1g, r2g, r1v, r2v;
#pragma unroll
                    for (int j = 0; j < 4; ++j) { r1g[j] = __shfl(g0[j], src1); r2g[j] = __shfl(g0[j], src2); r1v[j] = __shfl(v0[j], src1); r2v[j] = __shfl(v0[j], src2); }
                    const int lr = 16 * m + fr, tok = gbase + lr - 2;
                    f32x4 p1g = (fr >= 1) ? r1g : q1g, p2g = (fr >= 2) ? r2g : q2g, p1v = (fr >= 1) ? r1v : q1v, p2v = (fr >= 2) ? r2v : q2v;
                    const f32x4 z = {0.f, 0.f, 0.f, 0.f};
                    if (tok < 1) { p1g = z; p1v = z; }
                    if (tok < 2) { p2g = z; p2v = z; }
                    const f32x4 gate = bg + wg[0] * p2g + wg[1] * p1g + wg[2] * g0, val = bvv + wv[0] * p2v + wv[1] * p1v + wv[2] * v0;
                    if (lr >= 2 && tok < 4096) { float o4[4];
#pragma unroll
                        for (int j = 0; j < 4; ++j) { const float x = gate[j]; const float uu = 0.7978845608028654f * (x + 0.044715f * x * x * x);
                            const float th = 1.f - 2.f * __builtin_amdgcn_rcpf(1.f + __expf(2.f * uu)); o4[j] = 0.5f * x * (1.f + th) * val[j]; }
                        typedef unsigned u32x2e __attribute__((ext_vector_type(2))); u32x2e w; w.x = cvt_pk_bf16(o4[0], o4[1]); w.y = cvt_pk_bf16(o4[2], o4[3]);
                        *(u32x2e*)(H + ((size_t)batch * 4096 + tok) * 2816 + col) = w; }
                    q1g = r1g; q2g = r2g; q1v = r1v; q2v = r2v; } } }
    }
};
template <class Epi, class Sched, bool STAMP = false>
__device__ __forceinline__ void gemm_phase_ffn(PG8_LAS unsigned char* lds, const Gemm g, const Sched& S, const Epi& E, unsigned long long* stamps) {
    const int tid = threadIdx.x, wid = __builtin_amdgcn_readfirstlane(tid >> 6), lane = tid & 63, wr = wid >> 2, wc = wid & 3, fr = lane & 15, fq = lane >> 4;
    const int K = g.K, nt = K / BK;
    int ts_lo = 0, ts_hi = 0, nts = 0; const unsigned long long rt_entry = STAMP ? (unsigned long long)wall_clock64() : 0ull;
#define PG8_STAMP() do { if (STAMP && wid == 0 && nts < 64) { const unsigned long long _c = (unsigned long long)clock64(); \
        ts_lo = (lane == nts) ? (int)(unsigned)_c : ts_lo; ts_hi = (lane == nts) ? (int)(unsigned)(_c >> 32) : ts_hi; ++nts; } } while (0)
    PG8_STAMP();
    unsigned voffA[2], voffB[2];
#pragma unroll
    for (int i = 0; i < 2; ++i) { int R, C; stage_rc(tid * 16 + i * 8192, R, C); const int Rb = Epi::PERM ? ((R & ~31) + perm32(R & 31)) : R;
        voffA[i] = (unsigned)((62 * (R >> 6) + (R & 63)) * K + C) * 2u; voffB[i] = (unsigned)(Rb * K + C) * 2u; }
    const size_t kstep = (size_t)(BK * 2);
    const size_t hstepA = (size_t)124 * K * 2, hstepB = (size_t)2816 * K * 2;
#define PG8_ABASE(pm_) ((const char*)g.A + ((long)((pm_) / 17) * 4096 + 248L * ((pm_) % 17) - 2L) * (long)K * 2L)
#define PG8_BBASE(pn_) ((const char*)g.Bt + (size_t)(pn_) * HALF * K * 2)
    const unsigned ldsw = (unsigned)wid * 1024u;
    const int aoff = lds_byte(wr * 64 + fr, fq * 8), boff = lds_byte(wc * 32 + fr, fq * 8);
#define PG8_SA(b, h) (((b) * 2 + (h)) * HTB)
#define PG8_SB(b, h) ((4 + (b) * 2 + (h)) * HTB)
#define PG8_STAGE(bufoff, gbase, voff) do { _Pragma("unroll") for (int _i = 0; _i < 2; ++_i) \
        __builtin_amdgcn_global_load_lds((const unsigned*)((const char*)(gbase) + (voff)[_i]), (PG8_LAS unsigned*)(lds + (bufoff) + ldsw + _i * 8192), 16, 0, 0); } while (0)
#define PG8_LDA(dst, b, h) do { _Pragma("unroll") for (int m = 0; m < 4; ++m) _Pragma("unroll") for (int k = 0; k < 2; ++k) dst[m][k] = *(const PG8_LAS bf16x8*)(lds + PG8_SA(b, h) + aoff + m * 2048 + k * 1024); } while (0)
#define PG8_LDB(dst, b, h) do { _Pragma("unroll") for (int n = 0; n < 2; ++n) _Pragma("unroll") for (int k = 0; k < 2; ++k) dst[n][k] = *(const PG8_LAS bf16x8*)(lds + PG8_SB(b, h) + boff + n * 2048 + k * 1024); } while (0)
#define PG8_MMA(ai, bj, At, Bt) do { __builtin_amdgcn_s_setprio(1); _Pragma("unroll") for (int m = 0; m < 4; ++m) _Pragma("unroll") for (int n = 0; n < 2; ++n) _Pragma("unroll") for (int k = 0; k < 2; ++k) \
        acc[ai][bj][m][n] = __builtin_amdgcn_mfma_f32_16x16x32_bf16(Bt[n][k], At[m][k], acc[ai][bj][m][n], 0, 0, 0); __builtin_amdgcn_s_setprio(0); } while (0)
#define PG8_WAIT_V(n) asm volatile("s_waitcnt vmcnt(" #n ")" ::: "memory")
#define PG8_WAIT_L(n) asm volatile("s_waitcnt lgkmcnt(" #n ")" ::: "memory")
#define PG8_BAR __builtin_amdgcn_s_barrier()
#define PG8_SCHED __builtin_amdgcn_sched_barrier(0)
    Unit cur, nxt; int ui = 0;
    if (!S.next(0, cur)) return;
    f32x4 acc[2][2][4][2];
#pragma unroll
    for (int a = 0; a < 2; ++a)
#pragma unroll
        for (int b = 0; b < 2; ++b)
#pragma unroll
            for (int m = 0; m < 4; ++m)
#pragma unroll
                for (int n = 0; n < 2; ++n) acc[a][b][m][n] = (f32x4){0.f, 0.f, 0.f, 0.f};
    bf16x8 At[4][2], B0[2][2], B1[2][2];
    const char* cA = PG8_ABASE(cur.pm); const char* cB = PG8_BBASE(cur.pn);
    S.a_ready(cur);
    PG8_STAGE(PG8_SB(0, 0), cB, voffB); PG8_STAGE(PG8_SA(0, 0), cA, voffA); PG8_STAGE(PG8_SB(0, 1), cB + hstepB, voffB); PG8_STAGE(PG8_SA(0, 1), cA + hstepA, voffA);
    if (wr == 1) PG8_BAR;
    PG8_WAIT_V(4); PG8_BAR;
    PG8_STAGE(PG8_SB(1, 0), cB + kstep, voffB); PG8_STAGE(PG8_SA(1, 0), cA + kstep, voffA); PG8_STAGE(PG8_SB(1, 1), cB + hstepB + kstep, voffB);
    PG8_WAIT_V(6); PG8_BAR;
    PG8_STAMP();
    for (;;) {
        const bool has_next = S.next(ui + 1, nxt);
        const char* nA = has_next ? PG8_ABASE(nxt.pm) : cA; const char* nB = has_next ? PG8_BBASE(nxt.pn) : cB;
        for (int t = 0; t < nt; t += 2) {
            const bool last = (t == nt - 2);
            const char* a1 = cA + (size_t)(t + 1) * kstep;
            const char* a2 = last ? nA : cA + (size_t)(t + 2) * kstep; const char* b2 = last ? nB : cB + (size_t)(t + 2) * kstep;
            const char* a3 = a2 + kstep; const char* b3 = b2 + kstep;
            if (last && has_next) S.a_ready(nxt);
            PG8_LDB(B0, 0, 0); PG8_SCHED; PG8_LDA(At, 0, 0); PG8_STAGE(PG8_SA(1, 1), a1 + hstepA, voffA);
            PG8_WAIT_L(8); PG8_BAR; PG8_WAIT_L(0); PG8_MMA(0, 0, At, B0); PG8_BAR; PG8_SCHED;
            PG8_LDB(B1, 0, 1); PG8_STAGE(PG8_SB(0, 0), b2, voffB);
            PG8_BAR; PG8_WAIT_L(0); PG8_MMA(0, 1, At, B1); PG8_BAR;
            PG8_LDA(At, 0, 1); PG8_STAGE(PG8_SA(0, 0), a2, voffA);
            PG8_BAR; PG8_WAIT_L(0); PG8_MMA(1, 0, At, B0); PG8_BAR; PG8_SCHED;
            PG8_STAGE(PG8_SB(0, 1), b2 + hstepB, voffB);
            PG8_WAIT_V(6); PG8_BAR; PG8_MMA(1, 1, At, B1); PG8_BAR;
            PG8_LDB(B0, 1, 0); PG8_SCHED; PG8_LDA(At, 1, 0); PG8_STAGE(PG8_SA(0, 1), a2 + hstepA, voffA);
            PG8_WAIT_L(8); PG8_BAR; PG8_WAIT_L(0); PG8_MMA(0, 0, At, B0); PG8_BAR; PG8_SCHED;
            PG8_LDB(B1, 1, 1); PG8_STAGE(PG8_SB(1, 0), b3, voffB);
            PG8_BAR; PG8_WAIT_L(0); PG8_MMA(0, 1, At, B1); PG8_BAR;
            PG8_LDA(At, 1, 1); PG8_STAGE(PG8_SA(1, 0), a3, voffA);
            PG8_BAR; PG8_WAIT_L(0); PG8_MMA(1, 0, At, B0); PG8_BAR; PG8_SCHED;
            PG8_STAGE(PG8_SB(1, 1), b3 + hstepB, voffB);
            PG8_WAIT_V(6); PG8_BAR; PG8_MMA(1, 1, At, B1); PG8_BAR;
        }
        PG8_STAMP();
        if constexpr (!Epi::AFTER_DRAIN) { E(acc, cur, wr, wc, fr, fq); S.done(cur); }
        PG8_STAMP();
        if (!has_next) break;
#pragma unroll
        for (int a = 0; a < 2; ++a)
#pragma unroll
            for (int b = 0; b < 2; ++b)
#pragma unroll
                for (int m = 0; m < 4; ++m)
#pragma unroll
                    for (int n = 0; n < 2; ++n) acc[a][b][m][n] = (f32x4){0.f, 0.f, 0.f, 0.f};
        cur = nxt; cA = nA; cB = nB; ++ui;
    }
    PG8_WAIT_V(0);
    if (wr == 0) PG8_BAR;
    PG8_BAR;
    if constexpr (Epi::AFTER_DRAIN) { E.fused(acc, cur, wr, wc, fr, fq, lds, wid, lane); S.done(cur); }
    PG8_STAMP();
    if (STAMP && wid == 0) { stamps[lane] = lane < nts ? (((unsigned long long)(unsigned)ts_hi << 32) | (unsigned)ts_lo) : 0ull;
        if (lane == 62) stamps[62] = rt_entry; if (lane == 63) stamps[63] = (unsigned long long)wall_clock64(); }
#undef PG8_STAMP
#undef PG8_SA
#undef PG8_SB
#undef PG8_STAGE
#undef PG8_LDA
#undef PG8_LDB
#undef PG8_MMA
#undef PG8_WAIT_V
#undef PG8_WAIT_L
#undef PG8_BAR
#undef PG8_SCHED
#undef PG8_ABASE
#undef PG8_BBASE
}

}

using pg8::bf16_t; using pg8::bf16x8; using pg8::f32x4; using pg8::f32x2_nat;
#define LAS __attribute__((address_space(3)))
#ifndef N_LAUNCH_MODE
#define N_LAUNCH_MODE 0
#endif
constexpr int T = 32768, D = 1024, SEQ = 4096, NMEMR = 2048, DIN = 4104, NP = 4096, DFF = 2816, NUP = 5632, TH = 16384;
constexpr float ALPHA = 1.189207115002721f, LN_EPS = 1e-5f;
constexpr int HQ = 0, HF = 512, HI = 1024, HG = 1536, MQ = 2048, MK = 2560, MV = 3072, MO = 3584;
constexpr size_t MiB = 1ull << 20;
constexpr size_t WS_WIN = 0, WS_WOUT = 8 * MiB, WS_WQ = 10 * MiB, WS_WKV = 12 * MiB, WS_WO = 16 * MiB, WS_WUP = 18 * MiB, WS_WDN = 29 * MiB,
                 WS_GATES = 35 * MiB, WS_MEMB = 36 * MiB, WS_KB = 40 * MiB, WS_VT = 44 * MiB,
                 WS_XB = 50 * MiB  , WS_PROJ = 114 * MiB, WS_X1 = 114 * MiB, WS_X1B = 242 * MiB  , WS_QB = 306 * MiB,
                 WS_UB = 50 * MiB, WS_HB = 306 * MiB, WS_Y = 370 * MiB, WS_BAR = 49 * MiB;
constexpr size_t WS_ST1 = 483 * MiB, WS_ST2 = WS_ST1 + 256 * 1024, WS_CV = WS_ST1 + 512 * 1024;
constexpr int LDS_BYTES = 144 * 1024;
constexpr int NPH = 16;
struct Args { const float* in[23]; float* out; unsigned char* ws; int ph_lo, ph_hi; };

#define WAVE_LDS_SYNC() asm volatile("s_waitcnt lgkmcnt(0)" ::: "memory")
__device__ __forceinline__ unsigned pk2(float a, float b) { return pg8::cvt_pk_bf16(a, b); }
__device__ __forceinline__ bf16_t f2bf(float a) { return (bf16_t)(pk2(a, a) & 0xffffu); }
__device__ __forceinline__ float bf2f(bf16_t u) { return __uint_as_float(((unsigned)u) << 16); }
__device__ __forceinline__ float bflo(unsigned u) { return __uint_as_float(u << 16); }
__device__ __forceinline__ float bfhi(unsigned u) { return __uint_as_float(u & 0xffff0000u); }
__device__ __forceinline__ float wave_sum(float v) {
#pragma unroll
    for (int o = 1; o < 64; o <<= 1) v += __shfl_xor(v, o);
    return v;
}
__device__ __forceinline__ float sigm(float x) { return __builtin_amdgcn_rcpf(1.f + __expf(-x)); }
__device__ __forceinline__ float gelu_tanh(float x) { const float u = 0.7978845608028654f * (x + 0.044715f * x * x * x); const float th = 1.f - 2.f * __builtin_amdgcn_rcpf(1.f + __expf(2.f * u)); return 0.5f * x * (1.f + th); }

__device__ __forceinline__ void transpose_item(const float* W, int ldw, int K, int N, bf16_t* WT, LAS float* scr, int item, int lane, const float* gsc = nullptr, const float* bsc = nullptr, float* c1 = nullptr, float* c2 = nullptr) {
    const int nblk = N / 32, kb = item / nblk, nb = item % nblk, k0 = 64 * kb, n0 = 32 * nb;
    if (gsc) {
        float s1 = 0.f, s2 = 0.f;
#pragma unroll 8
        for (int i = 0; i < 32; ++i) { const int kk = 2 * i + (lane >> 5); const float wv = W[(size_t)(k0 + kk) * ldw + n0 + (lane & 31)]; const float gw = wv * gsc[k0 + kk];
            s1 += gw; s2 += wv * bsc[k0 + kk]; scr[kk * 33 + (lane & 31)] = gw; }
        s1 += __shfl_xor(s1, 32); s2 += __shfl_xor(s2, 32);
        if (lane < 32) { atomicAdd(c1 + n0 + lane, s1); atomicAdd(c2 + n0 + lane, s2); }
    } else {
#pragma unroll 8
    for (int i = 0; i < 32; ++i) { const int kk = 2 * i + (lane >> 5); scr[kk * 33 + (lane & 31)] = W[(size_t)(k0 + kk) * ldw + n0 + (lane & 31)]; }
    }
    WAVE_LDS_SYNC();
    const int c = lane & 7;
#pragma unroll
    for (int j = 0; j < 4; ++j) { const int n = (lane >> 3) + 8 * j; const LAS float* s = scr + (8 * c) * 33 + n;
        uint4 o; o.x = pk2(s[0 * 33], s[1 * 33]); o.y = pk2(s[2 * 33], s[3 * 33]); o.z = pk2(s[4 * 33], s[5 * 33]); o.w = pk2(s[6 * 33], s[7 * 33]);
        *(uint4*)(WT + (size_t)(n0 + n) * K + k0 + 8 * c) = o; }
    WAVE_LDS_SYNC();
}
__device__ __forceinline__ void p0_prep(const Args& a, LAS unsigned char* lds, int tid, int wave, int lane, int gw, int NGW) {
    unsigned char* ws = a.ws;
    LAS float* wgT = (LAS float*)lds;
    LAS float* scr = (LAS float*)(lds + 32768 + wave * 8448);
    const float* w_in = a.in[2];
    for (int e = tid; e < 8192; e += 512) { const int k = e >> 3, c = e & 7; wgT[c * 1024 + k] = w_in[(size_t)k * DIN + 4096 + c]; }
    __syncthreads();
    constexpr int I_IN = 16 * 128, I_KV = 16 * 64;
    for (int it = gw; it < I_IN + I_KV; it += NGW) {
        if (it < I_IN) transpose_item(a.in[2], DIN, D, NP, (bf16_t*)(ws + WS_WIN), scr, it, lane);
        else transpose_item(a.in[13], 2 * D, D, 2 * D, (bf16_t*)(ws + WS_WKV), scr, it - I_IN, lane);
    }
    for (int i = (gw * 64 + lane); i < (512 * 1024 + 64 * 1024) / 16; i += NGW * 64) ((uint4*)(ws + WS_ST1))[i] = make_uint4(0u, 0u, 0u, 0u);
    const float* x = a.in[0]; const float* b_in = a.in[3];
    bf16_t* xb = (bf16_t*)(ws + WS_XB); float* gates = (float*)(ws + WS_GATES);
    f32x4 xn[4];
    if (gw < T) {
#pragma unroll
        for (int j = 0; j < 4; ++j) xn[j] = ((const f32x4*)(x + (size_t)gw * D) + lane)[64 * j]; }
    for (int m = gw; m < T; m += NGW) {
        uint2* xo = (uint2*)(xb + (size_t)m * D) + lane;
        f32x4 xc[4];
#pragma unroll
        for (int j = 0; j < 4; ++j) xc[j] = xn[j];
        if (m + NGW < T) {
#pragma unroll
            for (int j = 0; j < 4; ++j) xn[j] = ((const f32x4*)(x + (size_t)(m + NGW) * D) + lane)[64 * j]; }
        float g[8];
#pragma unroll
        for (int c = 0; c < 8; ++c) g[c] = 0.f;
#pragma unroll
        for (int j = 0; j < 4; ++j) { const f32x4 v = xc[j]; uint2 o; o.x = pk2(v[0], v[1]); o.y = pk2(v[2], v[3]); xo[64 * j] = o;
#pragma unroll
            for (int c = 0; c < 8; ++c) { const f32x4 w = *(const LAS f32x4*)(wgT + c * 1024 + 4 * (lane + 64 * j)); g[c] += (v[0] * w[0] + v[1] * w[1]) + (v[2] * w[2] + v[3] * w[3]); } }
#pragma unroll
        for (int c = 0; c < 8; ++c) g[c] = wave_sum(g[c]);
        float r = g[0];
#pragma unroll
        for (int c = 1; c < 8; ++c) r = (lane == c) ? g[c] : r;
        if (lane < 8) gates[(size_t)m * 8 + lane] = r + b_in[4096 + lane];
    }
    const float* mem = a.in[1]; bf16_t* memb = (bf16_t*)(ws + WS_MEMB);
    for (int m = gw; m < NMEMR; m += NGW) {
        const f32x4* xr = (const f32x4*)(mem + (size_t)m * D) + lane; uint2* xo = (uint2*)(memb + (size_t)m * D) + lane;
#pragma unroll
        for (int j = 0; j < 4; ++j) { const f32x4 v = xr[64 * j]; uint2 o; o.x = pk2(v[0], v[1]); o.y = pk2(v[2], v[3]); xo[64 * j] = o; }
    }
}

__device__ __forceinline__ void late_prep(const Args& a, LAS unsigned char* lds, int wave, int lane, int gw2, int NGW2) {
    unsigned char* ws = a.ws; LAS float* scr = (LAS float*)(lds + 32768 + wave * 8448);
    constexpr int I_SQ = 16 * 32, I_UP = 16 * 176, I_DN = 44 * 32;
    for (int it = gw2; it < 3 * I_SQ + I_UP + I_DN; it += NGW2) {
        int r = it;
        if (r < I_SQ) { transpose_item(a.in[9], D, D, D, (bf16_t*)(ws + WS_WOUT), scr, r, lane); continue; } r -= I_SQ;
        if (r < I_SQ) { transpose_item(a.in[12], D, D, D, (bf16_t*)(ws + WS_WQ), scr, r, lane, a.in[10], a.in[11], (float*)(ws + WS_CV), (float*)(ws + WS_CV) + 1024); continue; } r -= I_SQ;
        if (r < I_SQ) { transpose_item(a.in[14], D, D, D, (bf16_t*)(ws + WS_WO), scr, r, lane); continue; } r -= I_SQ;
        if (r < I_UP) { transpose_item(a.in[17], NUP, D, NUP, (bf16_t*)(ws + WS_WUP), scr, r, lane); continue; } r -= I_UP;
        transpose_item(a.in[20], D, DFF, D, (bf16_t*)(ws + WS_WDN), scr, r, lane);
    }
}
__device__ __forceinline__ void hgrn2_rec(const Args& a, int b, int h, LAS float* lds, int tid, int wave, int lane) {
    const bf16_t* projb = (const bf16_t*)(a.ws + WS_PROJ); bf16_t* y = (bf16_t*)(a.ws + WS_Y);
    const float* lbl = a.in[4]; const float* nw = a.in[5];
    LAS float* sq = lds; LAS float* sf = lds + 2048; LAS float* sv = lds + 4096; LAS float* spart = lds + 6144;
    const int v = tid & 127, g = tid >> 7;
    const float l0 = lbl[h * 128 + v], l1 = lbl[512 + h * 128 + v]; const float lb = 1.f / (1.f + __expf(l1 - l0));
    float S[32];
#pragma unroll
    for (int i = 0; i < 32; ++i) S[i] = 0.f;
    for (int t0 = 0; t0 < SEQ; t0 += 16) {
#pragma unroll
        for (int i = 0; i < 4; ++i) { const int tt = g + 4 * i; const bf16_t* pr = projb + (size_t)(b * SEQ + t0 + tt) * NP + h * 128 + v;
            const float hq = bf2f(pr[HQ]), hf = bf2f(pr[HF]), hi = bf2f(pr[HI]);
            sq[tt * 128 + v] = hq * sigm(hq); sf[tt * 128 + v] = lb + (1.f - lb) * sigm(hf); sv[tt * 128 + v] = hi; }
        __syncthreads();
        for (int tt = 0; tt < 16; ++tt) { const float vv = sv[tt * 128 + v]; float part = 0.f;
#pragma unroll
            for (int i = 0; i < 32; i += 4) { const f32x4 f4 = *(const LAS f32x4*)(sf + tt * 128 + g * 32 + i), q4 = *(const LAS f32x4*)(sq + tt * 128 + g * 32 + i);
#pragma unroll
                for (int jj = 0; jj < 4; ++jj) { S[i + jj] = f4[jj] * S[i + jj] + (1.f - f4[jj]) * vv; part += q4[jj] * S[i + jj]; } }
            spart[(tt * 4 + g) * 128 + v] = part; }
        __syncthreads();
#pragma unroll
        for (int q = 0; q < 2; ++q) { const int tt = 2 * wave + q; const size_t row = (size_t)(b * SEQ + t0 + tt);
            float o0 = 0.f, o1 = 0.f;
#pragma unroll
            for (int gg = 0; gg < 4; ++gg) { o0 += spart[(tt * 4 + gg) * 128 + lane]; o1 += spart[(tt * 4 + gg) * 128 + lane + 64]; }
            const float rstd = rsqrtf(wave_sum(o0 * o0 + o1 * o1) * (1.f / 128.f) + LN_EPS);
            const float g0 = bf2f(projb[row * NP + HG + h * 128 + lane]), g1 = bf2f(projb[row * NP + HG + h * 128 + lane + 64]);
            y[row * D + h * 128 + lane] = f2bf(o0 * rstd * nw[h * 128 + lane] * (g0 * sigm(g0)));
            y[row * D + h * 128 + lane + 64] = f2bf(o1 * rstd * nw[h * 128 + lane + 64] * (g1 * sigm(g1))); }
    }
}
__device__ __forceinline__ void mlstm_rec(const Args& a, int b, int h, LAS float* lds, int tid, int wave, int lane) {
    const bf16_t* projb = (const bf16_t*)(a.ws + WS_PROJ); bf16_t* y = (bf16_t*)(a.ws + WS_Y); const float* gates = (const float*)(a.ws + WS_GATES);
    const float* cw = a.in[6]; const float* cb = a.in[7]; const float* nw = a.in[8];
    LAS float* sq = lds; LAS float* sk = lds + 2048; LAS float* sv = lds + 4096; LAS float* spart = lds + 6144;
    LAS float* sgi = lds + 6144 + 16 * 4 * 132; LAS float* sgf = sgi + 16; LAS float* smt = sgf + 16;
    const int v = tid & 127, g = tid >> 7;
    float cwq[4], cwk[4];
#pragma unroll
    for (int j = 0; j < 4; ++j) { cwq[j] = cw[j * 1024 + h * 128 + v]; cwk[j] = cw[j * 1024 + 512 + h * 128 + v]; }
    const float cbq = cb[h * 128 + v], cbk = cb[512 + h * 128 + v];
    float C[32], nn[32];
#pragma unroll
    for (int i = 0; i < 32; ++i) { C[i] = 0.f; nn[i] = 0.f; }
    float mrun = -1e30f;
    for (int t0 = 0; t0 < SEQ; t0 += 16) {
#pragma unroll
        for (int i = 0; i < 4; ++i) { const int tt = g + 4 * i, t = t0 + tt; const bf16_t* pr = projb + (size_t)(b * SEQ + t) * NP + h * 128 + v;
            float aq = cbq, ak = cbk;
#pragma unroll
            for (int j = 0; j < 4; ++j) { const int ts = t - 3 + j; if (ts >= 0) { const bf16_t* ps = pr - (size_t)(3 - j) * NP; aq += bf2f(ps[MQ]) * cwq[j]; ak += bf2f(ps[MK]) * cwk[j]; } }
            sq[tt * 128 + v] = aq * sigm(aq) * 0.08838834764831845f; sk[tt * 128 + v] = ak * sigm(ak); sv[tt * 128 + v] = bf2f(pr[MV]); }
        if (tid < 16) { const size_t row = (size_t)(b * SEQ + t0 + tid); const float mi = gates[row * 8 + h], mf = gates[row * 8 + 4 + h];
            sgi[tid] = mi; sgf[tid] = fminf(mf, 0.f) - log1pf(__expf(-fabsf(mf))); }
        __syncthreads();
        for (int tt = 0; tt < 16; ++tt) { const float vv = sv[tt * 128 + v];
            const float it = sgi[tt], lf = sgf[tt]; const float mnew = fmaxf(lf + mrun, it); const float fp = __expf(lf + mrun - mnew), ip = __expf(it - mnew); mrun = mnew;
            float part = 0.f, dpart = 0.f; const float iv = ip * vv;
#pragma unroll
            for (int i = 0; i < 32; i += 4) { const f32x4 k4 = *(const LAS f32x4*)(sk + tt * 128 + g * 32 + i), q4 = *(const LAS f32x4*)(sq + tt * 128 + g * 32 + i);
#pragma unroll
                for (int jj = 0; jj < 4; ++jj) { C[i + jj] = fp * C[i + jj] + iv * k4[jj]; nn[i + jj] = fp * nn[i + jj] + ip * k4[jj]; part += q4[jj] * C[i + jj]; dpart += q4[jj] * nn[i + jj]; } }
            spart[(tt * 4 + g) * 132 + v] = part; if (v == 0) spart[(tt * 4 + g) * 132 + 128] = dpart; if (tid == 0) smt[tt] = mnew; }
        __syncthreads();
#pragma unroll
        for (int q = 0; q < 2; ++q) { const int tt = 2 * wave + q; const size_t row = (size_t)(b * SEQ + t0 + tt);
            float o0 = 0.f, o1 = 0.f, den = 0.f;
#pragma unroll
            for (int gg = 0; gg < 4; ++gg) { o0 += spart[(tt * 4 + gg) * 132 + lane]; o1 += spart[(tt * 4 + gg) * 132 + lane + 64]; den += spart[(tt * 4 + gg) * 132 + 128]; }
            const float dn = 1.f / fmaxf(fabsf(den), __expf(-smt[tt]));
            o0 *= dn; o1 *= dn;
            const float mean = wave_sum(o0 + o1) * (1.f / 128.f); const float d0 = o0 - mean, d1 = o1 - mean;
            const float rstd = rsqrtf(wave_sum(d0 * d0 + d1 * d1) * (1.f / 128.f) + LN_EPS);
            const float g0 = bf2f(projb[row * NP + MO + h * 128 + lane]), g1 = bf2f(projb[row * NP + MO + h * 128 + lane + 64]);
            y[row * D + 512 + h * 128 + lane] = f2bf(sigm(g0) * d0 * rstd * nw[h * 128 + lane]);
            y[row * D + 512 + h * 128 + lane + 64] = f2bf(sigm(g1) * d1 * rstd * nw[h * 128 + lane + 64]); }
    }
}

constexpr int P128 = 136, P64 = 72;
typedef unsigned u32x2 __attribute__((ext_vector_type(2)));
typedef unsigned u32x4n __attribute__((ext_vector_type(4)));
__device__ __forceinline__ u32x2 pack4(float a, float b, float c, float d) { u32x2 r; r.x = pk2(a, b); r.y = pk2(c, d); return r; }
__device__ __forceinline__ void unpack4(u32x2 u, float (&o)[4]) { o[0] = bflo(u.x); o[1] = bfhi(u.x); o[2] = bflo(u.y); o[3] = bfhi(u.y); }
#define MFMA16(a, b, c) __builtin_amdgcn_mfma_f32_16x16x32_bf16(a, b, c, 0, 0, 0)
#define LDFRAG(base, row, pitch, ks) (*(const LAS bf16x8*)((base) + (row) * (pitch) + (ks) * 32 + quad * 8))

__device__ __forceinline__ void hgrn2_chunk(const Args& a, int b, int h, LAS unsigned char* lds, int tid, int w, int lane) {
    const bf16_t* projb = (const bf16_t*)(a.ws + WS_PROJ); bf16_t* y = (bf16_t*)(a.ws + WS_Y);
    const float* lbl = a.in[4]; const float* nw = a.in[5];
    LAS bf16_t* QD = (LAS bf16_t*)lds; LAS bf16_t* KD = QD + 64 * P128; LAS bf16_t* QB = KD + 64 * P128;
    LAS bf16_t* KLT = QB + 64 * P128; LAS bf16_t* VT = KLT + 128 * P64; LAS bf16_t* ATT = VT + 128 * P64; LAS bf16_t* ST = ATT + 64 * P64;
    LAS float* NRM = (LAS float*)(ST + 128 * P128);
    const int tg = lane >> 2, dg = lane & 3, quad = lane >> 4, r16 = lane & 15;
    const int tt = w >> 1, vh = w & 1;
    for (int e = tid; e < 128 * P128 / 2; e += 512) ((LAS unsigned*)ST)[e] = 0u;
    LAS float* NWL = NRM + 128;
    if (tid < 128) NWL[tid] = nw[h * 128 + tid];
    float lb[4];
#pragma unroll
    for (int k = 0; k < 4; ++k) { const int d = h * 128 + 16 * w + 4 * dg + k; lb[k] = __builtin_amdgcn_rcpf(1.f + __expf(lbl[512 + d] - lbl[d])); }
    f32x4 Sacc[8];
#pragma unroll
    for (int i = 0; i < 8; ++i) Sacc[i] = (f32x4){0.f, 0.f, 0.f, 0.f};
    const size_t rowbase = (size_t)b * SEQ;
    const bf16_t* pcol = projb + h * 128 + 16 * w + 4 * dg;
    const bf16_t* pgat = projb + HG + h * 128 + 64 * vh + 4 * quad;
    u32x2 rq[4], rf[4], rv[4], rg[4];
#pragma unroll
    for (int i = 0; i < 4; ++i) { const bf16_t* p = pcol + (rowbase + 4 * tg + i) * NP; rq[i] = *(const u32x2*)(p + HQ); rf[i] = *(const u32x2*)(p + HF); rv[i] = *(const u32x2*)(p + HI); }
#pragma unroll
    for (int vt = 0; vt < 4; ++vt) rg[vt] = *(const u32x2*)(pgat + (rowbase + 16 * tt + r16) * NP + 16 * vt);
    __syncthreads();
    for (int c = 0; c < 64; ++c) {
        float q[4][4], lf[4][4], kk[4][4], vv[4][4]; u32x2 rgc[4];
#pragma unroll
        for (int i = 0; i < 4; ++i) { float hq[4], hf[4]; unpack4(rq[i], hq); unpack4(rf[i], hf); unpack4(rv[i], vv[i]);
#pragma unroll
            for (int k = 0; k < 4; ++k) { q[i][k] = hq[k]; const float f = lb[k] + (1.f - lb[k]) * sigm(hf[k]); lf[i][k] = __logf(f); kk[i][k] = 1.f - f; } }
#pragma unroll
        for (int vt = 0; vt < 4; ++vt) rgc[vt] = rg[vt];
        float bref[4], blast[4], dec[4];
#pragma unroll
        for (int k = 0; k < 4; ++k) {
            lf[1][k] += lf[0][k]; lf[2][k] += lf[1][k]; lf[3][k] += lf[2][k];
            const float tot = lf[3][k]; float run = tot;
#pragma unroll
            for (int off = 4; off < 64; off <<= 1) { const float t2 = __shfl_up(run, off); if (lane >= off) run += t2; }
            const float excl = run - tot;
#pragma unroll
            for (int i = 0; i < 4; ++i) lf[i][k] += excl;
            bref[k] = __shfl(lf[3][k], 28 + dg); blast[k] = __shfl(lf[3][k], 60 + dg);
        }
#pragma unroll
        for (int j = 0; j < 4; ++j) { float e = __expf(blast[0]); e = (j == 1) ? __expf(blast[1]) : e; e = (j == 2) ? __expf(blast[2]) : e; e = (j == 3) ? __expf(blast[3]) : e; dec[j] = __shfl(e, 60 + quad); }
        {
            float eref[4], elast[4];
#pragma unroll
            for (int k = 0; k < 4; ++k) { eref[k] = __expf(bref[k]); elast[k] = __expf(blast[k] - bref[k]); }
            float kl[4][4];
#pragma unroll
            for (int i = 0; i < 4; ++i) { float qd[4], kd[4], qb[4];
#pragma unroll
                for (int k = 0; k < 4; ++k) { const float e1 = __expf(lf[i][k] - bref[k]), e2 = __expf(bref[k] - lf[i][k]);
                    qd[k] = q[i][k] * e1; kd[k] = kk[i][k] * e2; qb[k] = qd[k] * eref[k]; kl[i][k] = kd[k] * elast[k]; }
                const int off = (4 * tg + i) * P128 + 16 * w + 4 * dg;
                *(LAS u32x2*)(QD + off) = pack4(qd[0], qd[1], qd[2], qd[3]); *(LAS u32x2*)(KD + off) = pack4(kd[0], kd[1], kd[2], kd[3]); *(LAS u32x2*)(QB + off) = pack4(qb[0], qb[1], qb[2], qb[3]); }
#pragma unroll
            for (int k = 0; k < 4; ++k) { const int off = (16 * w + 4 * dg + k) * P64 + 4 * tg;
                *(LAS u32x2*)(KLT + off) = pack4(kl[0][k], kl[1][k], kl[2][k], kl[3][k]); *(LAS u32x2*)(VT + off) = pack4(vv[0][k], vv[1][k], vv[2][k], vv[3][k]); }
        }
        __syncthreads();
        { const int cn = (c + 1 < 64) ? c + 1 : 63;
#pragma unroll
            for (int i = 0; i < 4; ++i) { const bf16_t* p = pcol + (rowbase + cn * 64 + 4 * tg + i) * NP; rq[i] = *(const u32x2*)(p + HQ); rf[i] = *(const u32x2*)(p + HF); rv[i] = *(const u32x2*)(p + HI); }
#pragma unroll
            for (int vt = 0; vt < 4; ++vt) rg[vt] = *(const u32x2*)(pgat + (rowbase + cn * 64 + 16 * tt + r16) * NP + 16 * vt); }
        {
            bf16x8 qf[4];
#pragma unroll
            for (int ks = 0; ks < 4; ++ks) qf[ks] = LDFRAG(QD, 16 * tt + r16, P128, ks);
#pragma unroll
            for (int si = 0; si < 2; ++si) { const int st = 2 * vh + si; f32x4 acc = {0.f, 0.f, 0.f, 0.f};
                if (st <= tt) {
#pragma unroll
                    for (int ks = 0; ks < 4; ++ks) { const bf16x8 kf = LDFRAG(KD, 16 * st + r16, P128, ks); acc = MFMA16(kf, qf[ks], acc); }
                    const int t = 16 * tt + r16, s0 = 16 * st + 4 * quad;
#pragma unroll
                    for (int j = 0; j < 4; ++j) acc[j] = (s0 + j <= t) ? acc[j] : 0.f;
                }
                *(LAS u32x2*)(ATT + (16 * tt + r16) * P64 + 16 * st + 4 * quad) = pack4(acc[0], acc[1], acc[2], acc[3]); }
        }
        __syncthreads();
        f32x4 o[4];
        {
            bf16x8 af[2], qbf[4];
#pragma unroll
            for (int ks = 0; ks < 2; ++ks) af[ks] = LDFRAG(ATT, 16 * tt + r16, P64, ks);
#pragma unroll
            for (int ks = 0; ks < 4; ++ks) qbf[ks] = LDFRAG(QB, 16 * tt + r16, P128, ks);
            float ss = 0.f;
#pragma unroll
            for (int vt = 0; vt < 4; ++vt) { const int v0 = 64 * vh + 16 * vt; f32x4 acc = {0.f, 0.f, 0.f, 0.f};
#pragma unroll
                for (int ks = 0; ks < 2; ++ks) acc = MFMA16(LDFRAG(VT, v0 + r16, P64, ks), af[ks], acc);
#pragma unroll
                for (int ks = 0; ks < 4; ++ks) acc = MFMA16(LDFRAG(ST, v0 + r16, P128, ks), qbf[ks], acc);
                o[vt] = acc; ss += (acc[0] * acc[0] + acc[1] * acc[1]) + (acc[2] * acc[2] + acc[3] * acc[3]); }
            ss += __shfl_xor(ss, 16); ss += __shfl_xor(ss, 32);
            if (quad == 0) NRM[(16 * tt + r16) * 2 + vh] = ss;
            bf16x8 klf[2];
#pragma unroll
            for (int ks = 0; ks < 2; ++ks) klf[ks] = LDFRAG(KLT, 16 * w + r16, P64, ks);
#pragma unroll
            for (int v8 = 0; v8 < 8; ++v8) { f32x4 acc = Sacc[v8];
#pragma unroll
                for (int j = 0; j < 4; ++j) acc[j] *= dec[j];
#pragma unroll
                for (int ks = 0; ks < 2; ++ks) acc = MFMA16(klf[ks], LDFRAG(VT, 16 * v8 + r16, P64, ks), acc);
                Sacc[v8] = acc; }
        }
        __syncthreads();
#pragma unroll
        for (int v8 = 0; v8 < 8; ++v8) *(LAS u32x2*)(ST + (16 * v8 + r16) * P128 + 16 * w + 4 * quad) = pack4(Sacc[v8][0], Sacc[v8][1], Sacc[v8][2], Sacc[v8][3]);
        {
            const int t = 16 * tt + r16; const float rstd = __builtin_amdgcn_rsqf((NRM[t * 2] + NRM[t * 2 + 1]) * (1.f / 128.f) + LN_EPS);
            bf16_t* yp = y + (rowbase + c * 64 + t) * D + h * 128 + 64 * vh + 4 * quad;
#pragma unroll
            for (int vt = 0; vt < 4; ++vt) { float r[4], gt[4]; unpack4(rgc[vt], gt); const f32x4 nv = *(const LAS f32x4*)(NWL + 64 * vh + 16 * vt + 4 * quad);
#pragma unroll
                for (int j = 0; j < 4; ++j) r[j] = o[vt][j] * rstd * nv[j] * gt[j];
                *(u32x2*)(yp + 16 * vt) = pack4(r[0], r[1], r[2], r[3]); }
        }
    }
    __syncthreads();
}

__device__ __forceinline__ void mlstm_chunk(const Args& a, int b, int h, LAS unsigned char* lds, int tid, int w, int lane) {
    const bf16_t* projb = (const bf16_t*)(a.ws + WS_PROJ); bf16_t* y = (bf16_t*)(a.ws + WS_Y); const float* gates = (const float*)(a.ws + WS_GATES);
    const float* cw = a.in[6]; const float* cb = a.in[7]; const float* nw = a.in[8];
    LAS bf16_t* QM = (LAS bf16_t*)lds; LAS bf16_t* KM = QM + 64 * P128; LAS bf16_t* QW = KM + 64 * P128;
    LAS bf16_t* KLT = QW + 64 * P128; LAS bf16_t* VT = KLT + 128 * P64; LAS bf16_t* ATT = VT + 144 * P64; LAS bf16_t* ST = ATT + 64 * P64;
    LAS float* NRM = (LAS float*)(ST + 144 * P128);
    const int tg = lane >> 2, dg = lane & 3, quad = lane >> 4, r16 = lane & 15;
    const int tt = w >> 1, vh = w & 1;
    for (int e = tid; e < 144 * P128 / 2; e += 512) ((LAS unsigned*)ST)[e] = 0u;
    for (int e = tid; e < 16 * P64 / 2; e += 512) ((LAS unsigned*)(VT + 128 * P64))[e] = (e < P64 / 2) ? 0x3F803F80u : 0u;
    LAS float* NWL = NRM + 256 + 1280;
    if (tid < 128) NWL[tid] = nw[h * 128 + tid];
    LAS float* CWT = NRM + 256;
    for (int e = tid; e < 1280; e += 512) { const int r = e >> 7, d = e & 127; CWT[e] = (r < 4) ? cw[r * 1024 + h * 128 + d] : (r < 8) ? cw[(r - 4) * 1024 + 512 + h * 128 + d] : (r == 8) ? cb[h * 128 + d] : cb[512 + h * 128 + d]; }
    f32x4 Cacc[9];
#pragma unroll
    for (int i = 0; i < 9; ++i) Cacc[i] = (f32x4){0.f, 0.f, 0.f, 0.f};
    float m_st = -1e30f;
    const size_t rowbase = (size_t)b * SEQ;
    const bf16_t* pcol = projb + h * 128 + 16 * w + 4 * dg;
    const bf16_t* pgat = projb + MO + h * 128 + 64 * vh + 4 * quad;
    u32x2 rq[7], rk[7], rv[4], rg[4]; float rmi, rmf;
#pragma unroll
    for (int i = 0; i < 7; ++i) { const int t = 4 * tg + i - 3; if (t >= 0) { const bf16_t* p = pcol + (rowbase + t) * NP; rq[i] = *(const u32x2*)(p + MQ); rk[i] = *(const u32x2*)(p + MK); } else { rq[i] = (u32x2){0u, 0u}; rk[i] = (u32x2){0u, 0u}; } }
#pragma unroll
    for (int i = 0; i < 4; ++i) rv[i] = *(const u32x2*)(pcol + (rowbase + 4 * tg + i) * NP + MV);
#pragma unroll
    for (int vt = 0; vt < 4; ++vt) rg[vt] = *(const u32x2*)(pgat + (rowbase + 16 * tt + r16) * NP + 16 * vt);
    rmi = gates[(rowbase + lane) * 8 + h]; rmf = gates[(rowbase + lane) * 8 + 4 + h];
    __syncthreads();
    for (int c = 0; c < 64; ++c) {
        const float mi = rmi, lfs = fminf(rmf, 0.f) - log1pf(__expf(-fabsf(rmf)));
        float bs = lfs;
#pragma unroll
        for (int off = 1; off < 64; off <<= 1) { const float t2 = __shfl_up(bs, off); if (lane >= off) bs += t2; }
        const float gsum = __shfl(bs, 63);
        const float imb = mi - bs; float pm = imb;
#pragma unroll
        for (int off = 1; off < 64; off <<= 1) { const float t2 = __shfl_up(pm, off); if (lane >= off) pm = fmaxf(pm, t2); }
        const float inter = bs + m_st, m_t = fmaxf(inter, pm + bs);
        const float w_inter = __expf(inter - m_t);
        const float m_new = fmaxf(gsum + m_st, gsum + __shfl(pm, 63));
        const float decay = __expf(gsum + m_st - m_new), aexp = __expf(gsum + imb - m_new);
        const float bm = bs - m_t;
        float qv[4][4], kv[4][4], vv[4][4]; u32x2 rgc[4];
        {
            const LAS float* cwp = CWT + 16 * w + 4 * dg;
            { float xq[7][4]; f32x4 wq[4];
#pragma unroll
                for (int i = 0; i < 7; ++i) unpack4(rq[i], xq[i]);
#pragma unroll
                for (int j = 0; j < 4; ++j) wq[j] = *(const LAS f32x4*)(cwp + j * 128);
                const f32x4 bq = *(const LAS f32x4*)(cwp + 8 * 128);
#pragma unroll
                for (int i = 0; i < 4; ++i)
#pragma unroll
                    for (int k = 0; k < 4; ++k) { float aq = bq[k];
#pragma unroll
                        for (int j = 0; j < 4; ++j) aq += xq[i + j][k] * wq[j][k];
                        qv[i][k] = aq * sigm(aq) * 0.08838834764831845f; } }
            { float xk[7][4]; f32x4 wk[4];
#pragma unroll
                for (int i = 0; i < 7; ++i) unpack4(rk[i], xk[i]);
#pragma unroll
                for (int j = 0; j < 4; ++j) wk[j] = *(const LAS f32x4*)(cwp + (4 + j) * 128);
                const f32x4 bk = *(const LAS f32x4*)(cwp + 9 * 128);
#pragma unroll
                for (int i = 0; i < 4; ++i)
#pragma unroll
                    for (int k = 0; k < 4; ++k) { float ak = bk[k];
#pragma unroll
                        for (int j = 0; j < 4; ++j) ak += xk[i + j][k] * wk[j][k];
                        kv[i][k] = ak * sigm(ak); } }
#pragma unroll
            for (int i = 0; i < 4; ++i) unpack4(rv[i], vv[i]);
#pragma unroll
            for (int vt = 0; vt < 4; ++vt) rgc[vt] = rg[vt];
        }
        {
            float wi[4], ae[4];
#pragma unroll
            for (int i = 0; i < 4; ++i) { wi[i] = __shfl(w_inter, 4 * tg + i); ae[i] = __shfl(aexp, 4 * tg + i); }
#pragma unroll
            for (int i = 0; i < 4; ++i) { const int off = (4 * tg + i) * P128 + 16 * w + 4 * dg;
                *(LAS u32x2*)(QM + off) = pack4(qv[i][0], qv[i][1], qv[i][2], qv[i][3]); *(LAS u32x2*)(KM + off) = pack4(kv[i][0], kv[i][1], kv[i][2], kv[i][3]);
                *(LAS u32x2*)(QW + off) = pack4(qv[i][0] * wi[i], qv[i][1] * wi[i], qv[i][2] * wi[i], qv[i][3] * wi[i]); }
#pragma unroll
            for (int k = 0; k < 4; ++k) { const int off = (16 * w + 4 * dg + k) * P64 + 4 * tg;
                *(LAS u32x2*)(KLT + off) = pack4(kv[0][k] * ae[0], kv[1][k] * ae[1], kv[2][k] * ae[2], kv[3][k] * ae[3]); *(LAS u32x2*)(VT + off) = pack4(vv[0][k], vv[1][k], vv[2][k], vv[3][k]); }
        }
        __syncthreads();
        { const int cn = (c + 1 < 64) ? c + 1 : 63; const size_t rb = rowbase + cn * 64;
#pragma unroll
            for (int i = 0; i < 7; ++i) { const bf16_t* p = pcol + (rb + 4 * tg + i - 3) * NP; rq[i] = *(const u32x2*)(p + MQ); rk[i] = *(const u32x2*)(p + MK); }
#pragma unroll
            for (int i = 0; i < 4; ++i) rv[i] = *(const u32x2*)(pcol + (rb + 4 * tg + i) * NP + MV);
#pragma unroll
            for (int vt = 0; vt < 4; ++vt) rg[vt] = *(const u32x2*)(pgat + (rb + 16 * tt + r16) * NP + 16 * vt);
            rmi = gates[(rb + lane) * 8 + h]; rmf = gates[(rb + lane) * 8 + 4 + h]; }
        {
            bf16x8 qf[4];
#pragma unroll
            for (int ks = 0; ks < 4; ++ks) qf[ks] = LDFRAG(QM, 16 * tt + r16, P128, ks);
            const float bmt = __shfl(bm, 16 * tt + r16);
#pragma unroll
            for (int si = 0; si < 2; ++si) { const int st = 2 * vh + si; f32x4 acc = {0.f, 0.f, 0.f, 0.f};
                if (st <= tt) {
#pragma unroll
                    for (int ks = 0; ks < 4; ++ks) { const bf16x8 kf = LDFRAG(KM, 16 * st + r16, P128, ks); acc = MFMA16(kf, qf[ks], acc); }
                    const int t = 16 * tt + r16, s0 = 16 * st + 4 * quad;
#pragma unroll
                    for (int j = 0; j < 4; ++j) { const float ims = __shfl(imb, s0 + j); acc[j] = (s0 + j <= t) ? acc[j] * __expf(bmt + ims) : 0.f; }
                }
                *(LAS u32x2*)(ATT + (16 * tt + r16) * P64 + 16 * st + 4 * quad) = pack4(acc[0], acc[1], acc[2], acc[3]); }
        }
        __syncthreads();
        f32x4 o[4];
        {
            bf16x8 af[2], qwf[4];
#pragma unroll
            for (int ks = 0; ks < 2; ++ks) af[ks] = LDFRAG(ATT, 16 * tt + r16, P64, ks);
#pragma unroll
            for (int ks = 0; ks < 4; ++ks) qwf[ks] = LDFRAG(QW, 16 * tt + r16, P128, ks);
            f32x4 ae4 = {0.f, 0.f, 0.f, 0.f};
#pragma unroll
            for (int ks = 0; ks < 2; ++ks) ae4 = MFMA16(LDFRAG(VT, 128 + r16, P64, ks), af[ks], ae4);
#pragma unroll
            for (int ks = 0; ks < 4; ++ks) ae4 = MFMA16(LDFRAG(ST, 128 + r16, P128, ks), qwf[ks], ae4);
            const float den = __shfl(ae4[0], r16);
            const float mt_t = __shfl(m_t, 16 * tt + r16);
            const float dn = __builtin_amdgcn_rcpf(fmaxf(fabsf(den), __expf(-mt_t)));
            float s1 = 0.f, s2 = 0.f;
#pragma unroll
            for (int vt = 0; vt < 4; ++vt) { const int v0 = 64 * vh + 16 * vt; f32x4 acc = {0.f, 0.f, 0.f, 0.f};
#pragma unroll
                for (int ks = 0; ks < 2; ++ks) acc = MFMA16(LDFRAG(VT, v0 + r16, P64, ks), af[ks], acc);
#pragma unroll
                for (int ks = 0; ks < 4; ++ks) acc = MFMA16(LDFRAG(ST, v0 + r16, P128, ks), qwf[ks], acc);
                acc = acc * dn; o[vt] = acc; s1 += (acc[0] + acc[1]) + (acc[2] + acc[3]); s2 += (acc[0] * acc[0] + acc[1] * acc[1]) + (acc[2] * acc[2] + acc[3] * acc[3]); }
            s1 += __shfl_xor(s1, 16); s1 += __shfl_xor(s1, 32); s2 += __shfl_xor(s2, 16); s2 += __shfl_xor(s2, 32);
            if (quad == 0) { NRM[(16 * tt + r16) * 4 + 2 * vh] = s1; NRM[(16 * tt + r16) * 4 + 2 * vh + 1] = s2; }
            bf16x8 klf[2];
#pragma unroll
            for (int ks = 0; ks < 2; ++ks) klf[ks] = LDFRAG(KLT, 16 * w + r16, P64, ks);
#pragma unroll
            for (int v9 = 0; v9 < 9; ++v9) { f32x4 acc = Cacc[v9] * decay;
#pragma unroll
                for (int ks = 0; ks < 2; ++ks) acc = MFMA16(klf[ks], LDFRAG(VT, 16 * v9 + r16, P64, ks), acc);
                Cacc[v9] = acc; }
        }
        __syncthreads();
#pragma unroll
        for (int v9 = 0; v9 < 9; ++v9) *(LAS u32x2*)(ST + (16 * v9 + r16) * P128 + 16 * w + 4 * quad) = pack4(Cacc[v9][0], Cacc[v9][1], Cacc[v9][2], Cacc[v9][3]);
        {
            const int t = 16 * tt + r16; const float mean = (NRM[t * 4] + NRM[t * 4 + 2]) * (1.f / 128.f); const float var = fmaxf((NRM[t * 4 + 1] + NRM[t * 4 + 3]) * (1.f / 128.f) - mean * mean, 0.f);
            const float rstd = __builtin_amdgcn_rsqf(var + LN_EPS);
            bf16_t* yp = y + (rowbase + c * 64 + t) * D + 512 + h * 128 + 64 * vh + 4 * quad;
#pragma unroll
            for (int vt = 0; vt < 4; ++vt) { float r[4], gt[4]; unpack4(rgc[vt], gt); const f32x4 nv = *(const LAS f32x4*)(NWL + 64 * vh + 16 * vt + 4 * quad);
#pragma unroll
                for (int j = 0; j < 4; ++j) r[j] = gt[j] * (o[vt][j] - mean) * rstd * nv[j];
                *(u32x2*)(yp + 16 * vt) = pack4(r[0], r[1], r[2], r[3]); }
        }
        m_st = m_new;
    }
    __syncthreads();
}

__device__ __forceinline__ unsigned xcc_id() { return (unsigned)__builtin_amdgcn_s_getreg((3 << 11) | 20) & 0xFu; }
__device__ __forceinline__ void grid_bar(unsigned* bar, unsigned xcc, unsigned nxb, unsigned nx, unsigned round) {
    asm volatile("s_waitcnt vmcnt(0)" ::: "memory");
    __syncthreads();
    if (threadIdx.x == 0) {
        const unsigned prev = __hip_atomic_fetch_add(bar + 64 * (1 + xcc), 1u, __ATOMIC_RELAXED, __HIP_MEMORY_SCOPE_AGENT);
        if (prev + 1u == round * nxb) {
            __builtin_amdgcn_fence(__ATOMIC_RELEASE, "agent");
            asm volatile("s_waitcnt vmcnt(0)" ::: "memory");
            __hip_atomic_fetch_add(bar, 1u, __ATOMIC_RELAXED, __HIP_MEMORY_SCOPE_AGENT);
        }
        while (__hip_atomic_load(bar, __ATOMIC_RELAXED, __HIP_MEMORY_SCOPE_AGENT) < round * nx) __builtin_amdgcn_s_sleep(1);
        __builtin_amdgcn_fence(__ATOMIC_ACQUIRE, "agent");
        asm volatile("s_waitcnt vmcnt(0)" ::: "memory");
    }
    __syncthreads();
}
constexpr size_t WS_ATH = 434 * MiB, WS_ATM = 450 * MiB, WS_DECH = 466 * MiB, WS_SCM = 467 * MiB;
__device__ __forceinline__ void hgrn2_pre(const Args& a, int b, int h, int c, LAS unsigned char* lds, int tid, int w, int lane) {
    const bf16_t* projb = (const bf16_t*)(a.ws + WS_PROJ); const float* lbl = a.in[4];
    bf16_t* QBH = (bf16_t*)a.out; bf16_t* KLH = QBH + (size_t)T * 512; bf16_t* ATH = (bf16_t*)(a.ws + WS_ATH); float* DECH = (float*)(a.ws + WS_DECH);
    LAS bf16_t* QD = (LAS bf16_t*)lds; LAS bf16_t* KD = QD + 64 * P128;
    const int tg = lane >> 2, dg = lane & 3, quad = lane >> 4, r16 = lane & 15, tt = w >> 1, vh = w & 1;
    const size_t item = (size_t)((b * 4 + h) * 64 + c), row0 = (size_t)b * SEQ + c * 64;
    float lb[4];
#pragma unroll
    for (int k = 0; k < 4; ++k) { const int d = h * 128 + 16 * w + 4 * dg + k; lb[k] = __builtin_amdgcn_rcpf(1.f + __expf(lbl[512 + d] - lbl[d])); }
    const bf16_t* pcol = projb + h * 128 + 16 * w + 4 * dg;
    float q[4][4], lf[4][4], kk[4][4];
#pragma unroll
    for (int i = 0; i < 4; ++i) { const bf16_t* p = pcol + (row0 + 4 * tg + i) * NP; float hq[4], hf[4]; unpack4(*(const u32x2*)(p + HQ), hq); unpack4(*(const u32x2*)(p + HF), hf);
#pragma unroll
        for (int k = 0; k < 4; ++k) { q[i][k] = hq[k]; const float f = lb[k] + (1.f - lb[k]) * sigm(hf[k]); lf[i][k] = __logf(f); kk[i][k] = 1.f - f; } }
    float bref[4], blast[4];
#pragma unroll
    for (int k = 0; k < 4; ++k) {
        lf[1][k] += lf[0][k]; lf[2][k] += lf[1][k]; lf[3][k] += lf[2][k];
        const float tot = lf[3][k]; float run = tot;
#pragma unroll
        for (int off = 4; off < 64; off <<= 1) { const float t2 = __shfl_up(run, off); if (lane >= off) run += t2; }
        const float excl = run - tot;
#pragma unroll
        for (int i = 0; i < 4; ++i) lf[i][k] += excl;
        bref[k] = __shfl(lf[3][k], 28 + dg); blast[k] = __shfl(lf[3][k], 60 + dg);
    }
    {
        float eref[4], elast[4];
#pragma unroll
        for (int k = 0; k < 4; ++k) { eref[k] = __expf(bref[k]); elast[k] = __expf(blast[k] - bref[k]); }
        if (tg == 15) *(f32x4*)(DECH + item * 128 + 16 * w + 4 * dg) = (f32x4){__expf(blast[0]), __expf(blast[1]), __expf(blast[2]), __expf(blast[3])};
        float kl[4][4];
#pragma unroll
        for (int i = 0; i < 4; ++i) { float qd[4], kd[4], qb[4];
#pragma unroll
            for (int k = 0; k < 4; ++k) { const float e1 = __expf(lf[i][k] - bref[k]), e2 = __expf(bref[k] - lf[i][k]);
                qd[k] = q[i][k] * e1; kd[k] = kk[i][k] * e2; qb[k] = qd[k] * eref[k]; kl[i][k] = kd[k] * elast[k]; }
            const int off = (4 * tg + i) * P128 + 16 * w + 4 * dg;
            *(LAS u32x2*)(QD + off) = pack4(qd[0], qd[1], qd[2], qd[3]); *(LAS u32x2*)(KD + off) = pack4(kd[0], kd[1], kd[2], kd[3]);
            *(u32x2*)(QBH + (row0 + 4 * tg + i) * 512 + h * 128 + 16 * w + 4 * dg) = pack4(qb[0], qb[1], qb[2], qb[3]); }
#pragma unroll
        for (int k = 0; k < 4; ++k) *(u32x2*)(KLH + item * 8192 + (16 * w + 4 * dg + k) * 64 + 4 * tg) = pack4(kl[0][k], kl[1][k], kl[2][k], kl[3][k]);
    }
    __syncthreads();
    {
        bf16x8 qf[4];
#pragma unroll
        for (int ks = 0; ks < 4; ++ks) qf[ks] = LDFRAG(QD, 16 * tt + r16, P128, ks);
#pragma unroll
        for (int si = 0; si < 2; ++si) { const int st = 2 * vh + si; f32x4 acc = {0.f, 0.f, 0.f, 0.f};
            if (st <= tt) {
#pragma unroll
                for (int ks = 0; ks < 4; ++ks) { const bf16x8 kf = LDFRAG(KD, 16 * st + r16, P128, ks); acc = MFMA16(kf, qf[ks], acc); }
                const int t = 16 * tt + r16, s0 = 16 * st + 4 * quad;
#pragma unroll
                for (int j = 0; j < 4; ++j) acc[j] = (s0 + j <= t) ? acc[j] : 0.f;
            }
            *(u32x2*)(ATH + item * 4096 + (16 * tt + r16) * 64 + 16 * st + 4 * quad) = pack4(acc[0], acc[1], acc[2], acc[3]); }
    }
    __syncthreads();
}
__device__ __forceinline__ void mlstm_pre(const Args& a, int b, int h, int c, LAS unsigned char* lds, int tid, int w, int lane) {
    const bf16_t* projb = (const bf16_t*)(a.ws + WS_PROJ); const float* gates = (const float*)(a.ws + WS_GATES);
    const float* cw = a.in[6]; const float* cb = a.in[7];
    bf16_t* QMM = (bf16_t*)a.out + (size_t)T * 1024; bf16_t* KLM = QMM + (size_t)T * 512; bf16_t* ATM = (bf16_t*)(a.ws + WS_ATM); float* SCM = (float*)(a.ws + WS_SCM);
    LAS bf16_t* QM = (LAS bf16_t*)lds; LAS bf16_t* KM = QM + 64 * P128;
    const int tg = lane >> 2, dg = lane & 3, quad = lane >> 4, r16 = lane & 15, tt = w >> 1, vh = w & 1;
    const size_t item = (size_t)((b * 4 + h) * 64 + c), row0 = (size_t)b * SEQ + c * 64;
    const float mi = gates[(row0 + lane) * 8 + h], mf = gates[(row0 + lane) * 8 + 4 + h];
    float bs = fminf(mf, 0.f) - log1pf(__expf(-fabsf(mf)));
#pragma unroll
    for (int off = 1; off < 64; off <<= 1) { const float t2 = __shfl_up(bs, off); if (lane >= off) bs += t2; }
    const float imb = mi - bs; float pm = imb;
#pragma unroll
    for (int off = 1; off < 64; off <<= 1) { const float t2 = __shfl_up(pm, off); if (lane >= off) pm = fmaxf(pm, t2); }
    const float pm63 = __shfl(pm, 63);
    if (w == 0) { f32x2_nat o2 = {bs, pm}; *(f32x2_nat*)(SCM + (row0 + lane) * 8 + h * 2) = o2; }
    const float aloc = __expf(imb - pm63);
    const bf16_t* pcol = projb + h * 128 + 16 * w + 4 * dg; const int ch = h * 128 + 16 * w + 4 * dg;
    float qv[4][4], kv[4][4];
    {
        float xq[7][4], xk[7][4];
#pragma unroll
        for (int i = 0; i < 7; ++i) { const int tpos = c * 64 + 4 * tg + i - 3;
            if (tpos >= 0) { const bf16_t* p = pcol + ((size_t)b * SEQ + tpos) * NP; unpack4(*(const u32x2*)(p + MQ), xq[i]); unpack4(*(const u32x2*)(p + MK), xk[i]); }
            else {
#pragma unroll
                for (int k = 0; k < 4; ++k) { xq[i][k] = 0.f; xk[i][k] = 0.f; } } }
        f32x4 wq[4], wk[4];
#pragma unroll
        for (int j = 0; j < 4; ++j) { wq[j] = *(const f32x4*)(cw + j * 1024 + ch); wk[j] = *(const f32x4*)(cw + j * 1024 + 512 + ch); }
        const f32x4 bq = *(const f32x4*)(cb + ch), bk = *(const f32x4*)(cb + 512 + ch);
#pragma unroll
        for (int i = 0; i < 4; ++i)
#pragma unroll
            for (int k = 0; k < 4; ++k) { float aq = bq[k], ak = bk[k];
#pragma unroll
                for (int j = 0; j < 4; ++j) { aq += xq[i + j][k] * wq[j][k]; ak += xk[i + j][k] * wk[j][k]; }
                qv[i][k] = aq * sigm(aq) * 0.08838834764831845f; kv[i][k] = ak * sigm(ak); }
    }
    {
        float ae[4];
#pragma unroll
        for (int i = 0; i < 4; ++i) ae[i] = __shfl(aloc, 4 * tg + i);
#pragma unroll
        for (int i = 0; i < 4; ++i) { const int off = (4 * tg + i) * P128 + 16 * w + 4 * dg; const u32x2 qp = pack4(qv[i][0], qv[i][1], qv[i][2], qv[i][3]);
            *(LAS u32x2*)(QM + off) = qp; *(LAS u32x2*)(KM + off) = pack4(kv[i][0], kv[i][1], kv[i][2], kv[i][3]);
            *(u32x2*)(QMM + (row0 + 4 * tg + i) * 512 + h * 128 + 16 * w + 4 * dg) = qp; }
#pragma unroll
        for (int k = 0; k < 4; ++k) *(u32x2*)(KLM + item * 8192 + (16 * w + 4 * dg + k) * 64 + 4 * tg) = pack4(kv[0][k] * ae[0], kv[1][k] * ae[1], kv[2][k] * ae[2], kv[3][k] * ae[3]);
    }
    __syncthreads();
    {
        bf16x8 qf[4];
#pragma unroll
        for (int ks = 0; ks < 4; ++ks) qf[ks] = LDFRAG(QM, 16 * tt + r16, P128, ks);
        const float pmt = __shfl(pm, 16 * tt + r16);
#pragma unroll
        for (int si = 0; si < 2; ++si) { const int st = 2 * vh + si; f32x4 acc = {0.f, 0.f, 0.f, 0.f};
            if (st <= tt) {
#pragma unroll
                for (int ks = 0; ks < 4; ++ks) { const bf16x8 kf = LDFRAG(KM, 16 * st + r16, P128, ks); acc = MFMA16(kf, qf[ks], acc); }
                const int t = 16 * tt + r16, s0 = 16 * st + 4 * quad;
#pragma unroll
                for (int j = 0; j < 4; ++j) { const float ims = __shfl(imb, s0 + j); acc[j] = (s0 + j <= t) ? acc[j] * __expf(ims - pmt) : 0.f; }
            }
            *(u32x2*)(ATM + item * 4096 + (16 * tt + r16) * 64 + 16 * st + 4 * quad) = pack4(acc[0], acc[1], acc[2], acc[3]); }
    }
    __syncthreads();
}
template <int KIND> __device__ __forceinline__ void scan_loop(const Args& a, int b, int h, LAS unsigned char* lds, int tid, int w, int lane, unsigned* bar, unsigned xcc, unsigned nxb, unsigned nx, unsigned& bround) {
    constexpr int NV = KIND ? 144 : 128, NVT = NV / 16;
    const bf16_t* projb = (const bf16_t*)(a.ws + WS_PROJ); bf16_t* y = (bf16_t*)(a.ws + WS_Y);
    const bf16_t* QBG = KIND ? (const bf16_t*)a.out + (size_t)T * 1024 : (const bf16_t*)a.out; const bf16_t* KLG = QBG + (size_t)T * 512;
    const bf16_t* ATG = (const bf16_t*)(a.ws + (KIND ? WS_ATM : WS_ATH)); const float* DECH = (const float*)(a.ws + WS_DECH); const float* SCM = (const float*)(a.ws + WS_SCM);
    const float* nw = KIND ? a.in[8] : a.in[5];
    LAS bf16_t* QB = (LAS bf16_t*)lds; LAS bf16_t* ATT = QB + 64 * P128; LAS bf16_t* KLT = ATT + 64 * P64; LAS bf16_t* VT = KLT + 128 * P64; LAS bf16_t* ST = VT + NV * P64;
    LAS float* NRM = (LAS float*)(ST + NV * P128); LAS float* NWL = NRM + 256;
    const int tg = lane >> 2, dg = lane & 3, quad = lane >> 4, r16 = lane & 15, tt = w >> 1, vh = w & 1;
    for (int e = tid; e < NV * P128 / 2; e += 512) ((LAS unsigned*)ST)[e] = 0u;
    if (KIND) for (int e = tid; e < 16 * P64 / 2; e += 512) ((LAS unsigned*)(VT + 128 * P64))[e] = (e < P64 / 2) ? 0x3F803F80u : 0u;
    if (tid < 128) NWL[tid] = nw[h * 128 + tid];
    f32x4 Sacc[10];
#pragma unroll
    for (int i = 0; i < 10; ++i) Sacc[i] = (f32x4){0.f, 0.f, 0.f, 0.f};
    float m_st = -1e30f;
    const size_t rowbase = (size_t)b * SEQ, item0 = (size_t)(b * 4 + h) * 64;
    const bf16_t* pv = projb + (KIND ? MV : HI) + h * 128 + 16 * w + 4 * dg;
    const bf16_t* pgat = projb + (KIND ? MO : HG) + h * 128 + 64 * vh + 4 * quad;
    struct PSet { u32x4n rqb[2], rat, rkl[2]; f32x4 rdec, rdec2; f32x2_nat rsc; }; u32x2 rv[4];
    PSet SA, SB; SA.rdec = SB.rdec = SA.rdec2 = SB.rdec2 = (f32x4){1.f, 1.f, 1.f, 1.f}; SA.rsc = SB.rsc = (f32x2_nat){0.f, 0.f};
#define SCAN_LOAD(P_, cc) do { const size_t rb_ = rowbase + (size_t)(cc) * 64, it_ = item0 + (cc); \
        _Pragma("unroll") for (int i = 0; i < 2; ++i) { const int e = tid + 512 * i; P_.rqb[i] = *(const u32x4n*)(QBG + (rb_ + (e >> 4)) * 512 + h * 128 + (e & 15) * 8); P_.rkl[i] = *(const u32x4n*)(KLG + it_ * 8192 + (size_t)e * 8); } \
        P_.rat = *(const u32x4n*)(ATG + it_ * 4096 + (size_t)tid * 8); \
        if (KIND) P_.rsc = *(const f32x2_nat*)(SCM + (rb_ + lane) * 8 + h * 2); else { P_.rdec = *(const f32x4*)(DECH + it_ * 128 + 32 * tt + 4 * quad); P_.rdec2 = *(const f32x4*)(DECH + it_ * 128 + 32 * tt + 16 + 4 * quad); } } while (0)
    SCAN_LOAD(SA, 0); SCAN_LOAD(SB, 1);
#pragma unroll
    for (int i = 0; i < 4; ++i) rv[i] = *(const u32x2*)(pv + (rowbase + 4 * tg + i) * NP);
    __syncthreads();
#define SCAN_STEP(P_, c) do { \
        u32x2 rgc[4]; f32x4 dec = P_.rdec, dec2 = P_.rdec2; float rt_ = 1.f, wi_ = 0.f, mt_ = 0.f, decay = 1.f, scU = 1.f, m_new = 0.f; \
_Pragma("unroll") \
        for (int i = 0; i < 2; ++i) { const int e = tid + 512 * i; *(LAS u32x4n*)(QB + (e >> 4) * P128 + (e & 15) * 8) = P_.rqb[i]; *(LAS u32x4n*)(KLT + (e >> 3) * P64 + (e & 7) * 8) = P_.rkl[i]; } \
        *(LAS u32x4n*)(ATT + (tid >> 3) * P64 + (tid & 7) * 8) = P_.rat; \
        { float vv[4][4]; \
_Pragma("unroll") \
            for (int i = 0; i < 4; ++i) unpack4(rv[i], vv[i]); \
_Pragma("unroll") \
            for (int k = 0; k < 4; ++k) *(LAS u32x2*)(VT + (16 * w + 4 * dg + k) * P64 + 4 * tg) = pack4(vv[0][k], vv[1][k], vv[2][k], vv[3][k]); } \
        if (KIND) {                                                    \
            const float bs = P_.rsc[0], pm = P_.rsc[1]; const float g = __shfl(bs, 63), amax = g + __shfl(pm, 63); \
            const float inter = bs + m_st, m_t = fmaxf(inter, pm + bs); \
            const float wi = __expf(inter - m_t), rr = __expf(bs + pm - m_t); \
            m_new = fmaxf(g + m_st, amax); decay = __expf(g + m_st - m_new); scU = __expf(amax - m_new); \
            rt_ = __shfl(rr, 16 * tt + r16); wi_ = __shfl(wi, 16 * tt + r16); mt_ = __shfl(m_t, 16 * tt + r16); \
        } \
        __syncthreads(); \
        if ((((c) & 15) == 14) && (c) < 62) grid_bar(bar, xcc, nxb, nx, ++bround);     \
        { const int cn = ((c) + 2 < 64) ? (c) + 2 : 63; SCAN_LOAD(P_, cn); { const int c1 = ((c) + 1 < 64) ? (c) + 1 : 63; _Pragma("unroll") for (int i = 0; i < 4; ++i) rv[i] = *(const u32x2*)(pv + (rowbase + (size_t)c1 * 64 + 4 * tg + i) * NP); } _Pragma("unroll") for (int vt = 0; vt < 4; ++vt) rgc[vt] = *(const u32x2*)(pgat + (rowbase + (size_t)(c) * 64 + 16 * tt + r16) * NP + 16 * vt); } \
        f32x4 o[4]; \
        { \
            bf16x8 af[2], qbf[4]; \
_Pragma("unroll") \
            for (int ks = 0; ks < 2; ++ks) af[ks] = LDFRAG(ATT, 16 * tt + r16, P64, ks); \
_Pragma("unroll") \
            for (int ks = 0; ks < 4; ++ks) qbf[ks] = LDFRAG(QB, 16 * tt + r16, P128, ks); \
            float dn = 1.f; \
            if (KIND) { f32x4 a1 = {0.f, 0.f, 0.f, 0.f}, a2 = {0.f, 0.f, 0.f, 0.f}; \
_Pragma("unroll") \
                for (int ks = 0; ks < 2; ++ks) a1 = MFMA16(LDFRAG(VT, 128 + r16, P64, ks), af[ks], a1); \
_Pragma("unroll") \
                for (int ks = 0; ks < 4; ++ks) a2 = MFMA16(LDFRAG(ST, 128 + r16, P128, ks), qbf[ks], a2); \
                const float dl = rt_ * a1[0] + wi_ * a2[0]; const float den = __shfl(dl, r16); \
                dn = __builtin_amdgcn_rcpf(fmaxf(fabsf(den), __expf(-mt_))); } \
            float s1 = 0.f, s2 = 0.f; \
_Pragma("unroll") \
            for (int vt = 0; vt < 4; ++vt) { const int v0 = 64 * vh + 16 * vt; f32x4 a1 = {0.f, 0.f, 0.f, 0.f}, a2 = {0.f, 0.f, 0.f, 0.f}; \
_Pragma("unroll") \
                for (int ks = 0; ks < 2; ++ks) a1 = MFMA16(LDFRAG(VT, v0 + r16, P64, ks), af[ks], a1); \
_Pragma("unroll") \
                for (int ks = 0; ks < 4; ++ks) a2 = MFMA16(LDFRAG(ST, v0 + r16, P128, ks), qbf[ks], a2); \
                f32x4 acc = KIND ? (a1 * rt_ + a2 * wi_) * dn : (a1 + a2); \
                o[vt] = acc; s1 += (acc[0] + acc[1]) + (acc[2] + acc[3]); s2 += (acc[0] * acc[0] + acc[1] * acc[1]) + (acc[2] * acc[2] + acc[3] * acc[3]); } \
            s1 += __shfl_xor(s1, 16); s1 += __shfl_xor(s1, 32); s2 += __shfl_xor(s2, 16); s2 += __shfl_xor(s2, 32); \
            if (quad == 0) { NRM[(16 * tt + r16) * 4 + 2 * vh] = s1; NRM[(16 * tt + r16) * 4 + 2 * vh + 1] = s2; } \
            bf16x8 klf[2][2]; \
_Pragma("unroll") \
            for (int dt2 = 0; dt2 < 2; ++dt2) { _Pragma("unroll") for (int ks = 0; ks < 2; ++ks) klf[dt2][ks] = LDFRAG(KLT, 32 * tt + 16 * dt2 + r16, P64, ks); } \
_Pragma("unroll") \
            for (int vt = 0; vt < 4; ++vt) { bf16x8 vf[2]; \
_Pragma("unroll") \
                for (int ks = 0; ks < 2; ++ks) vf[ks] = LDFRAG(VT, 64 * vh + 16 * vt + r16, P64, ks); \
_Pragma("unroll") \
                for (int dt2 = 0; dt2 < 2; ++dt2) { f32x4 u = {0.f, 0.f, 0.f, 0.f}; \
_Pragma("unroll") \
                    for (int ks = 0; ks < 2; ++ks) u = MFMA16(klf[dt2][ks], vf[ks], u); \
                    if (KIND) Sacc[dt2 * 4 + vt] = Sacc[dt2 * 4 + vt] * decay + u * scU; else Sacc[dt2 * 4 + vt] = Sacc[dt2 * 4 + vt] * (dt2 ? dec2 : dec) + u; } } \
            if (KIND && vh == 0) { bf16x8 vf[2]; \
_Pragma("unroll") \
                for (int ks = 0; ks < 2; ++ks) vf[ks] = LDFRAG(VT, 128 + r16, P64, ks); \
_Pragma("unroll") \
                for (int dt2 = 0; dt2 < 2; ++dt2) { f32x4 u = {0.f, 0.f, 0.f, 0.f}; \
_Pragma("unroll") \
                    for (int ks = 0; ks < 2; ++ks) u = MFMA16(klf[dt2][ks], vf[ks], u); \
                    Sacc[8 + dt2] = Sacc[8 + dt2] * decay + u * scU; } } \
        } \
        __syncthreads(); \
_Pragma("unroll") \
        for (int dt2 = 0; dt2 < 2; ++dt2) { \
_Pragma("unroll") \
            for (int vt = 0; vt < 4; ++vt) *(LAS u32x2*)(ST + (64 * vh + 16 * vt + r16) * P128 + 32 * tt + 16 * dt2 + 4 * quad) = pack4(Sacc[dt2 * 4 + vt][0], Sacc[dt2 * 4 + vt][1], Sacc[dt2 * 4 + vt][2], Sacc[dt2 * 4 + vt][3]); \
            if (KIND && vh == 0) *(LAS u32x2*)(ST + (128 + r16) * P128 + 32 * tt + 16 * dt2 + 4 * quad) = pack4(Sacc[8 + dt2][0], Sacc[8 + dt2][1], Sacc[8 + dt2][2], Sacc[8 + dt2][3]); } \
        { \
            const int t = 16 * tt + r16; const f32x4 nr = *(const LAS f32x4*)(NRM + t * 4); \
            const float mean = KIND ? (nr[0] + nr[2]) * (1.f / 128.f) : 0.f; const float var = fmaxf((nr[1] + nr[3]) * (1.f / 128.f) - mean * mean, 0.f); \
            const float rstd = __builtin_amdgcn_rsqf(var + LN_EPS); \
            bf16_t* yp = y + (rowbase + (c) * 64 + t) * D + (KIND ? 512 : 0) + h * 128 + 64 * vh + 4 * quad; \
_Pragma("unroll") \
            for (int vt = 0; vt < 4; ++vt) { float r[4], gt[4]; unpack4(rgc[vt], gt); const f32x4 nv = *(const LAS f32x4*)(NWL + 64 * vh + 16 * vt + 4 * quad); \
_Pragma("unroll") \
                for (int j = 0; j < 4; ++j) r[j] = gt[j] * (o[vt][j] - mean) * rstd * nv[j]; \
                *(u32x2*)(yp + 16 * vt) = pack4(r[0], r[1], r[2], r[3]); } \
        } \
        if (KIND) m_st = m_new; \
    } while (0)
    for (int c2 = 0; c2 < 64; c2 += 2) { SCAN_STEP(SA, c2); SCAN_STEP(SB, c2 + 1); }
#undef SCAN_STEP
#undef SCAN_LOAD
    __syncthreads();
}

__device__ __forceinline__ void ln_rows(const float* r, const float* gam, const float* bet, float* xo, bf16_t* xbo, int lane, int gw, int NGW) {
    const f32x4 *gp = (const f32x4*)gam + lane, *bp = (const f32x4*)bet + lane;
    for (int m = gw; m < T; m += 2 * NGW) {
        f32x4 v[2][4]; float s[2] = {0.f, 0.f};
#pragma unroll
        for (int q = 0; q < 2; ++q) { const f32x4* xr = (const f32x4*)(r + (size_t)(m + q * NGW) * D) + lane;
#pragma unroll
            for (int j = 0; j < 4; ++j) v[q][j] = xr[64 * j]; }
#pragma unroll
        for (int q = 0; q < 2; ++q)
#pragma unroll
            for (int j = 0; j < 4; ++j) s[q] += (v[q][j][0] + v[q][j][1]) + (v[q][j][2] + v[q][j][3]);
#pragma unroll
        for (int q = 0; q < 2; ++q) { const float mean = wave_sum(s[q]) * (1.f / D); float s2 = 0.f;
#pragma unroll
            for (int j = 0; j < 4; ++j) { v[q][j] = v[q][j] - mean; s2 += (v[q][j][0] * v[q][j][0] + v[q][j][1] * v[q][j][1]) + (v[q][j][2] * v[q][j][2] + v[q][j][3] * v[q][j][3]); }
            const float rstd = __builtin_amdgcn_rsqf(wave_sum(s2) * (1.f / D) + LN_EPS); const size_t mm = (size_t)(m + q * NGW);
#pragma unroll
            for (int j = 0; j < 4; ++j) { const f32x4 o = v[q][j] * rstd * gp[64 * j] + bp[64 * j];
                if (xo) ((f32x4*)(xo + mm * D) + lane)[64 * j] = o;
                if (xbo) { uint2 w; w.x = pk2(o[0], o[1]); w.y = pk2(o[2], o[3]); ((uint2*)(xbo + mm * D) + lane)[64 * j] = w; } } }
    }
}

__device__ __forceinline__ void ln_rows16(const bf16_t* r, const float* gam, const float* bet, float* xo, bf16_t* xbo, int lane, int gw, int NGW) {
    for (int m = gw; m < T; m += 2 * NGW) {
        float v[2][16]; float s[2] = {0.f, 0.f};
#pragma unroll
        for (int q = 0; q < 2; ++q) { const int mq = (m + q * NGW < T) ? m + q * NGW : m; const u32x4n* xr = (const u32x4n*)(r + (size_t)mq * D) + lane;
#pragma unroll
            for (int j = 0; j < 2; ++j) { const u32x4n w = xr[64 * j]; const unsigned ww[4] = {w.x, w.y, w.z, w.w};
#pragma unroll
                for (int i = 0; i < 4; ++i) { v[q][8 * j + 2 * i] = bflo(ww[i]); v[q][8 * j + 2 * i + 1] = bfhi(ww[i]); } } }
#pragma unroll
        for (int q = 0; q < 2; ++q)
#pragma unroll
            for (int i = 0; i < 16; ++i) s[q] += v[q][i];
#pragma unroll
        for (int q = 0; q < 2; ++q) { const float mean = wave_sum(s[q]) * (1.f / D); float s2 = 0.f;
#pragma unroll
            for (int i = 0; i < 16; ++i) { v[q][i] -= mean; s2 += v[q][i] * v[q][i]; }
            const float rstd = __builtin_amdgcn_rsqf(wave_sum(s2) * (1.f / D) + LN_EPS); const size_t mm = (size_t)(m + q * NGW); if (m + q * NGW >= T) continue;
#pragma unroll
            for (int j = 0; j < 2; ++j) { const int e0 = 8 * (lane + 64 * j); const f32x4 g0 = *(const f32x4*)(gam + e0), g1 = *(const f32x4*)(gam + e0 + 4), b0 = *(const f32x4*)(bet + e0), b1 = *(const f32x4*)(bet + e0 + 4);
                float o[8];
#pragma unroll
                for (int i = 0; i < 4; ++i) { o[i] = v[q][8 * j + i] * rstd * g0[i] + b0[i]; o[4 + i] = v[q][8 * j + 4 + i] * rstd * g1[i] + b1[i]; }
                if (xo) { *(f32x4*)(xo + mm * D + e0) = (f32x4){o[0], o[1], o[2], o[3]}; *(f32x4*)(xo + mm * D + e0 + 4) = (f32x4){o[4], o[5], o[6], o[7]}; }
                if (xbo) { u32x4n w; w.x = pk2(o[0], o[1]); w.y = pk2(o[2], o[3]); w.z = pk2(o[4], o[5]); w.w = pk2(o[6], o[7]); *(u32x4n*)(xbo + mm * D + e0) = w; } } }
    }
}

__device__ __forceinline__ void attn_phase(const bf16_t* qb, const bf16_t* kb, const bf16_t* vT, bf16_t* ao, LAS unsigned char* lds, int wave, int lane, int blk, int G) {
    LAS bf16_t* P = (LAS bf16_t*)(lds + wave * 8448);
    const int r16 = lane & 15, quad = lane >> 4;
    for (int bi = blk; bi < (T / 128) * 4; bi += G) {
        const int h = bi & 3, r0 = (bi >> 2) * 128 + wave * 16, b = r0 / SEQ;
        bf16x8 qa[8];
        const bf16_t* qp = qb + (size_t)(r0 + r16) * D + h * 256 + quad * 8;
#pragma unroll
        for (int ks = 0; ks < 8; ++ks) qa[ks] = *(const bf16x8*)(qp + ks * 32);
        f32x4 s[16];
        const bf16_t* kp = kb + (size_t)(b * 256 + r16) * D + h * 256 + quad * 8;
#pragma unroll
        for (int nt = 0; nt < 16; ++nt) { f32x4 acc = {0.f, 0.f, 0.f, 0.f};
#pragma unroll
            for (int ks = 0; ks < 8; ++ks) { const bf16x8 bfr = *(const bf16x8*)(kp + (size_t)nt * 16 * D + ks * 32); acc = __builtin_amdgcn_mfma_f32_16x16x32_bf16(qa[ks], bfr, acc, 0, 0, 0); }
            s[nt] = acc; }
        float sm[4];
#pragma unroll
        for (int j = 0; j < 4; ++j) { float mx = s[0][j];
#pragma unroll
            for (int nt = 1; nt < 16; ++nt) mx = fmaxf(mx, s[nt][j]);
            mx = fmaxf(mx, __shfl_xor(mx, 1)); mx = fmaxf(mx, __shfl_xor(mx, 2)); mx = fmaxf(mx, __shfl_xor(mx, 4)); mx = fmaxf(mx, __shfl_xor(mx, 8));
            float sum = 0.f;
#pragma unroll
            for (int nt = 0; nt < 16; ++nt) { const float p = __expf((s[nt][j] - mx) * 0.0625f); sum += p; P[(quad * 4 + j) * 264 + nt * 16 + r16] = f2bf(p); }
            sum += __shfl_xor(sum, 1); sum += __shfl_xor(sum, 2); sum += __shfl_xor(sum, 4); sum += __shfl_xor(sum, 8);
            sm[j] = 1.f / sum; }
        WAVE_LDS_SYNC();
        bf16x8 pa[8];
#pragma unroll
        for (int ks = 0; ks < 8; ++ks) pa[ks] = *(const LAS bf16x8*)(P + r16 * 264 + ks * 32 + quad * 8);
        WAVE_LDS_SYNC();
        const bf16_t* vp = vT + (size_t)(h * 256 + r16) * NMEMR + b * 256 + quad * 8;
        bf16_t* op = ao + (size_t)(r0 + quad * 4) * D + h * 256 + r16;
#pragma unroll
        for (int nt = 0; nt < 16; ++nt) { f32x4 acc = {0.f, 0.f, 0.f, 0.f};
#pragma unroll
            for (int ks = 0; ks < 8; ++ks) { const bf16x8 bfr = *(const bf16x8*)(vp + (size_t)nt * 16 * NMEMR + ks * 32); acc = __builtin_amdgcn_mfma_f32_16x16x32_bf16(pa[ks], bfr, acc, 0, 0, 0); }
#pragma unroll
            for (int j = 0; j < 4; ++j) op[(size_t)j * D + nt * 16] = f2bf(acc[j] * sm[j]); }
    }
}


__device__ __forceinline__ void attn_phase2(const bf16_t* qb, const bf16_t* kb, const bf16_t* vT, bf16_t* ao, LAS unsigned char* lds, int tid, int wave, int lane, int blk, int G) {
    constexpr int PKV = 264;
    LAS bf16_t* KV = (LAS bf16_t*)lds;
    const int r16 = lane & 15, quad = lane >> 4;
    for (int bi = blk; bi < (T / 128) * 4; bi += G) {
        const int h = bi & 3, chunk = bi >> 2, r0 = chunk * 128 + wave * 16, b = chunk >> 5;
        { const bf16_t* sp = kb + (size_t)(b * 256 + (tid >> 5)) * D + h * 256 + (tid & 31) * 8; LAS bf16_t* dp = KV + (tid >> 5) * PKV + (tid & 31) * 8;
#pragma unroll 1
            for (int q4 = 0; q4 < 4; ++q4) { u32x4n v[4];
#pragma unroll
                for (int i = 0; i < 4; ++i) v[i] = *(const u32x4n*)(sp + (size_t)(16 * i) * D);
#pragma unroll
                for (int i = 0; i < 4; ++i) *(LAS u32x4n*)(dp + (16 * i) * PKV) = v[i];
                sp += (size_t)64 * D; dp += 64 * PKV; } }
        bf16x8 qf[8];
        { const bf16_t* qp = qb + (size_t)(r0 + r16) * D + h * 256 + quad * 8;
#pragma unroll
            for (int ks = 0; ks < 8; ++ks) qf[ks] = *(const bf16x8*)(qp + ks * 32); }
        __syncthreads();
        f32x4 sc[16];
#pragma unroll
        for (int nt = 0; nt < 16; ++nt) { f32x4 acc = {0.f, 0.f, 0.f, 0.f};
#pragma unroll
            for (int ks = 0; ks < 8; ++ks) acc = MFMA16(LDFRAG(KV, nt * 16 + r16, PKV, ks), qf[ks], acc);
            sc[nt] = acc; }
        float mx = sc[0][0];
#pragma unroll
        for (int nt = 0; nt < 16; ++nt)
#pragma unroll
            for (int j = 0; j < 4; ++j) mx = fmaxf(mx, sc[nt][j]);
        mx = fmaxf(mx, __shfl_xor(mx, 16)); mx = fmaxf(mx, __shfl_xor(mx, 32));
        float sum = 0.f;
#pragma unroll
        for (int nt = 0; nt < 16; ++nt)
#pragma unroll
            for (int j = 0; j < 4; ++j) { const float pv = __expf((sc[nt][j] - mx) * 0.0625f); sc[nt][j] = pv; sum += pv; }
        sum += __shfl_xor(sum, 16); sum += __shfl_xor(sum, 32);
        const float inv = __builtin_amdgcn_rcpf(sum);
        bf16x8 pf[8];
#pragma unroll
        for (int k2 = 0; k2 < 8; ++k2) { u32x4n w; w.x = pk2(sc[2 * k2][0], sc[2 * k2][1]); w.y = pk2(sc[2 * k2][2], sc[2 * k2][3]); w.z = pk2(sc[2 * k2 + 1][0], sc[2 * k2 + 1][1]); w.w = pk2(sc[2 * k2 + 1][2], sc[2 * k2 + 1][3]);
            pf[k2] = __builtin_bit_cast(bf16x8, w); }
        __syncthreads();
        { const bf16_t* sp = vT + (size_t)(h * 256 + (tid >> 5)) * NMEMR + b * 256 + (tid & 31) * 8; LAS bf16_t* dp = KV + (tid >> 5) * PKV + (tid & 31) * 8;
#pragma unroll 1
            for (int q4 = 0; q4 < 4; ++q4) { u32x4n v[4];
#pragma unroll
                for (int i = 0; i < 4; ++i) v[i] = *(const u32x4n*)(sp + (size_t)(16 * i) * NMEMR);
#pragma unroll
                for (int i = 0; i < 4; ++i) *(LAS u32x4n*)(dp + (16 * i) * PKV) = v[i];
                sp += (size_t)64 * NMEMR; dp += 64 * PKV; } }
        __syncthreads();
        bf16_t* op = ao + (size_t)(r0 + r16) * D + h * 256 + 4 * quad;
#pragma unroll
        for (int dt = 0; dt < 16; ++dt) { f32x4 acc = {0.f, 0.f, 0.f, 0.f};
#pragma unroll
            for (int k2 = 0; k2 < 8; ++k2) { const LAS bf16_t* vp = KV + (dt * 16 + r16) * PKV + 32 * k2 + 4 * quad;
                const u32x2 lo = *(const LAS u32x2*)vp, hi = *(const LAS u32x2*)(vp + 16);
                const u32x4n av = {lo.x, lo.y, hi.x, hi.y};
                acc = MFMA16(__builtin_bit_cast(bf16x8, av), pf[k2], acc); }
            *(u32x2*)(op + dt * 16) = pack4(acc[0] * inv, acc[1] * inv, acc[2] * inv, acc[3] * inv); }
        __syncthreads();
    }
}


__device__ __forceinline__ void attn_phase3(const bf16_t* qb, const bf16_t* kb, const bf16_t* vT, bf16_t* ao, LAS unsigned char* lds, int tid, int wave, int lane, int blk, int G) {
    constexpr int PKV = 264;
    LAS bf16_t* KV = (LAS bf16_t*)lds;
    const int r16 = lane & 15, quad = lane >> 4;
    for (int bi = blk; bi < (T / 256) * 4; bi += G) {
        const int h = bi & 3, chunk = bi >> 2, r0 = chunk * 256 + wave * 32, b = chunk >> 4;
        { const bf16_t* sp = kb + (size_t)(b * 256 + (tid >> 5)) * D + h * 256 + (tid & 31) * 8; LAS bf16_t* dp = KV + (tid >> 5) * PKV + (tid & 31) * 8;
#pragma unroll 1
            for (int q4 = 0; q4 < 4; ++q4) { u32x4n v[4];
#pragma unroll
                for (int i = 0; i < 4; ++i) v[i] = *(const u32x4n*)(sp + (size_t)(16 * i) * D);
#pragma unroll
                for (int i = 0; i < 4; ++i) *(LAS u32x4n*)(dp + (16 * i) * PKV) = v[i];
                sp += (size_t)64 * D; dp += 64 * PKV; } }
        bf16x8 qfA[8], qfB[8];
        { const bf16_t* qp = qb + (size_t)(r0 + r16) * D + h * 256 + quad * 8;
#pragma unroll
            for (int ks = 0; ks < 8; ++ks) { qfA[ks] = *(const bf16x8*)(qp + ks * 32); qfB[ks] = *(const bf16x8*)(qp + (size_t)16 * D + ks * 32); } }
        __syncthreads();
        f32x4 scA[16], scB[16];
#pragma unroll
        for (int nt = 0; nt < 16; ++nt) { f32x4 aA = {0.f, 0.f, 0.f, 0.f}, aB = {0.f, 0.f, 0.f, 0.f};
#pragma unroll
            for (int ks = 0; ks < 8; ++ks) { const bf16x8 kf = LDFRAG(KV, nt * 16 + r16, PKV, ks); aA = MFMA16(kf, qfA[ks], aA); aB = MFMA16(kf, qfB[ks], aB); }
            scA[nt] = aA; scB[nt] = aB; }
        bf16x8 pfA[8], pfB[8]; float invA, invB;
#define ATT_SOFTMAX(sc, pf, inv) do { float mx = sc[0][0]; \
            _Pragma("unroll") for (int nt = 0; nt < 16; ++nt) { _Pragma("unroll") for (int j = 0; j < 4; ++j) mx = fmaxf(mx, sc[nt][j]); } \
            mx = fmaxf(mx, __shfl_xor(mx, 16)); mx = fmaxf(mx, __shfl_xor(mx, 32)); float sum = 0.f; \
            _Pragma("unroll") for (int nt = 0; nt < 16; ++nt) { _Pragma("unroll") for (int j = 0; j < 4; ++j) { const float pv = __expf((sc[nt][j] - mx) * 0.0625f); sc[nt][j] = pv; sum += pv; } } \
            sum += __shfl_xor(sum, 16); sum += __shfl_xor(sum, 32); inv = __builtin_amdgcn_rcpf(sum); \
            _Pragma("unroll") for (int k2 = 0; k2 < 8; ++k2) { u32x4n w; w.x = pk2(sc[2 * k2][0], sc[2 * k2][1]); w.y = pk2(sc[2 * k2][2], sc[2 * k2][3]); w.z = pk2(sc[2 * k2 + 1][0], sc[2 * k2 + 1][1]); w.w = pk2(sc[2 * k2 + 1][2], sc[2 * k2 + 1][3]); \
                pf[k2] = __builtin_bit_cast(bf16x8, w); } } while (0)
        ATT_SOFTMAX(scA, pfA, invA); ATT_SOFTMAX(scB, pfB, invB);
#undef ATT_SOFTMAX
        __syncthreads();
        { const bf16_t* sp = vT + (size_t)(h * 256 + (tid >> 5)) * NMEMR + b * 256 + (tid & 31) * 8; LAS bf16_t* dp = KV + (tid >> 5) * PKV + (tid & 31) * 8;
#pragma unroll 1
            for (int q4 = 0; q4 < 4; ++q4) { u32x4n v[4];
#pragma unroll
                for (int i = 0; i < 4; ++i) v[i] = *(const u32x4n*)(sp + (size_t)(16 * i) * NMEMR);
#pragma unroll
                for (int i = 0; i < 4; ++i) *(LAS u32x4n*)(dp + (16 * i) * PKV) = v[i];
                sp += (size_t)64 * NMEMR; dp += 64 * PKV; } }
        __syncthreads();
        bf16_t* op = ao + (size_t)(r0 + r16) * D + h * 256 + 4 * quad;
#pragma unroll
        for (int dt = 0; dt < 16; ++dt) { f32x4 aA = {0.f, 0.f, 0.f, 0.f}, aB = {0.f, 0.f, 0.f, 0.f};
#pragma unroll
            for (int k2 = 0; k2 < 8; ++k2) { const LAS bf16_t* vp = KV + (dt * 16 + r16) * PKV + 32 * k2 + 4 * quad;
                const u32x2 lo = *(const LAS u32x2*)vp, hi = *(const LAS u32x2*)(vp + 16);
                const u32x4n av = {lo.x, lo.y, hi.x, hi.y}; const bf16x8 avf = __builtin_bit_cast(bf16x8, av);
                aA = MFMA16(avf, pfA[k2], aA); aB = MFMA16(avf, pfB[k2], aB); }
            *(u32x2*)(op + dt * 16) = pack4(aA[0] * invA, aA[1] * invA, aA[2] * invA, aA[3] * invA);
            *(u32x2*)(op + (size_t)16 * D + dt * 16) = pack4(aB[0] * invB, aB[1] * invB, aB[2] * invB, aB[3] * invB); }
        __syncthreads();
    }
}

__device__ __forceinline__ void conv_phase(const bf16_t* ub, const float* cw, const float* cb, bf16_t* hb, int half, int gtid, int NT) {
    for (int item = gtid; item < TH * 352; item += NT) {
        const int tl = item / 352, c8 = item - tl * 352, n0 = c8 * 8, t = half * TH + tl, tpos = t & (SEQ - 1);
        float ga[8], va[8];
#pragma unroll
        for (int i = 0; i < 8; ++i) { ga[i] = cb[n0 + i]; va[i] = cb[DFF + n0 + i]; }
#pragma unroll
        for (int j = 0; j < 3; ++j) { if (tpos - 2 + j >= 0) { const bf16_t* p = ub + (size_t)(tl - 2 + j) * NUP + n0;
            const uint4 gq = *(const uint4*)p, vq = *(const uint4*)(p + DFF); const unsigned gw4[4] = {gq.x, gq.y, gq.z, gq.w}, vw4[4] = {vq.x, vq.y, vq.z, vq.w};
            const float* wg = cw + (size_t)j * NUP + n0; const float* wv = wg + DFF;
#pragma unroll
            for (int i = 0; i < 4; ++i) { ga[2 * i] += bflo(gw4[i]) * wg[2 * i]; ga[2 * i + 1] += bfhi(gw4[i]) * wg[2 * i + 1]; va[2 * i] += bflo(vw4[i]) * wv[2 * i]; va[2 * i + 1] += bfhi(vw4[i]) * wv[2 * i + 1]; } } }
        uint4 o; o.x = pk2(gelu_tanh(ga[0]) * va[0], gelu_tanh(ga[1]) * va[1]); o.y = pk2(gelu_tanh(ga[2]) * va[2], gelu_tanh(ga[3]) * va[3]);
        o.z = pk2(gelu_tanh(ga[4]) * va[4], gelu_tanh(ga[5]) * va[5]); o.w = pk2(gelu_tanh(ga[6]) * va[6], gelu_tanh(ga[7]) * va[7]);
        *(uint4*)(hb + (size_t)t * DFF + n0) = o;
    }
}

template <class Epi> __device__ __forceinline__ void run_gemm(LAS unsigned char* lds, const bf16_t* A, const bf16_t* Bt, int M, int N, int K, const Epi& E) {
    pg8::Gemm g{A, Bt, M, N, K}; pg8::StaticOrder S; S.init(M, N, (int)gridDim.x, (int)blockIdx.x);
    pg8::gemm_phase<Epi, pg8::StaticOrder, false>(lds, g, S, E, nullptr);
}
__global__ void __launch_bounds__(512, 2) fwd_megakernel(Args a) {
    extern __shared__ __attribute__((aligned(16))) unsigned char shm[];
    LAS unsigned char* lds = (LAS unsigned char*)shm;
    const int tid = threadIdx.x, lane = tid & 63, wave = __builtin_amdgcn_readfirstlane(tid >> 6);
    const int G = gridDim.x, blk = blockIdx.x, gw = blk * 8 + wave, NGW = G * 8;
    unsigned char* ws = a.ws;
    const int lo = a.ph_lo, hi = a.ph_hi;
#if N_LAUNCH_MODE == 0
    cg::grid_group grid = cg::this_grid();
    unsigned* const bar = (unsigned*)(ws + WS_BAR); const unsigned xcc = xcc_id(); unsigned nxb = 0, nx = 0, bround = 0;
    if (tid == 0) { __hip_atomic_fetch_add(bar + 64 * (17 + xcc), 1u, __ATOMIC_RELAXED, __HIP_MEMORY_SCOPE_AGENT); __hip_atomic_fetch_add(bar + 64 * 33, 1u, __ATOMIC_RELAXED, __HIP_MEMORY_SCOPE_AGENT);
        while (__hip_atomic_load(bar + 64 * 33, __ATOMIC_RELAXED, __HIP_MEMORY_SCOPE_AGENT) < (unsigned)G) __builtin_amdgcn_s_sleep(1); }
    __syncthreads();
    nxb = __hip_atomic_load(bar + 64 * (17 + xcc), __ATOMIC_RELAXED, __HIP_MEMORY_SCOPE_AGENT);
    for (int x_ = 0; x_ < 16; ++x_) nx += (__hip_atomic_load(bar + 64 * (17 + x_), __ATOMIC_RELAXED, __HIP_MEMORY_SCOPE_AGENT) != 0u) ? 1u : 0u;
    if (a.ph_hi < 0) grid.sync();
#define SEAM(k) do { if (lo <= (k) && (k) + 1 < hi) grid_bar(bar, xcc, nxb, nx, ++bround); } while (0)
#define SEAM2() do { if (hi - lo > 1) grid_bar(bar, xcc, nxb, nx, ++bround); } while (0)
#else
#define SEAM(k) do { } while (0)
#define SEAM2() do { } while (0)
#endif
#define IN(k) (lo <= (k) && (k) < hi)
    bf16_t* xb = (bf16_t*)(ws + WS_XB); bf16_t* projb = (bf16_t*)(ws + WS_PROJ);
    float* x1 = (float*)(ws + WS_X1); bf16_t* x1b = (bf16_t*)(ws + WS_X1B); bf16_t* qb = (bf16_t*)(ws + WS_QB); bf16_t* x2b = (bf16_t*)(ws + WS_X1B); bf16_t* r16b = (bf16_t*)(ws + WS_X1)  ; bf16_t* r3b = (bf16_t*)(ws + WS_XB)  ;
    bf16_t* kb = (bf16_t*)(ws + WS_KB); bf16_t* vT = (bf16_t*)(ws + WS_VT); bf16_t* memb = (bf16_t*)(ws + WS_MEMB);
    bf16_t* ub = (bf16_t*)(ws + WS_UB); bf16_t* hb = (bf16_t*)(ws + WS_HB);

    if (IN(0)) { p0_prep(a, lds, tid, wave, lane, gw, NGW); __syncthreads(); SEAM(0); }
    if (IN(1)) {
        run_gemm(lds, xb, (const bf16_t*)(ws + WS_WIN), T, NP, D, pg8::EpiB16{projb, NP, a.in[3], 0x00C3u, 0xC000u});
        __syncthreads(); SEAM(1); }
    if (IN(2)) {
        for (int it = blk; it < 1024; it += G) { const int kind = it >> 9, bh = (it >> 4) & 31, c = it & 15;
            if (kind == 0) hgrn2_pre(a, bh >> 2, bh & 3, c, lds, tid, wave, lane); else mlstm_pre(a, bh >> 2, bh & 3, c, lds, tid, wave, lane); }
        __syncthreads(); SEAM(2); }
    if (IN(3)) {
        if (blk < 32) scan_loop<0>(a, (blk >> 2) & 7, blk & 3, lds, tid, wave, lane, bar, xcc, nxb, nx, bround);
        else if (blk < 64) scan_loop<1>(a, (blk >> 2) & 7, blk & 3, lds, tid, wave, lane, bar, xcc, nxb, nx, bround);
        else {
            for (int sl = 1; sl < 4; ++sl) {
                for (int it = blk - 64; it < 1024; it += G - 64) { const int kind = it >> 9, bh = (it >> 4) & 31, c = 16 * sl + (it & 15);
                    if (kind == 0) hgrn2_pre(a, bh >> 2, bh & 3, c, lds, tid, wave, lane); else mlstm_pre(a, bh >> 2, bh & 3, c, lds, tid, wave, lane); }
                __syncthreads(); grid_bar(bar, xcc, nxb, nx, ++bround); }
            late_prep(a, lds, wave, lane, (blk - 64) * 8 + wave, (G - 64) * 8); __syncthreads();
            { pg8::Gemm g{memb, (const bf16_t*)(ws + WS_WKV), NMEMR, D, D}; pg8::StaticOrder S; S.init(NMEMR, D, G - 64, blk - 64); pg8::gemm_phase<pg8::EpiB16, pg8::StaticOrder, false>(lds, g, S, pg8::EpiB16{kb, D, nullptr, 0u, 0u}, nullptr); }
            { pg8::Gemm g{(const bf16_t*)(ws + WS_WKV) + (size_t)D * D, memb, D, NMEMR, D}; pg8::StaticOrder S; S.init(D, NMEMR, G - 64, blk - 64); pg8::gemm_phase<pg8::EpiB16, pg8::StaticOrder, false>(lds, g, S, pg8::EpiB16{vT, NMEMR, nullptr, 0u, 0u}, nullptr); }
        }
        __syncthreads();
        SEAM(3); }
    if (IN(4)) { run_gemm(lds, (const bf16_t*)(ws + WS_Y), (const bf16_t*)(ws + WS_WOUT), T, D, D, pg8::EpiResO16<false>{a.in[0], r16b, D, ALPHA, (float*)(ws + WS_ST1)}); __syncthreads(); SEAM(4); }
    if (IN(6)) { run_gemm(lds, r16b, (const bf16_t*)(ws + WS_WQ), T, D, D, pg8::EpiLNq{qb, D, (const float*)(ws + WS_ST1), (const float*)(ws + WS_CV), (const float*)(ws + WS_CV) + 1024}); __syncthreads(); SEAM(6); }
    if (IN(7)) { attn_phase3(qb, kb, vT, xb  , lds, tid, wave, lane, blk, G); __syncthreads(); SEAM(7); }
    if (IN(8)) { run_gemm(lds, xb  , (const bf16_t*)(ws + WS_WO), T, D, D, pg8::EpiResLN{r16b, (const float*)(ws + WS_ST1), a.in[10], a.in[11], r16b, D, ALPHA, nullptr}); __syncthreads(); SEAM(8); }
    if (IN(9)) { ln_rows16(r16b, a.in[15], a.in[16], nullptr, x2b, lane, gw, NGW); SEAM(9); }
    if (IN(10)) {
        pg8::Gemm g{x2b, (const bf16_t*)(ws + WS_WUP), 136 * 256, NUP, D}; pg8::StaticOrder S; S.init(136 * 256, NUP, (int)gridDim.x, (int)blockIdx.x);
        pg8::gemm_phase_ffn<pg8::EpiFFN, pg8::StaticOrder, false>(lds, g, S, pg8::EpiFFN{hb, a.in[18], a.in[19]}, nullptr);
        __syncthreads(); SEAM(10); }
    if (IN(14)) { run_gemm(lds, hb, (const bf16_t*)(ws + WS_WDN), T, D, DFF, pg8::EpiResO16<true>{x2b, r3b, D, ALPHA, nullptr}); __syncthreads(); SEAM(14); }
    if (IN(15)) { ln_rows16(r3b, a.in[21], a.in[22], a.out, nullptr, lane, gw, NGW); }
}

extern "C" void kernel_launch(void* const* d_in, const int* in_sizes, int n_in, void* d_out, int out_size, void* d_ws, size_t ws_size, hipStream_t stream) {
    static int grid = 0;
    if (grid == 0) {
        int dev = 0, cus = 0, per_cu = 0;
        hipGetDevice(&dev); hipDeviceGetAttribute(&cus, hipDeviceAttributeMultiprocessorCount, dev);
        if (hipFuncSetAttribute((const void*)fwd_megakernel, hipFuncAttributeMaxDynamicSharedMemorySize, LDS_BYTES) != hipSuccess) { fprintf(stderr, "hipFuncSetAttribute failed\n"); }
        if (hipOccupancyMaxActiveBlocksPerMultiprocessor(&per_cu, (const void*)fwd_megakernel, 512, LDS_BYTES) != hipSuccess || per_cu < 1) { fprintf(stderr, "occupancy query: %d\n", per_cu); per_cu = 1; }
        (void)hipGetLastError();
        grid = cus * per_cu;
        if (ws_size < 482 * MiB) fprintf(stderr, "workspace too small: %zu\n", ws_size);
    }
    Args a{};
    for (int i = 0; i < 23; ++i) a.in[i] = (const float*)d_in[i];
    a.out = (float*)d_out; a.ws = (unsigned char*)d_ws;
#if N_LAUNCH_MODE == 0
    (void)hipMemsetAsync((unsigned char*)d_ws + WS_BAR, 0, 64 * 34 * 4, stream);
    a.ph_lo = 0; a.ph_hi = NPH; void* args[] = {&a};
    hipError_t e = hipLaunchCooperativeKernel((const void*)fwd_megakernel, dim3(grid), dim3(512), args, LDS_BYTES, stream);
    if (e != hipSuccess) fprintf(stderr, "cooperative launch failed: %s (grid %d)\n", hipGetErrorString(e), grid);
#else
    for (int ph = 0; ph < NPH; ++ph) { a.ph_lo = ph; a.ph_hi = ph + 1; hipLaunchKernelGGL(fwd_megakernel, dim3(grid), dim3(512), LDS_BYTES, stream, a); }
#endif
}
```

```cpp
#include <hip/hip_runtime.h>
#include <hip/hip_cooperative_groups.h>
#include <cstdio>
#include <cstdint>
namespace cg = cooperative_groups;
namespace pg8 {
#define PG8_LAS __attribute__((address_space(3)))
typedef unsigned short bf16_t;
typedef short bf16x8 __attribute__((ext_vector_type(8)));
typedef float f32x4 __attribute__((ext_vector_type(4)));
typedef unsigned u32x4 __attribute__((ext_vector_type(4)));
constexpr int BM = 256, BK = 64, HALF = 128, HTB = HALF * BK * 2  , STAGE_BYTES = 8 * HTB, NXCD = 8, WGM = 8;

__host__ __device__ __forceinline__ int lds_byte(int r, int c) { const int st = (r >> 4) * 2 + (c >> 5), rr = r & 15, cc = c & 31, ob = rr * 64 + cc * 2; return st * 1024 + (ob ^ (((ob >> 9) & 1) << 5)); }
__host__ __device__ __forceinline__ void stage_rc(int b, int& R, int& C) { const int st = b / 1024, sb = b % 1024, swz = sb ^ (((sb >> 9) & 1) << 5); R = (st >> 1) * 16 + swz / 64; C = (st & 1) * 32 + (swz % 64) / 2; }
__host__ __device__ __forceinline__ int perm32(int rho) { const int n = rho >> 4, i = rho & 15; return 8 * (i >> 2) + 4 * n + (i & 3); }

struct Unit { int pm, pn; };
struct Gemm { const bf16_t* A; const bf16_t* Bt; int M, N, K; };

struct StaticOrder {
    int nM, nN, nwg, G, c;
    __host__ __device__ void init(int M, int N, int G_, int c_) { nM = M / BM; nN = N / BM; nwg = nM * nN; G = G_; c = c_; }
    __host__ __device__ bool next(int i, Unit& u) const {
        const long L = (long)i * G + c; if (L >= nwg) return false;
        int wgid = (int)L; { const int q = nwg / NXCD, r = nwg % NXCD, xcd = wgid % NXCD, off = wgid / NXCD; wgid = (xcd < r ? xcd * (q + 1) : r * (q + 1) + (xcd - r) * q) + off; }
        const int nig = WGM * nN, gid = wgid / nig, fm = gid * WGM, gsz = (nM - fm) < WGM ? (nM - fm) : WGM;
        u.pm = fm + ((wgid % nig) % gsz); u.pn = (wgid % nig) / gsz; return true;
    }
    __device__ __forceinline__ void a_ready(const Unit&) const {}
    __device__ __forceinline__ void done(const Unit&) const {}
};
typedef __bf16 bf16x2_nat __attribute__((ext_vector_type(2))); typedef float f32x2_nat __attribute__((ext_vector_type(2)));
__device__ __forceinline__ unsigned cvt_pk_bf16(float lo, float hi) { f32x2_nat v = {lo, hi}; bf16x2_nat r = __builtin_convertvector(v, bf16x2_nat); return __builtin_bit_cast(unsigned, r); }
typedef float f32x2 __attribute__((ext_vector_type(2)));
struct EpiB16 {
    static constexpr bool PERM = true, AFTER_DRAIN = false;
    bf16_t* O; int ldc; const float* bias; unsigned silu_mask, sig_mask;
    __device__ __forceinline__ void operator()(const f32x4 (&acc)[2][2][4][2], const Unit& u, int wr, int wc, int fr, int fq) const {
        const int row0 = u.pm * BM + wr * 64 + fr; const int col0 = u.pn * BM + wc * 32 + 8 * fq;
        const int act = ((silu_mask >> u.pn) & 1u) ? 1 : (((sig_mask >> u.pn) & 1u) ? 2 : 0);
        f32x4 bv[2][2];
#pragma unroll
        for (int bj = 0; bj < 2; ++bj)
#pragma unroll
            for (int n = 0; n < 2; ++n) bv[bj][n] = bias ? *(const f32x4*)(bias + col0 + bj * HALF + 4 * n) : (f32x4){0.f, 0.f, 0.f, 0.f};
#pragma unroll
        for (int ai = 0; ai < 2; ++ai)
#pragma unroll
            for (int m = 0; m < 4; ++m) { bf16_t* rowp = O + (size_t)(row0 + ai * HALF + m * 16) * ldc + col0;
#pragma unroll
                for (int bj = 0; bj < 2; ++bj) { f32x4 v0 = acc[ai][bj][m][0] + bv[bj][0], v1 = acc[ai][bj][m][1] + bv[bj][1];
                    if (act) {
#pragma unroll
                        for (int j = 0; j < 4; ++j) { const float s0 = __builtin_amdgcn_rcpf(1.f + __expf(-v0[j])), s1 = __builtin_amdgcn_rcpf(1.f + __expf(-v1[j]));
                            v0[j] = (act == 1) ? v0[j] * s0 : s0; v1[j] = (act == 1) ? v1[j] * s1 : s1; } }
                    u32x4 w; w.x = cvt_pk_bf16(v0[0], v0[1]); w.y = cvt_pk_bf16(v0[2], v0[3]); w.z = cvt_pk_bf16(v1[0], v1[1]); w.w = cvt_pk_bf16(v1[2], v1[3]);
                    *(u32x4*)(rowp + bj * HALF) = w; } }
    }
};
template <bool BASE16> struct EpiResO16 {
    static constexpr bool PERM = false, AFTER_DRAIN = false;
    const void* base; bf16_t* out; int ldc; float alpha; float* stats;
    __device__ __forceinline__ void operator()(const f32x4 (&acc)[2][2][4][2], const Unit& u, int wr, int wc, int fr, int fq) const {
        typedef unsigned u32x2e __attribute__((ext_vector_type(2)));
        const int row0 = u.pm * BM + wr * 64 + fr, col0 = u.pn * BM + wc * 32 + 4 * fq;
#pragma unroll
        for (int ai = 0; ai < 2; ++ai)
#pragma unroll
            for (int m = 0; m < 4; ++m) { const size_t off = (size_t)(row0 + ai * HALF + m * 16) * ldc + col0; float rs = 0.f, rq = 0.f;
#pragma unroll
                for (int bj = 0; bj < 2; ++bj)
#pragma unroll
                    for (int n = 0; n < 2; ++n) { f32x4 bs;
                        if (BASE16) { const u32x2e bw = *(const u32x2e*)((const bf16_t*)base + off + bj * HALF + n * 16);
                            bs = (f32x4){__uint_as_float(bw.x << 16), __uint_as_float(bw.x & 0xffff0000u), __uint_as_float(bw.y << 16), __uint_as_float(bw.y & 0xffff0000u)}; }
                        else bs = *(const f32x4*)((const float*)base + off + bj * HALF + n * 16);
                        const f32x4 v = bs * alpha + acc[ai][bj][m][n]; u32x2e w; w.x = cvt_pk_bf16(v[0], v[1]); w.y = cvt_pk_bf16(v[2], v[3]);
                        rs += (v[0] + v[1]) + (v[2] + v[3]); rq += (v[0] * v[0] + v[1] * v[1]) + (v[2] * v[2] + v[3] * v[3]);
                        *(u32x2e*)(out + off + bj * HALF + n * 16) = w; }
                if (stats) { rs += __shfl_xor(rs, 16); rs += __shfl_xor(rs, 32); rq += __shfl_xor(rq, 16); rq += __shfl_xor(rq, 32);
                    if (fq == 0) { float* sp = stats + 2 * (size_t)(row0 + ai * HALF + m * 16); atomicAdd(sp, rs); atomicAdd(sp + 1, rq); } } }
    }
};
struct EpiLNq {
    static constexpr bool PERM = true, AFTER_DRAIN = false;
    bf16_t* O; int ldc; const float* st; const float* c1; const float* c2;
    __device__ __forceinline__ void operator()(const f32x4 (&acc)[2][2][4][2], const Unit& u, int wr, int wc, int fr, int fq) const {
        const int row0 = u.pm * BM + wr * 64 + fr, col0 = u.pn * BM + wc * 32 + 8 * fq;
        f32x4 k1[2][2], k2[2][2];
#pragma unroll
        for (int bj = 0; bj < 2; ++bj)
#pragma unroll
            for (int n = 0; n < 2; ++n) { k1[bj][n] = *(const f32x4*)(c1 + col0 + bj * HALF + 4 * n); k2[bj][n] = *(const f32x4*)(c2 + col0 + bj * HALF + 4 * n); }
#pragma unroll
        for (int ai = 0; ai < 2; ++ai)
#pragma unroll
            for (int m = 0; m < 4; ++m) { const int row = row0 + ai * HALF + m * 16; const f32x2_nat sv = *(const f32x2_nat*)(st + 2 * (size_t)row);
                const float mu = sv[0] * (1.f / 1024.f), rstd = __builtin_amdgcn_rsqf(fmaxf(sv[1] * (1.f / 1024.f) - mu * mu, 0.f) + 1e-5f);
                bf16_t* rowp = O + (size_t)row * ldc + col0;
#pragma unroll
                for (int bj = 0; bj < 2; ++bj) { const f32x4 v0 = (acc[ai][bj][m][0] - k1[bj][0] * mu) * rstd + k2[bj][0], v1 = (acc[ai][bj][m][1] - k1[bj][1] * mu) * rstd + k2[bj][1];
                    u32x4 w; w.x = cvt_pk_bf16(v0[0], v0[1]); w.y = cvt_pk_bf16(v0[2], v0[3]); w.z = cvt_pk_bf16(v1[0], v1[1]); w.w = cvt_pk_bf16(v1[2], v1[3]);
                    *(u32x4*)(rowp + bj * HALF) = w; } }
    }
};
struct EpiResLN {
    static constexpr bool PERM = false, AFTER_DRAIN = false;
    const bf16_t* rsrc; const float* st; const float* gam; const float* bet; bf16_t* out; int ldc; float alpha; float* stats;
    __device__ __forceinline__ void operator()(const f32x4 (&acc)[2][2][4][2], const Unit& u, int wr, int wc, int fr, int fq) const {
        typedef unsigned u32x2e __attribute__((ext_vector_type(2)));
        const int row0 = u.pm * BM + wr * 64 + fr, col0 = u.pn * BM + wc * 32 + 4 * fq;
        f32x4 gv[2][2], bv[2][2];
#pragma unroll
        for (int bj = 0; bj < 2; ++bj)
#pragma unroll
            for (int n = 0; n < 2; ++n) { gv[bj][n] = *(const f32x4*)(gam + col0 + bj * HALF + n * 16); bv[bj][n] = *(const f32x4*)(bet + col0 + bj * HALF + n * 16); }
#pragma unroll
        for (int ai = 0; ai < 2; ++ai)
#pragma unroll
            for (int m = 0; m < 4; ++m) { const int row = row0 + ai * HALF + m * 16; const size_t off = (size_t)row * ldc + col0; const f32x2_nat sv = *(const f32x2_nat*)(st + 2 * (size_t)row);
                const float mu = sv[0] * (1.f / 1024.f), rstd = __builtin_amdgcn_rsqf(fmaxf(sv[1] * (1.f / 1024.f) - mu * mu, 0.f) + 1e-5f); float rs = 0.f, rq = 0.f;
#pragma unroll
                for (int bj = 0; bj < 2; ++bj)
#pragma unroll
                    for (int n = 0; n < 2; ++n) { const u32x2e bw = *(const u32x2e*)(rsrc + off + bj * HALF + n * 16);
                        const f32x4 rr = {__uint_as_float(bw.x << 16), __uint_as_float(bw.x & 0xffff0000u), __uint_as_float(bw.y << 16), __uint_as_float(bw.y & 0xffff0000u)};
                        const f32x4 xb_ = (rr - mu) * rstd * gv[bj][n] + bv[bj][n]; const f32x4 v = xb_ * alpha + acc[ai][bj][m][n];
                        u32x2e w; w.x = cvt_pk_bf16(v[0], v[1]); w.y = cvt_pk_bf16(v[2], v[3]);
                        rs += (v[0] + v[1]) + (v[2] + v[3]); rq += (v[0] * v[0] + v[1] * v[1]) + (v[2] * v[2] + v[3] * v[3]);
                        *(u32x2e*)(out + off + bj * HALF + n * 16) = w; }
                if (stats) { rs += __shfl_xor(rs, 16); rs += __shfl_xor(rs, 32); rq += __shfl_xor(rq, 16); rq += __shfl_xor(rq, 32);
                    if (fq == 0) { float* sp = stats + 2 * (size_t)row; atomicAdd(sp, rs); atomicAdd(sp + 1, rq); } } }
    }
};
struct EpiResB {
    static constexpr bool PERM = false, AFTER_DRAIN = false;
    const bf16_t* base; float* out; int ldc; float alpha;
    __device__ __forceinline__ void operator()(const f32x4 (&acc)[2][2][4][2], const Unit& u, int wr, int wc, int fr, int fq) const {
        const int row0 = u.pm * BM + wr * 64 + fr, col0 = u.pn * BM + wc * 32 + 4 * fq;
#pragma unroll
        for (int ai = 0; ai < 2; ++ai)
#pragma unroll
            for (int m = 0; m < 4; ++m) { const size_t off = (size_t)(row0 + ai * HALF + m * 16) * ldc + col0;
#pragma unroll
                for (int bj = 0; bj < 2; ++bj)
#pragma unroll
                    for (int n = 0; n < 2; ++n) { typedef unsigned u32x2e __attribute__((ext_vector_type(2))); const u32x2e bw = *(const u32x2e*)(base + off + bj * HALF + n * 16);
                        const f32x4 bs = {__uint_as_float(bw.x << 16), __uint_as_float(bw.x & 0xffff0000u), __uint_as_float(bw.y << 16), __uint_as_float(bw.y & 0xffff0000u)};
                        *(f32x4*)(out + off + bj * HALF + n * 16) = bs * alpha + acc[ai][bj][m][n]; } }
    }
};
struct EpiRes {
    static constexpr bool PERM = false, AFTER_DRAIN = false;
    const float* base; float* out; int ldc; float alpha;
    __device__ __forceinline__ void operator()(const f32x4 (&acc)[2][2][4][2], const Unit& u, int wr, int wc, int fr, int fq) const {
        const int row0 = u.pm * BM + wr * 64 + fr, col0 = u.pn * BM + wc * 32 + 4 * fq;
#pragma unroll
        for (int ai = 0; ai < 2; ++ai)
#pragma unroll
            for (int m = 0; m < 4; ++m) { const size_t off = (size_t)(row0 + ai * HALF + m * 16) * ldc + col0;
#pragma unroll
                for (int bj = 0; bj < 2; ++bj)
#pragma unroll
                    for (int n = 0; n < 2; ++n) { const f32x4 bs = *(const f32x4*)(base + off + bj * HALF + n * 16);
                        *(f32x4*)(out + off + bj * HALF + n * 16) = bs * alpha + acc[ai][bj][m][n]; } }
    }
};
template <class Epi, class Sched, bool STAMP = false>
__device__ __forceinline__ void gemm_phase(PG8_LAS unsigned char* lds, const Gemm g, const Sched& S, const Epi& E, unsigned long long* stamps) {
    const int tid = threadIdx.x, wid = __builtin_amdgcn_readfirstlane(tid >> 6), lane = tid & 63, wr = wid >> 2, wc = wid & 3, fr = lane & 15, fq = lane >> 4;
    const int K = g.K, nt = K / BK;
    int ts_lo = 0, ts_hi = 0, nts = 0; const unsigned long long rt_entry = STAMP ? (unsigned long long)wall_clock64() : 0ull;
#define PG8_STAMP() do { if (STAMP && wid == 0 && nts < 64) { const unsigned long long _c = (unsigned long long)clock64(); \
        ts_lo = (lane == nts) ? (int)(unsigned)_c : ts_lo; ts_hi = (lane == nts) ? (int)(unsigned)(_c >> 32) : ts_hi; ++nts; } } while (0)
    PG8_STAMP();
    unsigned voffA[2], voffB[2];
#pragma unroll
    for (int i = 0; i < 2; ++i) { int R, C; stage_rc(tid * 16 + i * 8192, R, C); const int Rb = Epi::PERM ? ((R & ~31) + perm32(R & 31)) : R;
        voffA[i] = (unsigned)(R * K + C) * 2u; voffB[i] = (unsigned)(Rb * K + C) * 2u; }
    const size_t kstep = (size_t)(BK * 2);
    const size_t hstep = (size_t)HALF * K * 2;
    const size_t tstep = 2 * hstep;
    const unsigned ldsw = (unsigned)wid * 1024u;
    const int aoff = lds_byte(wr * 64 + fr, fq * 8), boff = lds_byte(wc * 32 + fr, fq * 8);
#define PG8_SA(b, h) (((b) * 2 + (h)) * HTB)
#define PG8_SB(b, h) ((4 + (b) * 2 + (h)) * HTB)
#define PG8_STAGE(bufoff, gbase, voff) do { _Pragma("unroll") for (int _i = 0; _i < 2; ++_i) \
        __builtin_amdgcn_global_load_lds((const unsigned*)((const char*)(gbase) + (voff)[_i]), (PG8_LAS unsigned*)(lds + (bufoff) + ldsw + _i * 8192), 16, 0, 0); } while (0)
#define PG8_LDA(dst, b, h) do { _Pragma("unroll") for (int m = 0; m < 4; ++m) _Pragma("unroll") for (int k = 0; k < 2; ++k) dst[m][k] = *(const PG8_LAS bf16x8*)(lds + PG8_SA(b, h) + aoff + m * 2048 + k * 1024); } while (0)
#define PG8_LDB(dst, b, h) do { _Pragma("unroll") for (int n = 0; n < 2; ++n) _Pragma("unroll") for (int k = 0; k < 2; ++k) dst[n][k] = *(const PG8_LAS bf16x8*)(lds + PG8_SB(b, h) + boff + n * 2048 + k * 1024); } while (0)
#define PG8_MMA(ai, bj, At, Bt) do { __builtin_amdgcn_s_setprio(1); _Pragma("unroll") for (int m = 0; m < 4; ++m) _Pragma("unroll") for (int n = 0; n < 2; ++n) _Pragma("unroll") for (int k = 0; k < 2; ++k) \
        acc[ai][bj][m][n] = __builtin_amdgcn_mfma_f32_16x16x32_bf16(Bt[n][k], At[m][k], acc[ai][bj][m][n], 0, 0, 0); __builtin_amdgcn_s_setprio(0); } while (0)
#define PG8_WAIT_V(n) asm volatile("s_waitcnt vmcnt(" #n ")" ::: "memory")
#define PG8_WAIT_L(n) asm volatile("s_waitcnt lgkmcnt(" #n ")" ::: "memory")
#define PG8_BAR __builtin_amdgcn_s_barrier()
#define PG8_SCHED __builtin_amdgcn_sched_barrier(0)
    Unit cur, nxt; int ui = 0;
    if (!S.next(0, cur)) return;
    f32x4 acc[2][2][4][2];
#pragma unroll
    for (int a = 0; a < 2; ++a)
#pragma unroll
        for (int b = 0; b < 2; ++b)
#pragma unroll
            for (int m = 0; m < 4; ++m)
#pragma unroll
                for (int n = 0; n < 2; ++n) acc[a][b][m][n] = (f32x4){0.f, 0.f, 0.f, 0.f};
    bf16x8 At[4][2], B0[2][2], B1[2][2];
    const char* cA = (const char*)g.A + (size_t)cur.pm * tstep; const char* cB = (const char*)g.Bt + (size_t)cur.pn * tstep;
    S.a_ready(cur);
    PG8_STAGE(PG8_SB(0, 0), cB, voffB); PG8_STAGE(PG8_SA(0, 0), cA, voffA); PG8_STAGE(PG8_SB(0, 1), cB + hstep, voffB); PG8_STAGE(PG8_SA(0, 1), cA + hstep, voffA);
    if (wr == 1) PG8_BAR;
    PG8_WAIT_V(4); PG8_BAR;
    PG8_STAGE(PG8_SB(1, 0), cB + kstep, voffB); PG8_STAGE(PG8_SA(1, 0), cA + kstep, voffA); PG8_STAGE(PG8_SB(1, 1), cB + hstep + kstep, voffB);
    PG8_WAIT_V(6); PG8_BAR;
    PG8_STAMP();
    for (;;) {
        const bool has_next = S.next(ui + 1, nxt);
        const char* nA = has_next ? (const char*)g.A + (size_t)nxt.pm * tstep : cA; const char* nB = has_next ? (const char*)g.Bt + (size_t)nxt.pn * tstep : cB;
        for (int t = 0; t < nt; t += 2) {
            const bool last = (t == nt - 2);
            const char* a1 = cA + (size_t)(t + 1) * kstep;
            const char* a2 = last ? nA : cA + (size_t)(t + 2) * kstep; const char* b2 = last ? nB : cB + (size_t)(t + 2) * kstep;
            const char* a3 = a2 + kstep; const char* b3 = b2 + kstep;
            if (last && has_next) S.a_ready(nxt);
            PG8_LDB(B0, 0, 0); PG8_SCHED; PG8_LDA(At, 0, 0); PG8_STAGE(PG8_SA(1, 1), a1 + hstep, voffA);
            PG8_WAIT_L(8); PG8_BAR; PG8_WAIT_L(0); PG8_MMA(0, 0, At, B0); PG8_BAR; PG8_SCHED;
            PG8_LDB(B1, 0, 1); PG8_STAGE(PG8_SB(0, 0), b2, voffB);
            PG8_BAR; PG8_WAIT_L(0); PG8_MMA(0, 1, At, B1); PG8_BAR;
            PG8_LDA(At, 0, 1); PG8_STAGE(PG8_SA(0, 0), a2, voffA);
            PG8_BAR; PG8_WAIT_L(0); PG8_MMA(1, 0, At, B0); PG8_BAR; PG8_SCHED;
            PG8_STAGE(PG8_SB(0, 1), b2 + hstep, voffB);
            PG8_WAIT_V(6); PG8_BAR; PG8_MMA(1, 1, At, B1); PG8_BAR;
            PG8_LDB(B0, 1, 0); PG8_SCHED; PG8_LDA(At, 1, 0); PG8_STAGE(PG8_SA(0, 1), a2 + hstep, voffA);
            PG8_WAIT_L(8); PG8_BAR; PG8_WAIT_L(0); PG8_MMA(0, 0, At, B0); PG8_BAR; PG8_SCHED;
            PG8_LDB(B1, 1, 1); PG8_STAGE(PG8_SB(1, 0), b3, voffB);
            PG8_BAR; PG8_WAIT_L(0); PG8_MMA(0, 1, At, B1); PG8_BAR;
            PG8_LDA(At, 1, 1); PG8_STAGE(PG8_SA(1, 0), a3, voffA);
            PG8_BAR; PG8_WAIT_L(0); PG8_MMA(1, 0, At, B0); PG8_BAR; PG8_SCHED;
            PG8_STAGE(PG8_SB(1, 1), b3 + hstep, voffB);
            PG8_WAIT_V(6); PG8_BAR; PG8_MMA(1, 1, At, B1); PG8_BAR;
        }
        PG8_STAMP();
        if constexpr (!Epi::AFTER_DRAIN) { E(acc, cur, wr, wc, fr, fq); S.done(cur); }
        PG8_STAMP();
        if (!has_next) break;
#pragma unroll
        for (int a = 0; a < 2; ++a)
#pragma unroll
            for (int b = 0; b < 2; ++b)
#pragma unroll
                for (int m = 0; m < 4; ++m)
#pragma unroll
                    for (int n = 0; n < 2; ++n) acc[a][b][m][n] = (f32x4){0.f, 0.f, 0.f, 0.f};
        cur = nxt; cA = nA; cB = nB; ++ui;
    }
    PG8_WAIT_V(0);
    if (wr == 0) PG8_BAR;
    PG8_BAR;
    if constexpr (Epi::AFTER_DRAIN) { E.fused(acc, cur, wr, wc, fr, fq, lds, wid, lane); S.done(cur); }
    PG8_STAMP();
    if (STAMP && wid == 0) { stamps[lane] = lane < nts ? (((unsigned long long)(unsigned)ts_hi << 32) | (unsigned)ts_lo) : 0ull;
        if (lane == 62) stamps[62] = rt_entry; if (lane == 63) stamps[63] = (unsigned long long)wall_clock64(); }
#undef PG8_STAMP
#undef PG8_SA
#undef PG8_SB
#undef PG8_STAGE
#undef PG8_LDA
#undef PG8_LDB
#undef PG8_MMA
#undef PG8_WAIT_V
#undef PG8_WAIT_L
#undef PG8_BAR
#undef PG8_SCHED
}

struct EpiFFN {
    static constexpr bool PERM = true, AFTER_DRAIN = false;
    bf16_t* H; const float* cw; const float* cb;
    __device__ __forceinline__ void operator()(const f32x4 (&acc)[2][2][4][2], const Unit& u, int wr, int wc, int fr, int fq) const {
        const int batch = u.pm / 17, jj = u.pm % 17, col0 = u.pn * 128 + wc * 32 + 8 * fq;
        const int lane = (int)(threadIdx.x & 63u), src1 = (lane & 48) | ((lane - 1) & 15), src2 = (lane & 48) | ((lane - 2) & 15);
#pragma unroll
        for (int n = 0; n < 2; ++n) { const int col = col0 + 4 * n;
            f32x4 wg[3], wv[3];
#pragma unroll
            for (int tp = 0; tp < 3; ++tp) { wg[tp] = *(const f32x4*)(cw + tp * 5632 + col); wv[tp] = *(const f32x4*)(cw + tp * 5632 + 2816 + col); }
            const f32x4 bg = *(const f32x4*)(cb + col), bvv = *(const f32x4*)(cb + 2816 + col);
#pragma unroll
            for (int ai = 0; ai < 2; ++ai) { const int gbase = 248 * jj + 62 * (2 * ai + wr);
                f32x4 q1g = {0.f, 0.f, 0.f, 0.f}, q2g = q1g, q1v = q1g, q2v = q1g;
#pragma unroll
                for (int m = 0; m < 4; ++m) { const f32x4 g0 = acc[ai][0][m][n], v0 = acc[ai][1][m][n]; f32x4 r1g, r2g, r1v, r2v;
#pragma unroll
                    for (int j = 0; j < 4; ++j) { r1g[j] = __shfl(g0[j], src1); r2g[j] = __shfl(g0[j], src2); r1v[j] = __shfl(v0[j], src1); r2v[j] = __shfl(v0[j], src2); }
                    const int lr = 16 * m + fr, tok = gbase + lr - 2;
                    f32x4 p1g = (fr >= 1) ? r1g : q1g, p2g = (fr >= 2) ? r2g : q2g, p1v = (fr >= 1) ? r1v : q1v, p2v = (fr >= 2) ? r2v : q2v;
                    const f32x4 z = {0.f, 0.f, 0.f, 0.f};
                    if (tok < 1) { p1g = z; p1v = z; }
                    if (tok < 2) { p2g = z; p2v = z; }
                    const f32x4 gate = bg + wg[0] * p2g + wg[1] * p1g + wg[2] * g0, val = bvv + wv[0] * p2v + wv[1] * p1v + wv[2] * v0;
                    if (lr >= 2 && tok < 4096) { float o4[4];
#pragma unroll
                        for (int j = 0; j < 4; ++j) { const float x = gate[j]; const float uu = 0.7978845608028654f * (x + 0.044715f * x * x * x);
                            const float th = 1.f - 2.f * __builtin_amdgcn_rcpf(1.f + __expf(2.f * uu)); o4[j] = 0.5f * x * (1.f + th) * val[j]; }
                        typedef unsigned u32x2e __attribute__((ext_vector_type(2))); u32x2e w; w.x = cvt_pk_bf16(o4[0], o4[1]); w.y = cvt_pk_bf16(o4[2], o4[3]);
                        *(u32x2e*)(H + ((size_t)batch * 4096 + tok) * 2816 + col) = w; }
                    q1g = r1g; q2g = r2g; q1v = r1v; q2v = r2v; } } }
    }
};
template <class Epi, class Sched, bool STAMP = false>
__device__ __forceinline__ void gemm_phase_ffn(PG8_LAS unsigned char* lds, const Gemm g, const Sched& S, const Epi& E, unsigned long long* stamps) {
    const int tid = threadIdx.x, wid = __builtin_amdgcn_readfirstlane(tid >> 6), lane = tid & 63, wr = wid >> 2, wc = wid & 3, fr = lane & 15, fq = lane >> 4;
    const int K = g.K, nt = K / BK;
    int ts_lo = 0, ts_hi = 0, nts = 0; const unsigned long long rt_entry = STAMP ? (unsigned long long)wall_clock64() : 0ull;
#define PG8_STAMP() do { if (STAMP && wid == 0 && nts < 64) { const unsigned long long _c = (unsigned long long)clock64(); \
        ts_lo = (lane == nts) ? (int)(unsigned)_c : ts_lo; ts_hi = (lane == nts) ? (int)(unsigned)(_c >> 32) : ts_hi; ++nts; } } while (0)
    PG8_STAMP();
    unsigned voffA[2], voffB[2];
#pragma unroll
    for (int i = 0; i < 2; ++i) { int R, C; stage_rc(tid * 16 + i * 8192, R, C); const int Rb = Epi::PERM ? ((R & ~31) + perm32(R & 31)) : R;
        voffA[i] = (unsigned)((62 * (R >> 6) + (R & 63)) * K + C) * 2u; voffB[i] = (unsigned)(Rb * K + C) * 2u; }
    const size_t kstep = (size_t)(BK * 2);
    const size_t hstepA = (size_t)124 * K * 2, hstepB = (size_t)2816 * K * 2;
#define PG8_ABASE(pm_) ((const char*)g.A + ((long)((pm_) / 17) * 4096 + 248L * ((pm_) % 17) - 2L) * (long)K * 2L)
#define PG8_BBASE(pn_) ((const char*)g.Bt + (size_t)(pn_) * HALF * K * 2)
    const unsigned ldsw = (unsigned)wid * 1024u;
    const int aoff = lds_byte(wr * 64 + fr, fq * 8), boff = lds_byte(wc * 32 + fr, fq * 8);
#define PG8_SA(b, h) (((b) * 2 + (h)) * HTB)
#define PG8_SB(b, h) ((4 + (b) * 2 + (h)) * HTB)
#define PG8_STAGE(bufoff, gbase, voff) do { _Pragma("unroll") for (int _i = 0; _i < 2; ++_i) \
        __builtin_amdgcn_global_load_lds((const unsigned*)((const char*)(gbase) + (voff)[_i]), (PG8_LAS unsigned*)(lds + (bufoff) + ldsw + _i * 8192), 16, 0, 0); } while (0)
#define PG8_LDA(dst, b, h) do { _Pragma("unroll") for (int m = 0; m < 4; ++m) _Pragma("unroll") for (int k = 0; k < 2; ++k) dst[m][k] = *(const PG8_LAS bf16x8*)(lds + PG8_SA(b, h) + aoff + m * 2048 + k * 1024); } while (0)
#define PG8_LDB(dst, b, h) do { _Pragma("unroll") for (int n = 0; n < 2; ++n) _Pragma("unroll") for (int k = 0; k < 2; ++k) dst[n][k] = *(const PG8_LAS bf16x8*)(lds + PG8_SB(b, h) + boff + n * 2048 + k * 1024); } while (0)
#define PG8_MMA(ai, bj, At, Bt) do { __builtin_amdgcn_s_setprio(1); _Pragma("unroll") for (int m = 0; m < 4; ++m) _Pragma("unroll") for (int n = 0; n < 2; ++n) _Pragma("unroll") for (int k = 0; k < 2; ++k) \
        acc[ai][bj][m][n] = __builtin_amdgcn_mfma_f32_16x16x32_bf16(Bt[n][k], At[m][k], acc[ai][bj][m][n], 0, 0, 0); __builtin_amdgcn_s_setprio(0); } while (0)
#define PG8_WAIT_V(n) asm volatile("s_waitcnt vmcnt(" #n ")" ::: "memory")
#define PG8_WAIT_L(n) asm volatile("s_waitcnt lgkmcnt(" #n ")" ::: "memory")
#define PG8_BAR __builtin_amdgcn_s_barrier()
#define PG8_SCHED __builtin_amdgcn_sched_barrier(0)
    Unit cur, nxt; int ui = 0;
    if (!S.next(0, cur)) return;
    f32x4 acc[2][2][4][2];
#pragma unroll
    for (int a = 0; a < 2; ++a)
#pragma unroll
        for (int b = 0; b < 2; ++b)
#pragma unroll
            for (int m = 0; m < 4; ++m)
#pragma unroll
                for (int n = 0; n < 2; ++n) acc[a][b][m][n] = (f32x4){0.f, 0.f, 0.f, 0.f};
    bf16x8 At[4][2], B0[2][2], B1[2][2];
    const char* cA = PG8_ABASE(cur.pm); const char* cB = PG8_BBASE(cur.pn);
    S.a_ready(cur);
    PG8_STAGE(PG8_SB(0, 0), cB, voffB); PG8_STAGE(PG8_SA(0, 0), cA, voffA); PG8_STAGE(PG8_SB(0, 1), cB + hstepB, voffB); PG8_STAGE(PG8_SA(0, 1), cA + hstepA, voffA);
    if (wr == 1) PG8_BAR;
    PG8_WAIT_V(4); PG8_BAR;
    PG8_STAGE(PG8_SB(1, 0), cB + kstep, voffB); PG8_STAGE(PG8_SA(1, 0), cA + kstep, voffA); PG8_STAGE(PG8_SB(1, 1), cB + hstepB + kstep, voffB);
    PG8_WAIT_V(6); PG8_BAR;
    PG8_STAMP();
    for (;;) {
        const bool has_next = S.next(ui + 1, nxt);
        const char* nA = has_next ? PG8_ABASE(nxt.pm) : cA; const char* nB = has_next ? PG8_BBASE(nxt.pn) : cB;
        for (int t = 0; t < nt; t += 2) {
            const bool last = (t == nt - 2);
            const char* a1 = cA + (size_t)(t + 1) * kstep;
            const char* a2 = last ? nA : cA + (size_t)(t + 2) * kstep; const char* b2 = last ? nB : cB + (size_t)(t + 2) * kstep;
            const char* a3 = a2 + kstep; const char* b3 = b2 + kstep;
            if (last && has_next) S.a_ready(nxt);
            PG8_LDB(B0, 0, 0); PG8_SCHED; PG8_LDA(At, 0, 0); PG8_STAGE(PG8_SA(1, 1), a1 + hstepA, voffA);
            PG8_WAIT_L(8); PG8_BAR; PG8_WAIT_L(0); PG8_MMA(0, 0, At, B0); PG8_BAR; PG8_SCHED;
            PG8_LDB(B1, 0, 1); PG8_STAGE(PG8_SB(0, 0), b2, voffB);
            PG8_BAR; PG8_WAIT_L(0); PG8_MMA(0, 1, At, B1); PG8_BAR;
            PG8_LDA(At, 0, 1); PG8_STAGE(PG8_SA(0, 0), a2, voffA);
            PG8_BAR; PG8_WAIT_L(0); PG8_MMA(1, 0, At, B0); PG8_BAR; PG8_SCHED;
            PG8_STAGE(PG8_SB(0, 1), b2 + hstepB, voffB);
            PG8_WAIT_V(6); PG8_BAR; PG8_MMA(1, 1, At, B1); PG8_BAR;
            PG8_LDB(B0, 1, 0); PG8_SCHED; PG8_LDA(At, 1, 0); PG8_STAGE(PG8_SA(0, 1), a2 + hstepA, voffA);
            PG8_WAIT_L(8); PG8_BAR; PG8_WAIT_L(0); PG8_MMA(0, 0, At, B0); PG8_BAR; PG8_SCHED;
            PG8_LDB(B1, 1, 1); PG8_STAGE(PG8_SB(1, 0), b3, voffB);
            PG8_BAR; PG8_WAIT_L(0); PG8_MMA(0, 1, At, B1); PG8_BAR;
            PG8_LDA(At, 1, 1); PG8_STAGE(PG8_SA(1, 0), a3, voffA);
            PG8_BAR; PG8_WAIT_L(0); PG8_MMA(1, 0, At, B0); PG8_BAR; PG8_SCHED;
            PG8_STAGE(PG8_SB(1, 1), b3 + hstepB, voffB);
            PG8_WAIT_V(6); PG8_BAR; PG8_MMA(1, 1, At, B1); PG8_BAR;
        }
        PG8_STAMP();
        if constexpr (!Epi::AFTER_DRAIN) { E(acc, cur, wr, wc, fr, fq); S.done(cur); }
        PG8_STAMP();
        if (!has_next) break;
#pragma unroll
        for (int a = 0; a < 2; ++a)
#pragma unroll
            for (int b = 0; b < 2; ++b)
#pragma unroll
                for (int m = 0; m < 4; ++m)
#pragma unroll
                    for (int n = 0; n < 2; ++n) acc[a][b][m][n] = (f32x4){0.f, 0.f, 0.f, 0.f};
        cur = nxt; cA = nA; cB = nB; ++ui;
    }
    PG8_WAIT_V(0);
    if (wr == 0) PG8_BAR;
    PG8_BAR;
    if constexpr (Epi::AFTER_DRAIN) { E.fused(acc, cur, wr, wc, fr, fq, lds, wid, lane); S.done(cur); }
    PG8_STAMP();
    if (STAMP && wid == 0) { stamps[lane] = lane < nts ? (((unsigned long long)(unsigned)ts_hi << 32) | (unsigned)ts_lo) : 0ull;
        if (lane == 62) stamps[62] = rt_entry; if (lane == 63) stamps[63] = (unsigned long long)wall_clock64(); }
#undef PG8_STAMP
#undef PG8_SA
#undef PG8_SB
#undef PG8_STAGE
#undef PG8_LDA
#undef PG8_LDB
#undef PG8_MMA
#undef PG8_WAIT_V
#undef PG8_WAIT_L
#undef PG8_BAR
#undef PG8_SCHED
#undef PG8_ABASE
#undef PG8_BBASE
}

template <class Epi, class Sched, bool ALIGN_EPI = false, bool SP2 = false>
__device__ __forceinline__ void gemm_phase2(PG8_LAS unsigned char* lds, const Gemm g, const Sched& S, const Epi& E) {
    const int tid = threadIdx.x, wid = __builtin_amdgcn_readfirstlane(tid >> 6), lane = tid & 63, wr = wid >> 2, wc = wid & 3, fr = lane & 15, fq = lane >> 4;
    const int K = g.K, nt = K / BK;
    unsigned voffA[2], voffB[2];
#pragma unroll
    for (int i = 0; i < 2; ++i) { int R, C; stage_rc(tid * 16 + i * 8192, R, C); const int Rb = Epi::PERM ? ((R & ~31) + perm32(R & 31)) : R;
        voffA[i] = (unsigned)(R * K + C) * 2u; voffB[i] = (unsigned)(Rb * K + C) * 2u; }
    const size_t kstep = (size_t)(BK * 2);
    const size_t hstep = (size_t)HALF * K * 2;
    const size_t tstep = 2 * hstep;
    const unsigned ldsw = (unsigned)wid * 1024u;
    const int aoff = lds_byte(wr * 64 + fr, fq * 8), boff = lds_byte(wc * 32 + fr, fq * 8);
#define PG8_SA(b, h) (((b) * 2 + (h)) * HTB)
#define PG8_SB(b, h) ((4 + (b) * 2 + (h)) * HTB)
#define PG8_STAGE(bufoff, gbase, voff) do { _Pragma("unroll") for (int _i = 0; _i < 2; ++_i) \
        __builtin_amdgcn_global_load_lds((const unsigned*)((const char*)(gbase) + (voff)[_i]), (PG8_LAS unsigned*)(lds + (bufoff) + ldsw + _i * 8192), 16, 0, 0); } while (0)
#define PG8_LDA(dst, b, h) do { _Pragma("unroll") for (int m = 0; m < 4; ++m) _Pragma("unroll") for (int k = 0; k < 2; ++k) dst[m][k] = *(const PG8_LAS bf16x8*)(lds + PG8_SA(b, h) + aoff + m * 2048 + k * 1024); } while (0)
#define PG8_LDB(dst, b, h) do { _Pragma("unroll") for (int n = 0; n < 2; ++n) _Pragma("unroll") for (int k = 0; k < 2; ++k) dst[n][k] = *(const PG8_LAS bf16x8*)(lds + PG8_SB(b, h) + boff + n * 2048 + k * 1024); } while (0)
#define PG8_MMA(ai, bj, At, Bt) do { __builtin_amdgcn_s_setprio(1); _Pragma("unroll") for (int m = 0; m < 4; ++m) _Pragma("unroll") for (int n = 0; n < 2; ++n) _Pragma("unroll") for (int k = 0; k < 2; ++k) \
        acc[ai][bj][m][n] = __builtin_amdgcn_mfma_f32_16x16x32_bf16(Bt[n][k], At[m][k], acc[ai][bj][m][n], 0, 0, 0); __builtin_amdgcn_s_setprio(0); } while (0)
#define PG8_WAIT_V(n) asm volatile("s_waitcnt vmcnt(" #n ")" ::: "memory")
#define PG8_WAIT_L(n) asm volatile("s_waitcnt lgkmcnt(" #n ")" ::: "memory")
#define PG8_BAR __builtin_amdgcn_s_barrier()
#define PG8_SCHED __builtin_amdgcn_sched_barrier(0)
    Unit cur, nxt; int ui = 0;
    if (!S.next(0, cur)) return;
    f32x4 acc[2][2][4][2];
#pragma unroll
    for (int a = 0; a < 2; ++a)
#pragma unroll
        for (int b = 0; b < 2; ++b)
#pragma unroll
            for (int m = 0; m < 4; ++m)
#pragma unroll
                for (int n = 0; n < 2; ++n) acc[a][b][m][n] = (f32x4){0.f, 0.f, 0.f, 0.f};
    bf16x8 At[4][2], B0[2][2], B1[2][2];
    const char* cA = (const char*)g.A + (size_t)cur.pm * tstep; const char* cB = (const char*)g.Bt + (size_t)cur.pn * tstep;
    S.a_ready(cur);
    if constexpr (SP2) {
        PG8_STAGE(PG8_SB(0, 0), cB, voffB); PG8_STAGE(PG8_SB(0, 1), cB + hstep, voffB); PG8_STAGE(PG8_SA(0, 0), cA, voffA); PG8_STAGE(PG8_SA(0, 1), cA + hstep, voffA);
        if (wr == 1) PG8_BAR;
        PG8_WAIT_V(2); PG8_BAR;
        PG8_STAGE(PG8_SB(1, 0), cB + kstep, voffB); PG8_STAGE(PG8_SA(1, 0), cA + kstep, voffA); PG8_STAGE(PG8_SB(1, 1), cB + hstep + kstep, voffB);
        PG8_WAIT_V(6); PG8_BAR;
    } else {
        PG8_STAGE(PG8_SB(0, 0), cB, voffB); PG8_STAGE(PG8_SA(0, 0), cA, voffA); PG8_STAGE(PG8_SB(0, 1), cB + hstep, voffB); PG8_STAGE(PG8_SA(0, 1), cA + hstep, voffA);
        if (wr == 1) PG8_BAR;
        PG8_WAIT_V(4); PG8_BAR;
        PG8_STAGE(PG8_SB(1, 0), cB + kstep, voffB); PG8_STAGE(PG8_SA(1, 0), cA + kstep, voffA); PG8_STAGE(PG8_SB(1, 1), cB + hstep + kstep, voffB);
        PG8_WAIT_V(6); PG8_BAR;
    }
    for (;;) {
        const bool has_next = S.next(ui + 1, nxt);
        const char* nA = has_next ? (const char*)g.A + (size_t)nxt.pm * tstep : cA; const char* nB = has_next ? (const char*)g.Bt + (size_t)nxt.pn * tstep : cB;
        for (int t = 0; t < nt; t += 2) {
            const bool last = (t == nt - 2);
            const char* a1 = cA + (size_t)(t + 1) * kstep;
            const char* a2 = last ? nA : cA + (size_t)(t + 2) * kstep; const char* b2 = last ? nB : cB + (size_t)(t + 2) * kstep;
            const char* a3 = a2 + kstep; const char* b3 = b2 + kstep;
            if (last && has_next) S.a_ready(nxt);
            if constexpr (SP2) {
            PG8_LDB(B0, 0, 0); PG8_LDB(B1, 0, 1); PG8_SCHED; PG8_LDA(At, 0, 0); PG8_STAGE(PG8_SA(1, 1), a1 + hstep, voffA);
            PG8_WAIT_V(8); PG8_WAIT_L(0); PG8_BAR; PG8_MMA(0, 0, At, B0); PG8_MMA(0, 1, At, B1); PG8_BAR; PG8_SCHED;
            PG8_LDA(At, 0, 1); PG8_STAGE(PG8_SB(0, 0), b2, voffB); PG8_STAGE(PG8_SB(0, 1), b2 + hstep, voffB); PG8_STAGE(PG8_SA(0, 0), a2, voffA);
            PG8_WAIT_V(8); PG8_WAIT_L(0); PG8_BAR; PG8_MMA(1, 0, At, B0); PG8_MMA(1, 1, At, B1); PG8_BAR; PG8_SCHED;
            PG8_LDB(B0, 1, 0); PG8_LDB(B1, 1, 1); PG8_SCHED; PG8_LDA(At, 1, 0); PG8_STAGE(PG8_SA(0, 1), a2 + hstep, voffA);
            PG8_WAIT_V(8); PG8_WAIT_L(0); PG8_BAR; PG8_MMA(0, 0, At, B0); PG8_MMA(0, 1, At, B1); PG8_BAR; PG8_SCHED;
            PG8_LDA(At, 1, 1); PG8_STAGE(PG8_SB(1, 0), b3, voffB); PG8_STAGE(PG8_SB(1, 1), b3 + hstep, voffB); PG8_STAGE(PG8_SA(1, 0), a3, voffA);
            PG8_WAIT_V(8); PG8_WAIT_L(0); PG8_BAR; PG8_MMA(1, 0, At, B0); PG8_MMA(1, 1, At, B1); PG8_BAR; PG8_SCHED;
            } else {
            PG8_LDB(B0, 0, 0); PG8_SCHED; PG8_LDA(At, 0, 0); PG8_STAGE(PG8_SA(1, 1), a1 + hstep, voffA);
            PG8_WAIT_L(8); PG8_BAR; PG8_WAIT_L(0); PG8_MMA(0, 0, At, B0); PG8_BAR; PG8_SCHED;
            PG8_LDB(B1, 0, 1); PG8_STAGE(PG8_SB(0, 0), b2, voffB);
            PG8_BAR; PG8_WAIT_L(0); PG8_MMA(0, 1, At, B1); PG8_BAR;
            PG8_LDA(At, 0, 1); PG8_STAGE(PG8_SA(0, 0), a2, voffA);
            PG8_BAR; PG8_WAIT_L(0); PG8_MMA(1, 0, At, B0); PG8_BAR; PG8_SCHED;
            PG8_STAGE(PG8_SB(0, 1), b2 + hstep, voffB);
            PG8_WAIT_V(6); PG8_BAR; PG8_MMA(1, 1, At, B1); PG8_BAR;
            PG8_LDB(B0, 1, 0); PG8_SCHED; PG8_LDA(At, 1, 0); PG8_STAGE(PG8_SA(0, 1), a2 + hstep, voffA);
            PG8_WAIT_L(8); PG8_BAR; PG8_WAIT_L(0); PG8_MMA(0, 0, At, B0); PG8_BAR; PG8_SCHED;
            PG8_LDB(B1, 1, 1); PG8_STAGE(PG8_SB(1, 0), b3, voffB);
            PG8_BAR; PG8_WAIT_L(0); PG8_MMA(0, 1, At, B1); PG8_BAR;
            PG8_LDA(At, 1, 1); PG8_STAGE(PG8_SA(1, 0), a3, voffA);
            PG8_BAR; PG8_WAIT_L(0); PG8_MMA(1, 0, At, B0); PG8_BAR; PG8_SCHED;
            PG8_STAGE(PG8_SB(1, 1), b3 + hstep, voffB);
            PG8_WAIT_V(6); PG8_BAR; PG8_MMA(1, 1, At, B1); PG8_BAR;
            }
        }
        if constexpr (ALIGN_EPI) { if (wr == 0) PG8_BAR; }
        if constexpr (!Epi::AFTER_DRAIN) { E(acc, cur, wr, wc, fr, fq); S.done(cur); }
        if (!has_next) break;
#pragma unroll
        for (int a = 0; a < 2; ++a)
#pragma unroll
            for (int b = 0; b < 2; ++b)
#pragma unroll
                for (int m = 0; m < 4; ++m)
#pragma unroll
                    for (int n = 0; n < 2; ++n) acc[a][b][m][n] = (f32x4){0.f, 0.f, 0.f, 0.f};
        cur = nxt; cA = nA; cB = nB; ++ui;
        if constexpr (ALIGN_EPI) { if (wr == 1) PG8_BAR; }
    }
    PG8_WAIT_V(0);
    if constexpr (!ALIGN_EPI) { if (wr == 0) PG8_BAR; }
    PG8_BAR;
    if constexpr (Epi::AFTER_DRAIN) { E.fused(acc, cur, wr, wc, fr, fq, lds, wid, lane); S.done(cur); }
#undef PG8_SA
#undef PG8_SB
#undef PG8_STAGE
#undef PG8_LDA
#undef PG8_LDB
#undef PG8_MMA
#undef PG8_WAIT_V
#undef PG8_WAIT_L
#undef PG8_BAR
#undef PG8_SCHED
}
template <class Epi, class Sched, bool ALIGN_EPI = false, bool SP2 = false>
__device__ __forceinline__ void gemm_phase2_ffn(PG8_LAS unsigned char* lds, const Gemm g, const Sched& S, const Epi& E) {
    const int tid = threadIdx.x, wid = __builtin_amdgcn_readfirstlane(tid >> 6), lane = tid & 63, wr = wid >> 2, wc = wid & 3, fr = lane & 15, fq = lane >> 4;
    const int K = g.K, nt = K / BK;
    unsigned voffA[2], voffB[2];
#pragma unroll
    for (int i = 0; i < 2; ++i) { int R, C; stage_rc(tid * 16 + i * 8192, R, C); const int Rb = Epi::PERM ? ((R & ~31) + perm32(R & 31)) : R;
        voffA[i] = (unsigned)((62 * (R >> 6) + (R & 63)) * K + C) * 2u; voffB[i] = (unsigned)(Rb * K + C) * 2u; }
    const size_t kstep = (size_t)(BK * 2);
    const size_t hstepA = (size_t)124 * K * 2, hstepB = (size_t)2816 * K * 2;
#define PG8_ABASE(pm_) ((const char*)g.A + ((long)((pm_) / 17) * 4096 + 248L * ((pm_) % 17) - 2L) * (long)K * 2L)
#define PG8_BBASE(pn_) ((const char*)g.Bt + (size_t)(pn_) * HALF * K * 2)
    const unsigned ldsw = (unsigned)wid * 1024u;
    const int aoff = lds_byte(wr * 64 + fr, fq * 8), boff = lds_byte(wc * 32 + fr, fq * 8);
#define PG8_SA(b, h) (((b) * 2 + (h)) * HTB)
#define PG8_SB(b, h) ((4 + (b) * 2 + (h)) * HTB)
#define PG8_STAGE(bufoff, gbase, voff) do { _Pragma("unroll") for (int _i = 0; _i < 2; ++_i) \
        __builtin_amdgcn_global_load_lds((const unsigned*)((const char*)(gbase) + (voff)[_i]), (PG8_LAS unsigned*)(lds + (bufoff) + ldsw + _i * 8192), 16, 0, 0); } while (0)
#define PG8_LDA(dst, b, h) do { _Pragma("unroll") for (int m = 0; m < 4; ++m) _Pragma("unroll") for (int k = 0; k < 2; ++k) dst[m][k] = *(const PG8_LAS bf16x8*)(lds + PG8_SA(b, h) + aoff + m * 2048 + k * 1024); } while (0)
#define PG8_LDB(dst, b, h) do { _Pragma("unroll") for (int n = 0; n < 2; ++n) _Pragma("unroll") for (int k = 0; k < 2; ++k) dst[n][k] = *(const PG8_LAS bf16x8*)(lds + PG8_SB(b, h) + boff + n * 2048 + k * 1024); } while (0)
#define PG8_MMA(ai, bj, At, Bt) do { __builtin_amdgcn_s_setprio(1); _Pragma("unroll") for (int m = 0; m < 4; ++m) _Pragma("unroll") for (int n = 0; n < 2; ++n) _Pragma("unroll") for (int k = 0; k < 2; ++k) \
        acc[ai][bj][m][n] = __builtin_amdgcn_mfma_f32_16x16x32_bf16(Bt[n][k], At[m][k], acc[ai][bj][m][n], 0, 0, 0); __builtin_amdgcn_s_setprio(0); } while (0)
#define PG8_WAIT_V(n) asm volatile("s_waitcnt vmcnt(" #n ")" ::: "memory")
#define PG8_WAIT_L(n) asm volatile("s_waitcnt lgkmcnt(" #n ")" ::: "memory")
#define PG8_BAR __builtin_amdgcn_s_barrier()
#define PG8_SCHED __builtin_amdgcn_sched_barrier(0)
    Unit cur, nxt; int ui = 0;
    if (!S.next(0, cur)) return;
    f32x4 acc[2][2][4][2];
#pragma unroll
    for (int a = 0; a < 2; ++a)
#pragma unroll
        for (int b = 0; b < 2; ++b)
#pragma unroll
            for (int m = 0; m < 4; ++m)
#pragma unroll
                for (int n = 0; n < 2; ++n) acc[a][b][m][n] = (f32x4){0.f, 0.f, 0.f, 0.f};
    bf16x8 At[4][2], B0[2][2], B1[2][2];
    const char* cA = PG8_ABASE(cur.pm); const char* cB = PG8_BBASE(cur.pn);
    S.a_ready(cur);
    if constexpr (SP2) {
        PG8_STAGE(PG8_SB(0, 0), cB, voffB); PG8_STAGE(PG8_SB(0, 1), cB + hstepB, voffB); PG8_STAGE(PG8_SA(0, 0), cA, voffA); PG8_STAGE(PG8_SA(0, 1), cA + hstepA, voffA);
        if (wr == 1) PG8_BAR;
        PG8_WAIT_V(2); PG8_BAR;
        PG8_STAGE(PG8_SB(1, 0), cB + kstep, voffB); PG8_STAGE(PG8_SA(1, 0), cA + kstep, voffA); PG8_STAGE(PG8_SB(1, 1), cB + hstepB + kstep, voffB);
        PG8_WAIT_V(6); PG8_BAR;
    } else {
        PG8_STAGE(PG8_SB(0, 0), cB, voffB); PG8_STAGE(PG8_SA(0, 0), cA, voffA); PG8_STAGE(PG8_SB(0, 1), cB + hstepB, voffB); PG8_STAGE(PG8_SA(0, 1), cA + hstepA, voffA);
        if (wr == 1) PG8_BAR;
        PG8_WAIT_V(4); PG8_BAR;
        PG8_STAGE(PG8_SB(1, 0), cB + kstep, voffB); PG8_STAGE(PG8_SA(1, 0), cA + kstep, voffA); PG8_STAGE(PG8_SB(1, 1), cB + hstepB + kstep, voffB);
        PG8_WAIT_V(6); PG8_BAR;
    }
    for (;;) {
        const bool has_next = S.next(ui + 1, nxt);
        const char* nA = has_next ? PG8_ABASE(nxt.pm) : cA; const char* nB = has_next ? PG8_BBASE(nxt.pn) : cB;
        for (int t = 0; t < nt; t += 2) {
            const bool last = (t == nt - 2);
            const char* a1 = cA + (size_t)(t + 1) * kstep;
            const char* a2 = last ? nA : cA + (size_t)(t + 2) * kstep; const char* b2 = last ? nB : cB + (size_t)(t + 2) * kstep;
            const char* a3 = a2 + kstep; const char* b3 = b2 + kstep;
            if (last && has_next) S.a_ready(nxt);
            if constexpr (SP2) {
            PG8_LDB(B0, 0, 0); PG8_LDB(B1, 0, 1); PG8_SCHED; PG8_LDA(At, 0, 0); PG8_STAGE(PG8_SA(1, 1), a1 + hstepA, voffA);
            PG8_WAIT_V(8); PG8_WAIT_L(0); PG8_BAR; PG8_MMA(0, 0, At, B0); PG8_MMA(0, 1, At, B1); PG8_BAR; PG8_SCHED;
            PG8_LDA(At, 0, 1); PG8_STAGE(PG8_SB(0, 0), b2, voffB); PG8_STAGE(PG8_SB(0, 1), b2 + hstepB, voffB); PG8_STAGE(PG8_SA(0, 0), a2, voffA);
            PG8_WAIT_V(8); PG8_WAIT_L(0); PG8_BAR; PG8_MMA(1, 0, At, B0); PG8_MMA(1, 1, At, B1); PG8_BAR; PG8_SCHED;
            PG8_LDB(B0, 1, 0); PG8_LDB(B1, 1, 1); PG8_SCHED; PG8_LDA(At, 1, 0); PG8_STAGE(PG8_SA(0, 1), a2 + hstepA, voffA);
            PG8_WAIT_V(8); PG8_WAIT_L(0); PG8_BAR; PG8_MMA(0, 0, At, B0); PG8_MMA(0, 1, At, B1); PG8_BAR; PG8_SCHED;
            PG8_LDA(At, 1, 1); PG8_STAGE(PG8_SB(1, 0), b3, voffB); PG8_STAGE(PG8_SB(1, 1), b3 + hstepB, voffB); PG8_STAGE(PG8_SA(1, 0), a3, voffA);
            PG8_WAIT_V(8); PG8_WAIT_L(0); PG8_BAR; PG8_MMA(1, 0, At, B0); PG8_MMA(1, 1, At, B1); PG8_BAR; PG8_SCHED;
            } else {
            PG8_LDB(B0, 0, 0); PG8_SCHED; PG8_LDA(At, 0, 0); PG8_STAGE(PG8_SA(1, 1), a1 + hstepA, voffA);
            PG8_WAIT_L(8); PG8_BAR; PG8_WAIT_L(0); PG8_MMA(0, 0, At, B0); PG8_BAR; PG8_SCHED;
            PG8_LDB(B1, 0, 1); PG8_STAGE(PG8_SB(0, 0), b2, voffB);
            PG8_BAR; PG8_WAIT_L(0); PG8_MMA(0, 1, At, B1); PG8_BAR;
            PG8_LDA(At, 0, 1); PG8_STAGE(PG8_SA(0, 0), a2, voffA);
            PG8_BAR; PG8_WAIT_L(0); PG8_MMA(1, 0, At, B0); PG8_BAR; PG8_SCHED;
            PG8_STAGE(PG8_SB(0, 1), b2 + hstepB, voffB);
            PG8_WAIT_V(6); PG8_BAR; PG8_MMA(1, 1, At, B1); PG8_BAR;
            PG8_LDB(B0, 1, 0); PG8_SCHED; PG8_LDA(At, 1, 0); PG8_STAGE(PG8_SA(0, 1), a2 + hstepA, voffA);
            PG8_WAIT_L(8); PG8_BAR; PG8_WAIT_L(0); PG8_MMA(0, 0, At, B0); PG8_BAR; PG8_SCHED;
            PG8_LDB(B1, 1, 1); PG8_STAGE(PG8_SB(1, 0), b3, voffB);
            PG8_BAR; PG8_WAIT_L(0); PG8_MMA(0, 1, At, B1); PG8_BAR;
            PG8_LDA(At, 1, 1); PG8_STAGE(PG8_SA(1, 0), a3, voffA);
            PG8_BAR; PG8_WAIT_L(0); PG8_MMA(1, 0, At, B0); PG8_BAR; PG8_SCHED;
            PG8_STAGE(PG8_SB(1, 1), b3 + hstepB, voffB);
            PG8_WAIT_V(6); PG8_BAR; PG8_MMA(1, 1, At, B1); PG8_BAR;
            }
        }
        if constexpr (ALIGN_EPI) { if (wr == 0) PG8_BAR; }
        if constexpr (!Epi::AFTER_DRAIN) { E(acc, cur, wr, wc, fr, fq); S.done(cur); }
        if (!has_next) break;
#pragma unroll
        for (int a = 0; a < 2; ++a)
#pragma unroll
            for (int b = 0; b < 2; ++b)
#pragma unroll
                for (int m = 0; m < 4; ++m)
#pragma unroll
                    for (int n = 0; n < 2; ++n) acc[a][b][m][n] = (f32x4){0.f, 0.f, 0.f, 0.f};
        cur = nxt; cA = nA; cB = nB; ++ui;
        if constexpr (ALIGN_EPI) { if (wr == 1) PG8_BAR; }
    }
    PG8_WAIT_V(0);
    if constexpr (!ALIGN_EPI) { if (wr == 0) PG8_BAR; }
    PG8_BAR;
    if constexpr (Epi::AFTER_DRAIN) { E.fused(acc, cur, wr, wc, fr, fq, lds, wid, lane); S.done(cur); }
#undef PG8_SA
#undef PG8_SB
#undef PG8_STAGE
#undef PG8_LDA
#undef PG8_LDB
#undef PG8_MMA
#undef PG8_WAIT_V
#undef PG8_WAIT_L
#undef PG8_BAR
#undef PG8_SCHED
#undef PG8_ABASE
#undef PG8_BBASE
}
}


using pg8::bf16_t; using pg8::bf16x8; using pg8::f32x4; using pg8::f32x2_nat;
#define LAS __attribute__((address_space(3)))
#ifndef N_LAUNCH_MODE
#define N_LAUNCH_MODE 0
#endif
constexpr int T = 32768, D = 1024, SEQ = 4096, NMEMR = 2048, DIN = 4104, NP = 4096, DFF = 2816, NUP = 5632, TH = 16384;
constexpr float ALPHA = 1.189207115002721f, LN_EPS = 1e-5f;
constexpr int HQ = 0, HF = 512, HI = 1024, HG = 1536, MQ = 2048, MK = 2560, MV = 3072, MO = 3584;
constexpr size_t MiB = 1ull << 20;
constexpr size_t WS_WIN = 0, WS_WOUT = 8 * MiB, WS_WQ = 10 * MiB, WS_WKV = 12 * MiB, WS_WO = 16 * MiB, WS_WUP = 18 * MiB, WS_WDN = 29 * MiB,
                 WS_GATES = 35 * MiB, WS_MEMB = 36 * MiB, WS_KB = 40 * MiB, WS_VT = 44 * MiB,
                 WS_XB = 50 * MiB  , WS_PROJ = 114 * MiB, WS_X1 = 114 * MiB, WS_X1B = 242 * MiB  , WS_QB = 306 * MiB,
                 WS_UB = 50 * MiB, WS_HB = 306 * MiB, WS_Y = 370 * MiB, WS_BAR = 49 * MiB;
constexpr size_t WS_ST1 = 483 * MiB, WS_ST2 = WS_ST1 + 256 * 1024, WS_CV = WS_ST1 + 512 * 1024;
constexpr int LDS_BYTES = 144 * 1024;
constexpr int NPH = 16;
struct Args { const float* in[23]; float* out; unsigned char* ws; int ph_lo, ph_hi; };

#define WAVE_LDS_SYNC() asm volatile("s_waitcnt lgkmcnt(0)" ::: "memory")
__device__ __forceinline__ unsigned pk2(float a, float b) { return pg8::cvt_pk_bf16(a, b); }
__device__ __forceinline__ bf16_t f2bf(float a) { return (bf16_t)(pk2(a, a) & 0xffffu); }
__device__ __forceinline__ float bf2f(bf16_t u) { return __uint_as_float(((unsigned)u) << 16); }
__device__ __forceinline__ float bflo(unsigned u) { return __uint_as_float(u << 16); }
__device__ __forceinline__ float bfhi(unsigned u) { return __uint_as_float(u & 0xffff0000u); }
__device__ __forceinline__ float wave_sum(float v) {
#pragma unroll
    for (int o = 1; o < 64; o <<= 1) v += __shfl_xor(v, o);
    return v;
}
__device__ __forceinline__ float sigm(float x) { return __builtin_amdgcn_rcpf(1.f + __expf(-x)); }
__device__ __forceinline__ float gelu_tanh(float x) { const float u = 0.7978845608028654f * (x + 0.044715f * x * x * x); const float th = 1.f - 2.f * __builtin_amdgcn_rcpf(1.f + __expf(2.f * u)); return 0.5f * x * (1.f + th); }

__device__ __forceinline__ void transpose_item(const float* W, int ldw, int K, int N, bf16_t* WT, LAS float* scr, int item, int lane, const float* gsc = nullptr, const float* bsc = nullptr, float* c1 = nullptr, float* c2 = nullptr) {
    const int nblk = N / 32, kb = item / nblk, nb = item % nblk, k0 = 64 * kb, n0 = 32 * nb;
    if (gsc) {
        float s1 = 0.f, s2 = 0.f;
#pragma unroll 8
        for (int i = 0; i < 32; ++i) { const int kk = 2 * i + (lane >> 5); const float wv = W[(size_t)(k0 + kk) * ldw + n0 + (lane & 31)]; const float gw = wv * gsc[k0 + kk];
            s1 += gw; s2 += wv * bsc[k0 + kk]; scr[kk * 33 + (lane & 31)] = gw; }
        s1 += __shfl_xor(s1, 32); s2 += __shfl_xor(s2, 32);
        if (lane < 32) { atomicAdd(c1 + n0 + lane, s1); atomicAdd(c2 + n0 + lane, s2); }
    } else {
#pragma unroll 8
    for (int i = 0; i < 32; ++i) { const int kk = 2 * i + (lane >> 5); scr[kk * 33 + (lane & 31)] = W[(size_t)(k0 + kk) * ldw + n0 + (lane & 31)]; }
    }
    WAVE_LDS_SYNC();
    const int c = lane & 7;
#pragma unroll
    for (int j = 0; j < 4; ++j) { const int n = (lane >> 3) + 8 * j; const LAS float* s = scr + (8 * c) * 33 + n;
        uint4 o; o.x = pk2(s[0 * 33], s[1 * 33]); o.y = pk2(s[2 * 33], s[3 * 33]); o.z = pk2(s[4 * 33], s[5 * 33]); o.w = pk2(s[6 * 33], s[7 * 33]);
        *(uint4*)(WT + (size_t)(n0 + n) * K + k0 + 8 * c) = o; }
    WAVE_LDS_SYNC();
}
__device__ __forceinline__ void p0_prep(const Args& a, LAS unsigned char* lds, int tid, int wave, int lane, int gw, int NGW) {
    unsigned char* ws = a.ws;
    LAS float* wgT = (LAS float*)lds;
    LAS float* scr = (LAS float*)(lds + 32768 + wave * 8448);
    const float* w_in = a.in[2];
    for (int e = tid; e < 8192; e += 512) { const int k = e >> 3, c = e & 7; wgT[c * 1024 + k] = w_in[(size_t)k * DIN + 4096 + c]; }
    __syncthreads();
    constexpr int I_IN = 16 * 128, I_KV = 16 * 64;
    for (int it = gw; it < I_IN + I_KV; it += NGW) {
        if (it < I_IN) transpose_item(a.in[2], DIN, D, NP, (bf16_t*)(ws + WS_WIN), scr, it, lane);
        else transpose_item(a.in[13], 2 * D, D, 2 * D, (bf16_t*)(ws + WS_WKV), scr, it - I_IN, lane);
    }
    for (int i = (gw * 64 + lane); i < (512 * 1024 + 64 * 1024) / 16; i += NGW * 64) ((uint4*)(ws + WS_ST1))[i] = make_uint4(0u, 0u, 0u, 0u);
    const float* x = a.in[0]; const float* b_in = a.in[3];
    bf16_t* xb = (bf16_t*)(ws + WS_XB); float* gates = (float*)(ws + WS_GATES);
    f32x4 xn[4];
    if (gw < T) {
#pragma unroll
        for (int j = 0; j < 4; ++j) xn[j] = ((const f32x4*)(x + (size_t)gw * D) + lane)[64 * j]; }
    for (int m = gw; m < T; m += NGW) {
        uint2* xo = (uint2*)(xb + (size_t)m * D) + lane;
        f32x4 xc[4];
#pragma unroll
        for (int j = 0; j < 4; ++j) xc[j] = xn[j];
        if (m + NGW < T) {
#pragma unroll
            for (int j = 0; j < 4; ++j) xn[j] = ((const f32x4*)(x + (size_t)(m + NGW) * D) + lane)[64 * j]; }
        float g[8];
#pragma unroll
        for (int c = 0; c < 8; ++c) g[c] = 0.f;
#pragma unroll
        for (int j = 0; j < 4; ++j) { const f32x4 v = xc[j]; uint2 o; o.x = pk2(v[0], v[1]); o.y = pk2(v[2], v[3]); xo[64 * j] = o;
#pragma unroll
            for (int c = 0; c < 8; ++c) { const f32x4 w = *(const LAS f32x4*)(wgT + c * 1024 + 4 * (lane + 64 * j)); g[c] += (v[0] * w[0] + v[1] * w[1]) + (v[2] * w[2] + v[3] * w[3]); } }
#pragma unroll
        for (int c = 0; c < 8; ++c) g[c] = wave_sum(g[c]);
        float r = g[0];
#pragma unroll
        for (int c = 1; c < 8; ++c) r = (lane == c) ? g[c] : r;
        if (lane < 8) gates[(size_t)m * 8 + lane] = r + b_in[4096 + lane];
    }
    const float* mem = a.in[1]; bf16_t* memb = (bf16_t*)(ws + WS_MEMB);
    for (int m = gw; m < NMEMR; m += NGW) {
        const f32x4* xr = (const f32x4*)(mem + (size_t)m * D) + lane; uint2* xo = (uint2*)(memb + (size_t)m * D) + lane;
#pragma unroll
        for (int j = 0; j < 4; ++j) { const f32x4 v = xr[64 * j]; uint2 o; o.x = pk2(v[0], v[1]); o.y = pk2(v[2], v[3]); xo[64 * j] = o; }
    }
}

__device__ __forceinline__ void late_prep(const Args& a, LAS unsigned char* lds, int wave, int lane, int gw2, int NGW2) {
    unsigned char* ws = a.ws; LAS float* scr = (LAS float*)(lds + 32768 + wave * 8448);
    constexpr int I_SQ = 16 * 32, I_UP = 16 * 176, I_DN = 44 * 32;
    for (int it = gw2; it < 3 * I_SQ + I_UP + I_DN; it += NGW2) {
        int r = it;
        if (r < I_SQ) { transpose_item(a.in[9], D, D, D, (bf16_t*)(ws + WS_WOUT), scr, r, lane); continue; } r -= I_SQ;
        if (r < I_SQ) { transpose_item(a.in[12], D, D, D, (bf16_t*)(ws + WS_WQ), scr, r, lane, a.in[10], a.in[11], (float*)(ws + WS_CV), (float*)(ws + WS_CV) + 1024); continue; } r -= I_SQ;
        if (r < I_SQ) { transpose_item(a.in[14], D, D, D, (bf16_t*)(ws + WS_WO), scr, r, lane); continue; } r -= I_SQ;
        if (r < I_UP) { transpose_item(a.in[17], NUP, D, NUP, (bf16_t*)(ws + WS_WUP), scr, r, lane); continue; } r -= I_UP;
        transpose_item(a.in[20], D, DFF, D, (bf16_t*)(ws + WS_WDN), scr, r, lane);
    }
}
__device__ __forceinline__ void hgrn2_rec(const Args& a, int b, int h, LAS float* lds, int tid, int wave, int lane) {
    const bf16_t* projb = (const bf16_t*)(a.ws + WS_PROJ); bf16_t* y = (bf16_t*)(a.ws + WS_Y);
    const float* lbl = a.in[4]; const float* nw = a.in[5];
    LAS float* sq = lds; LAS float* sf = lds + 2048; LAS float* sv = lds + 4096; LAS float* spart = lds + 6144;
    const int v = tid & 127, g = tid >> 7;
    const float l0 = lbl[h * 128 + v], l1 = lbl[512 + h * 128 + v]; const float lb = 1.f / (1.f + __expf(l1 - l0));
    float S[32];
#pragma unroll
    for (int i = 0; i < 32; ++i) S[i] = 0.f;
    for (int t0 = 0; t0 < SEQ; t0 += 16) {
#pragma unroll
        for (int i = 0; i < 4; ++i) { const int tt = g + 4 * i; const bf16_t* pr = projb + (size_t)(b * SEQ + t0 + tt) * NP + h * 128 + v;
            const float hq = bf2f(pr[HQ]), hf = bf2f(pr[HF]), hi = bf2f(pr[HI]);
            sq[tt * 128 + v] = hq * sigm(hq); sf[tt * 128 + v] = lb + (1.f - lb) * sigm(hf); sv[tt * 128 + v] = hi; }
        __syncthreads();
        for (int tt = 0; tt < 16; ++tt) { const float vv = sv[tt * 128 + v]; float part = 0.f;
#pragma unroll
            for (int i = 0; i < 32; i += 4) { const f32x4 f4 = *(const LAS f32x4*)(sf + tt * 128 + g * 32 + i), q4 = *(const LAS f32x4*)(sq + tt * 128 + g * 32 + i);
#pragma unroll
                for (int jj = 0; jj < 4; ++jj) { S[i + jj] = f4[jj] * S[i + jj] + (1.f - f4[jj]) * vv; part += q4[jj] * S[i + jj]; } }
            spart[(tt * 4 + g) * 128 + v] = part; }
        __syncthreads();
#pragma unroll
        for (int q = 0; q < 2; ++q) { const int tt = 2 * wave + q; const size_t row = (size_t)(b * SEQ + t0 + tt);
            float o0 = 0.f, o1 = 0.f;
#pragma unroll
            for (int gg = 0; gg < 4; ++gg) { o0 += spart[(tt * 4 + gg) * 128 + lane]; o1 += spart[(tt * 4 + gg) * 128 + lane + 64]; }
            const float rstd = rsqrtf(wave_sum(o0 * o0 + o1 * o1) * (1.f / 128.f) + LN_EPS);
            const float g0 = bf2f(projb[row * NP + HG + h * 128 + lane]), g1 = bf2f(projb[row * NP + HG + h * 128 + lane + 64]);
            y[row * D + h * 128 + lane] = f2bf(o0 * rstd * nw[h * 128 + lane] * (g0 * sigm(g0)));
            y[row * D + h * 128 + lane + 64] = f2bf(o1 * rstd * nw[h * 128 + lane + 64] * (g1 * sigm(g1))); }
    }
}
__device__ __forceinline__ void mlstm_rec(const Args& a, int b, int h, LAS float* lds, int tid, int wave, int lane) {
    const bf16_t* projb = (const bf16_t*)(a.ws + WS_PROJ); bf16_t* y = (bf16_t*)(a.ws + WS_Y); const float* gates = (const float*)(a.ws + WS_GATES);
    const float* cw = a.in[6]; const float* cb = a.in[7]; const float* nw = a.in[8];
    LAS float* sq = lds; LAS float* sk = lds + 2048; LAS float* sv = lds + 4096; LAS float* spart = lds + 6144;
    LAS float* sgi = lds + 6144 + 16 * 4 * 132; LAS float* sgf = sgi + 16; LAS float* smt = sgf + 16;
    const int v = tid & 127, g = tid >> 7;
    float cwq[4], cwk[4];
#pragma unroll
    for (int j = 0; j < 4; ++j) { cwq[j] = cw[j * 1024 + h * 128 + v]; cwk[j] = cw[j * 1024 + 512 + h * 128 + v]; }
    const float cbq = cb[h * 128 + v], cbk = cb[512 + h * 128 + v];
    float C[32], nn[32];
#pragma unroll
    for (int i = 0; i < 32; ++i) { C[i] = 0.f; nn[i] = 0.f; }
    float mrun = -1e30f;
    for (int t0 = 0; t0 < SEQ; t0 += 16) {
#pragma unroll
        for (int i = 0; i < 4; ++i) { const int tt = g + 4 * i, t = t0 + tt; const bf16_t* pr = projb + (size_t)(b * SEQ + t) * NP + h * 128 + v;
            float aq = cbq, ak = cbk;
#pragma unroll
            for (int j = 0; j < 4; ++j) { const int ts = t - 3 + j; if (ts >= 0) { const bf16_t* ps = pr - (size_t)(3 - j) * NP; aq += bf2f(ps[MQ]) * cwq[j]; ak += bf2f(ps[MK]) * cwk[j]; } }
            sq[tt * 128 + v] = aq * sigm(aq) * 0.08838834764831845f; sk[tt * 128 + v] = ak * sigm(ak); sv[tt * 128 + v] = bf2f(pr[MV]); }
        if (tid < 16) { const size_t row = (size_t)(b * SEQ + t0 + tid); const float mi = gates[row * 8 + h], mf = gates[row * 8 + 4 + h];
            sgi[tid] = mi; sgf[tid] = fminf(mf, 0.f) - log1pf(__expf(-fabsf(mf))); }
        __syncthreads();
        for (int tt = 0; tt < 16; ++tt) { const float vv = sv[tt * 128 + v];
            const float it = sgi[tt], lf = sgf[tt]; const float mnew = fmaxf(lf + mrun, it); const float fp = __expf(lf + mrun - mnew), ip = __expf(it - mnew); mrun = mnew;
            float part = 0.f, dpart = 0.f; const float iv = ip * vv;
#pragma unroll
            for (int i = 0; i < 32; i += 4) { const f32x4 k4 = *(const LAS f32x4*)(sk + tt * 128 + g * 32 + i), q4 = *(const LAS f32x4*)(sq + tt * 128 + g * 32 + i);
#pragma unroll
                for (int jj = 0; jj < 4; ++jj) { C[i + jj] = fp * C[i + jj] + iv * k4[jj]; nn[i + jj] = fp * nn[i + jj] + ip * k4[jj]; part += q4[jj] * C[i + jj]; dpart += q4[jj] * nn[i + jj]; } }
            spart[(tt * 4 + g) * 132 + v] = part; if (v == 0) spart[(tt * 4 + g) * 132 + 128] = dpart; if (tid == 0) smt[tt] = mnew; }
        __syncthreads();
#pragma unroll
        for (int q = 0; q < 2; ++q) { const int tt = 2 * wave + q; const size_t row = (size_t)(b * SEQ + t0 + tt);
            float o0 = 0.f, o1 = 0.f, den = 0.f;
#pragma unroll
            for (int gg = 0; gg < 4; ++gg) { o0 += spart[(tt * 4 + gg) * 132 + lane]; o1 += spart[(tt * 4 + gg) * 132 + lane + 64]; den += spart[(tt * 4 + gg) * 132 + 128]; }
            const float dn = 1.f / fmaxf(fabsf(den), __expf(-smt[tt]));
            o0 *= dn; o1 *= dn;
            const float mean = wave_sum(o0 + o1) * (1.f / 128.f); const float d0 = o0 - mean, d1 = o1 - mean;
            const float rstd = rsqrtf(wave_sum(d0 * d0 + d1 * d1) * (1.f / 128.f) + LN_EPS);
            const float g0 = bf2f(projb[row * NP + MO + h * 128 + lane]), g1 = bf2f(projb[row * NP + MO + h * 128 + lane + 64]);
            y[row * D + 512 + h * 128 + lane] = f2bf(sigm(g0) * d0 * rstd * nw[h * 128 + lane]);
            y[row * D + 512 + h * 128 + lane + 64] = f2bf(sigm(g1) * d1 * rstd * nw[h * 128 + lane + 64]); }
    }
}

constexpr int P128 = 136, P64 = 72;
typedef unsigned u32x2 __attribute__((ext_vector_type(2)));
typedef unsigned u32x4n __attribute__((ext_vector_type(4)));
__device__ __forceinline__ u32x2 pack4(float a, float b, float c, float d) { u32x2 r; r.x = pk2(a, b); r.y = pk2(c, d); return r; }
__device__ __forceinline__ void unpack4(u32x2 u, float (&o)[4]) { o[0] = bflo(u.x); o[1] = bfhi(u.x); o[2] = bflo(u.y); o[3] = bfhi(u.y); }
#define MFMA16(a, b, c) __builtin_amdgcn_mfma_f32_16x16x32_bf16(a, b, c, 0, 0, 0)
#define LDFRAG(base, row, pitch, ks) (*(const LAS bf16x8*)((base) + (row) * (pitch) + (ks) * 32 + quad * 8))

__device__ __forceinline__ void hgrn2_chunk(const Args& a, int b, int h, LAS unsigned char* lds, int tid, int w, int lane) {
    const bf16_t* projb = (const bf16_t*)(a.ws + WS_PROJ); bf16_t* y = (bf16_t*)(a.ws + WS_Y);
    const float* lbl = a.in[4]; const float* nw = a.in[5];
    LAS bf16_t* QD = (LAS bf16_t*)lds; LAS bf16_t* KD = QD + 64 * P128; LAS bf16_t* QB = KD + 64 * P128;
    LAS bf16_t* KLT = QB + 64 * P128; LAS bf16_t* VT = KLT + 128 * P64; LAS bf16_t* ATT = VT + 128 * P64; LAS bf16_t* ST = ATT + 64 * P64;
    LAS float* NRM = (LAS float*)(ST + 128 * P128);
    const int tg = lane >> 2, dg = lane & 3, quad = lane >> 4, r16 = lane & 15;
    const int tt = w >> 1, vh = w & 1;
    for (int e = tid; e < 128 * P128 / 2; e += 512) ((LAS unsigned*)ST)[e] = 0u;
    LAS float* NWL = NRM + 128;
    if (tid < 128) NWL[tid] = nw[h * 128 + tid];
    float lb[4];
#pragma unroll
    for (int k = 0; k < 4; ++k) { const int d = h * 128 + 16 * w + 4 * dg + k; lb[k] = __builtin_amdgcn_rcpf(1.f + __expf(lbl[512 + d] - lbl[d])); }
    f32x4 Sacc[8];
#pragma unroll
    for (int i = 0; i < 8; ++i) Sacc[i] = (f32x4){0.f, 0.f, 0.f, 0.f};
    const size_t rowbase = (size_t)b * SEQ;
    const bf16_t* pcol = projb + h * 128 + 16 * w + 4 * dg;
    const bf16_t* pgat = projb + HG + h * 128 + 64 * vh + 4 * quad;
    u32x2 rq[4], rf[4], rv[4], rg[4];
#pragma unroll
    for (int i = 0; i < 4; ++i) { const bf16_t* p = pcol + (rowbase + 4 * tg + i) * NP; rq[i] = *(const u32x2*)(p + HQ); rf[i] = *(const u32x2*)(p + HF); rv[i] = *(const u32x2*)(p + HI); }
#pragma unroll
    for (int vt = 0; vt < 4; ++vt) rg[vt] = *(const u32x2*)(pgat + (rowbase + 16 * tt + r16) * NP + 16 * vt);
    __syncthreads();
    for (int c = 0; c < 64; ++c) {
        float q[4][4], lf[4][4], kk[4][4], vv[4][4]; u32x2 rgc[4];
#pragma unroll
        for (int i = 0; i < 4; ++i) { float hq[4], hf[4]; unpack4(rq[i], hq); unpack4(rf[i], hf); unpack4(rv[i], vv[i]);
#pragma unroll
            for (int k = 0; k < 4; ++k) { q[i][k] = hq[k]; const float f = lb[k] + (1.f - lb[k]) * sigm(hf[k]); lf[i][k] = __logf(f); kk[i][k] = 1.f - f; } }
#pragma unroll
        for (int vt = 0; vt < 4; ++vt) rgc[vt] = rg[vt];
        float bref[4], blast[4], dec[4];
#pragma unroll
        for (int k = 0; k < 4; ++k) {
            lf[1][k] += lf[0][k]; lf[2][k] += lf[1][k]; lf[3][k] += lf[2][k];
            const float tot = lf[3][k]; float run = tot;
#pragma unroll
            for (int off = 4; off < 64; off <<= 1) { const float t2 = __shfl_up(run, off); if (lane >= off) run += t2; }
            const float excl = run - tot;
#pragma unroll
            for (int i = 0; i < 4; ++i) lf[i][k] += excl;
            bref[k] = __shfl(lf[3][k], 28 + dg); blast[k] = __shfl(lf[3][k], 60 + dg);
        }
#pragma unroll
        for (int j = 0; j < 4; ++j) { float e = __expf(blast[0]); e = (j == 1) ? __expf(blast[1]) : e; e = (j == 2) ? __expf(blast[2]) : e; e = (j == 3) ? __expf(blast[3]) : e; dec[j] = __shfl(e, 60 + quad); }
        {
            float eref[4], elast[4];
#pragma unroll
            for (int k = 0; k < 4; ++k) { eref[k] = __expf(bref[k]); elast[k] = __expf(blast[k] - bref[k]); }
            float kl[4][4];
#pragma unroll
            for (int i = 0; i < 4; ++i) { float qd[4], kd[4], qb[4];
#pragma unroll
                for (int k = 0; k < 4; ++k) { const float e1 = __expf(lf[i][k] - bref[k]), e2 = __expf(bref[k] - lf[i][k]);
                    qd[k] = q[i][k] * e1; kd[k] = kk[i][k] * e2; qb[k] = qd[k] * eref[k]; kl[i][k] = kd[k] * elast[k]; }
                const int off = (4 * tg + i) * P128 + 16 * w + 4 * dg;
                *(LAS u32x2*)(QD + off) = pack4(qd[0], qd[1], qd[2], qd[3]); *(LAS u32x2*)(KD + off) = pack4(kd[0], kd[1], kd[2], kd[3]); *(LAS u32x2*)(QB + off) = pack4(qb[0], qb[1], qb[2], qb[3]); }
#pragma unroll
            for (int k = 0; k < 4; ++k) { const int off = (16 * w + 4 * dg + k) * P64 + 4 * tg;
                *(LAS u32x2*)(KLT + off) = pack4(kl[0][k], kl[1][k], kl[2][k], kl[3][k]); *(LAS u32x2*)(VT + off) = pack4(vv[0][k], vv[1][k], vv[2][k], vv[3][k]); }
        }
        __syncthreads();
        { const int cn = (c + 1 < 64) ? c + 1 : 63;
#pragma unroll
            for (int i = 0; i < 4; ++i) { const bf16_t* p = pcol + (rowbase + cn * 64 + 4 * tg + i) * NP; rq[i] = *(const u32x2*)(p + HQ); rf[i] = *(const u32x2*)(p + HF); rv[i] = *(const u32x2*)(p + HI); }
#pragma unroll
            for (int vt = 0; vt < 4; ++vt) rg[vt] = *(const u32x2*)(pgat + (rowbase + cn * 64 + 16 * tt + r16) * NP + 16 * vt); }
        {
            bf16x8 qf[4];
#pragma unroll
            for (int ks = 0; ks < 4; ++ks) qf[ks] = LDFRAG(QD, 16 * tt + r16, P128, ks);
#pragma unroll
            for (int si = 0; si < 2; ++si) { const int st = 2 * vh + si; f32x4 acc = {0.f, 0.f, 0.f, 0.f};
                if (st <= tt) {
#pragma unroll
                    for (int ks = 0; ks < 4; ++ks) { const bf16x8 kf = LDFRAG(KD, 16 * st + r16, P128, ks); acc = MFMA16(kf, qf[ks], acc); }
                    const int t = 16 * tt + r16, s0 = 16 * st + 4 * quad;
#pragma unroll
                    for (int j = 0; j < 4; ++j) acc[j] = (s0 + j <= t) ? acc[j] : 0.f;
                }
                *(LAS u32x2*)(ATT + (16 * tt + r16) * P64 + 16 * st + 4 * quad) = pack4(acc[0], acc[1], acc[2], acc[3]); }
        }
        __syncthreads();
        f32x4 o[4];
        {
            bf16x8 af[2], qbf[4];
#pragma unroll
            for (int ks = 0; ks < 2; ++ks) af[ks] = LDFRAG(ATT, 16 * tt + r16, P64, ks);
#pragma unroll
            for (int ks = 0; ks < 4; ++ks) qbf[ks] = LDFRAG(QB, 16 * tt + r16, P128, ks);
            float ss = 0.f;
#pragma unroll
            for (int vt = 0; vt < 4; ++vt) { const int v0 = 64 * vh + 16 * vt; f32x4 acc = {0.f, 0.f, 0.f, 0.f};
#pragma unroll
                for (int ks = 0; ks < 2; ++ks) acc = MFMA16(LDFRAG(VT, v0 + r16, P64, ks), af[ks], acc);
#pragma unroll
                for (int ks = 0; ks < 4; ++ks) acc = MFMA16(LDFRAG(ST, v0 + r16, P128, ks), qbf[ks], acc);
                o[vt] = acc; ss += (acc[0] * acc[0] + acc[1] * acc[1]) + (acc[2] * acc[2] + acc[3] * acc[3]); }
            ss += __shfl_xor(ss, 16); ss += __shfl_xor(ss, 32);
            if (quad == 0) NRM[(16 * tt + r16) * 2 + vh] = ss;
            bf16x8 klf[2];
#pragma unroll
            for (int ks = 0; ks < 2; ++ks) klf[ks] = LDFRAG(KLT, 16 * w + r16, P64, ks);
#pragma unroll
            for (int v8 = 0; v8 < 8; ++v8) { f32x4 acc = Sacc[v8];
#pragma unroll
                for (int j = 0; j < 4; ++j) acc[j] *= dec[j];
#pragma unroll
                for (int ks = 0; ks < 2; ++ks) acc = MFMA16(klf[ks], LDFRAG(VT, 16 * v8 + r16, P64, ks), acc);
                Sacc[v8] = acc; }
        }
        __syncthreads();
#pragma unroll
        for (int v8 = 0; v8 < 8; ++v8) *(LAS u32x2*)(ST + (16 * v8 + r16) * P128 + 16 * w + 4 * quad) = pack4(Sacc[v8][0], Sacc[v8][1], Sacc[v8][2], Sacc[v8][3]);
        {
            const int t = 16 * tt + r16; const float rstd = __builtin_amdgcn_rsqf((NRM[t * 2] + NRM[t * 2 + 1]) * (1.f / 128.f) + LN_EPS);
            bf16_t* yp = y + (rowbase + c * 64 + t) * D + h * 128 + 64 * vh + 4 * quad;
#pragma unroll
            for (int vt = 0; vt < 4; ++vt) { float r[4], gt[4]; unpack4(rgc[vt], gt); const f32x4 nv = *(const LAS f32x4*)(NWL + 64 * vh + 16 * vt + 4 * quad);
#pragma unroll
                for (int j = 0; j < 4; ++j) r[j] = o[vt][j] * rstd * nv[j] * gt[j];
                *(u32x2*)(yp + 16 * vt) = pack4(r[0], r[1], r[2], r[3]); }
        }
    }
    __syncthreads();
}

__device__ __forceinline__ void mlstm_chunk(const Args& a, int b, int h, LAS unsigned char* lds, int tid, int w, int lane) {
    const bf16_t* projb = (const bf16_t*)(a.ws + WS_PROJ); bf16_t* y = (bf16_t*)(a.ws + WS_Y); const float* gates = (const float*)(a.ws + WS_GATES);
    const float* cw = a.in[6]; const float* cb = a.in[7]; const float* nw = a.in[8];
    LAS bf16_t* QM = (LAS bf16_t*)lds; LAS bf16_t* KM = QM + 64 * P128; LAS bf16_t* QW = KM + 64 * P128;
    LAS bf16_t* KLT = QW + 64 * P128; LAS bf16_t* VT = KLT + 128 * P64; LAS bf16_t* ATT = VT + 144 * P64; LAS bf16_t* ST = ATT + 64 * P64;
    LAS float* NRM = (LAS float*)(ST + 144 * P128);
    const int tg = lane >> 2, dg = lane & 3, quad = lane >> 4, r16 = lane & 15;
    const int tt = w >> 1, vh = w & 1;
    for (int e = tid; e < 144 * P128 / 2; e += 512) ((LAS unsigned*)ST)[e] = 0u;
    for (int e = tid; e < 16 * P64 / 2; e += 512) ((LAS unsigned*)(VT + 128 * P64))[e] = (e < P64 / 2) ? 0x3F803F80u : 0u;
    LAS float* NWL = NRM + 256 + 1280;
    if (tid < 128) NWL[tid] = nw[h * 128 + tid];
    LAS float* CWT = NRM + 256;
    for (int e = tid; e < 1280; e += 512) { const int r = e >> 7, d = e & 127; CWT[e] = (r < 4) ? cw[r * 1024 + h * 128 + d] : (r < 8) ? cw[(r - 4) * 1024 + 512 + h * 128 + d] : (r == 8) ? cb[h * 128 + d] : cb[512 + h * 128 + d]; }
    f32x4 Cacc[9];
#pragma unroll
    for (int i = 0; i < 9; ++i) Cacc[i] = (f32x4){0.f, 0.f, 0.f, 0.f};
    float m_st = -1e30f;
    const size_t rowbase = (size_t)b * SEQ;
    const bf16_t* pcol = projb + h * 128 + 16 * w + 4 * dg;
    const bf16_t* pgat = projb + MO + h * 128 + 64 * vh + 4 * quad;
    u32x2 rq[7], rk[7], rv[4], rg[4]; float rmi, rmf;
#pragma unroll
    for (int i = 0; i < 7; ++i) { const int t = 4 * tg + i - 3; if (t >= 0) { const bf16_t* p = pcol + (rowbase + t) * NP; rq[i] = *(const u32x2*)(p + MQ); rk[i] = *(const u32x2*)(p + MK); } else { rq[i] = (u32x2){0u, 0u}; rk[i] = (u32x2){0u, 0u}; } }
#pragma unroll
    for (int i = 0; i < 4; ++i) rv[i] = *(const u32x2*)(pcol + (rowbase + 4 * tg + i) * NP + MV);
#pragma unroll
    for (int vt = 0; vt < 4; ++vt) rg[vt] = *(const u32x2*)(pgat + (rowbase + 16 * tt + r16) * NP + 16 * vt);
    rmi = gates[(rowbase + lane) * 8 + h]; rmf = gates[(rowbase + lane) * 8 + 4 + h];
    __syncthreads();
    for (int c = 0; c < 64; ++c) {
        const float mi = rmi, lfs = fminf(rmf, 0.f) - log1pf(__expf(-fabsf(rmf)));
        float bs = lfs;
#pragma unroll
        for (int off = 1; off < 64; off <<= 1) { const float t2 = __shfl_up(bs, off); if (lane >= off) bs += t2; }
        const float gsum = __shfl(bs, 63);
        const float imb = mi - bs; float pm = imb;
#pragma unroll
        for (int off = 1; off < 64; off <<= 1) { const float t2 = __shfl_up(pm, off); if (lane >= off) pm = fmaxf(pm, t2); }
        const float inter = bs + m_st, m_t = fmaxf(inter, pm + bs);
        const float w_inter = __expf(inter - m_t);
        const float m_new = fmaxf(gsum + m_st, gsum + __shfl(pm, 63));
        const float decay = __expf(gsum + m_st - m_new), aexp = __expf(gsum + imb - m_new);
        const float bm = bs - m_t;
        float qv[4][4], kv[4][4], vv[4][4]; u32x2 rgc[4];
        {
            const LAS float* cwp = CWT + 16 * w + 4 * dg;
            { float xq[7][4]; f32x4 wq[4];
#pragma unroll
                for (int i = 0; i < 7; ++i) unpack4(rq[i], xq[i]);
#pragma unroll
                for (int j = 0; j < 4; ++j) wq[j] = *(const LAS f32x4*)(cwp + j * 128);
                const f32x4 bq = *(const LAS f32x4*)(cwp + 8 * 128);
#pragma unroll
                for (int i = 0; i < 4; ++i)
#pragma unroll
                    for (int k = 0; k < 4; ++k) { float aq = bq[k];
#pragma unroll
                        for (int j = 0; j < 4; ++j) aq += xq[i + j][k] * wq[j][k];
                        qv[i][k] = aq * sigm(aq) * 0.08838834764831845f; } }
            { float xk[7][4]; f32x4 wk[4];
#pragma unroll
                for (int i = 0; i < 7; ++i) unpack4(rk[i], xk[i]);
#pragma unroll
                for (int j = 0; j < 4; ++j) wk[j] = *(const LAS f32x4*)(cwp + (4 + j) * 128);
                const f32x4 bk = *(const LAS f32x4*)(cwp + 9 * 128);
#pragma unroll
                for (int i = 0; i < 4; ++i)
#pragma unroll
                    for (int k = 0; k < 4; ++k) { float ak = bk[k];
#pragma unroll
                        for (int j = 0; j < 4; ++j) ak += xk[i + j][k] * wk[j][k];
                        kv[i][k] = ak * sigm(ak); } }
#pragma unroll
            for (int i = 0; i < 4; ++i) unpack4(rv[i], vv[i]);
#pragma unroll
            for (int vt = 0; vt < 4; ++vt) rgc[vt] = rg[vt];
        }
        {
            float wi[4], ae[4];
#pragma unroll
            for (int i = 0; i < 4; ++i) { wi[i] = __shfl(w_inter, 4 * tg + i); ae[i] = __shfl(aexp, 4 * tg + i); }
#pragma unroll
            for (int i = 0; i < 4; ++i) { const int off = (4 * tg + i) * P128 + 16 * w + 4 * dg;
                *(LAS u32x2*)(QM + off) = pack4(qv[i][0], qv[i][1], qv[i][2], qv[i][3]); *(LAS u32x2*)(KM + off) = pack4(kv[i][0], kv[i][1], kv[i][2], kv[i][3]);
                *(LAS u32x2*)(QW + off) = pack4(qv[i][0] * wi[i], qv[i][1] * wi[i], qv[i][2] * wi[i], qv[i][3] * wi[i]); }
#pragma unroll
            for (int k = 0; k < 4; ++k) { const int off = (16 * w + 4 * dg + k) * P64 + 4 * tg;
                *(LAS u32x2*)(KLT + off) = pack4(kv[0][k] * ae[0], kv[1][k] * ae[1], kv[2][k] * ae[2], kv[3][k] * ae[3]); *(LAS u32x2*)(VT + off) = pack4(vv[0][k], vv[1][k], vv[2][k], vv[3][k]); }
        }
        __syncthreads();
        { const int cn = (c + 1 < 64) ? c + 1 : 63; const size_t rb = rowbase + cn * 64;
#pragma unroll
            for (int i = 0; i < 7; ++i) { const bf16_t* p = pcol + (rb + 4 * tg + i - 3) * NP; rq[i] = *(const u32x2*)(p + MQ); rk[i] = *(const u32x2*)(p + MK); }
#pragma unroll
            for (int i = 0; i < 4; ++i) rv[i] = *(const u32x2*)(pcol + (rb + 4 * tg + i) * NP + MV);
#pragma unroll
            for (int vt = 0; vt < 4; ++vt) rg[vt] = *(const u32x2*)(pgat + (rb + 16 * tt + r16) * NP + 16 * vt);
            rmi = gates[(rb + lane) * 8 + h]; rmf = gates[(rb + lane) * 8 + 4 + h]; }
        {
            bf16x8 qf[4];
#pragma unroll
            for (int ks = 0; ks < 4; ++ks) qf[ks] = LDFRAG(QM, 16 * tt + r16, P128, ks);
            const float bmt = __shfl(bm, 16 * tt + r16);
#pragma unroll
            for (int si = 0; si < 2; ++si) { const int st = 2 * vh + si; f32x4 acc = {0.f, 0.f, 0.f, 0.f};
                if (st <= tt) {
#pragma unroll
                    for (int ks = 0; ks < 4; ++ks) { const bf16x8 kf = LDFRAG(KM, 16 * st + r16, P128, ks); acc = MFMA16(kf, qf[ks], acc); }
                    const int t = 16 * tt + r16, s0 = 16 * st + 4 * quad;
#pragma unroll
                    for (int j = 0; j < 4; ++j) { const float ims = __shfl(imb, s0 + j); acc[j] = (s0 + j <= t) ? acc[j] * __expf(bmt + ims) : 0.f; }
                }
                *(LAS u32x2*)(ATT + (16 * tt + r16) * P64 + 16 * st + 4 * quad) = pack4(acc[0], acc[1], acc[2], acc[3]); }
        }
        __syncthreads();
        f32x4 o[4];
        {
            bf16x8 af[2], qwf[4];
#pragma unroll
            for (int ks = 0; ks < 2; ++ks) af[ks] = LDFRAG(ATT, 16 * tt + r16, P64, ks);
#pragma unroll
            for (int ks = 0; ks < 4; ++ks) qwf[ks] = LDFRAG(QW, 16 * tt + r16, P128, ks);
            f32x4 ae4 = {0.f, 0.f, 0.f, 0.f};
#pragma unroll
            for (int ks = 0; ks < 2; ++ks) ae4 = MFMA16(LDFRAG(VT, 128 + r16, P64, ks), af[ks], ae4);
#pragma unroll
            for (int ks = 0; ks < 4; ++ks) ae4 = MFMA16(LDFRAG(ST, 128 + r16, P128, ks), qwf[ks], ae4);
            const float den = __shfl(ae4[0], r16);
            const float mt_t = __shfl(m_t, 16 * tt + r16);
            const float dn = __builtin_amdgcn_rcpf(fmaxf(fabsf(den), __expf(-mt_t)));
            float s1 = 0.f, s2 = 0.f;
#pragma unroll
            for (int vt = 0; vt < 4; ++vt) { const int v0 = 64 * vh + 16 * vt; f32x4 acc = {0.f, 0.f, 0.f, 0.f};
#pragma unroll
                for (int ks = 0; ks < 2; ++ks) acc = MFMA16(LDFRAG(VT, v0 + r16, P64, ks), af[ks], acc);
#pragma unroll
                for (int ks = 0; ks < 4; ++ks) acc = MFMA16(LDFRAG(ST, v0 + r16, P128, ks), qwf[ks], acc);
                acc = acc * dn; o[vt] = acc; s1 += (acc[0] + acc[1]) + (acc[2] + acc[3]); s2 += (acc[0] * acc[0] + acc[1] * acc[1]) + (acc[2] * acc[2] + acc[3] * acc[3]); }
            s1 += __shfl_xor(s1, 16); s1 += __shfl_xor(s1, 32); s2 += __shfl_xor(s2, 16); s2 += __shfl_xor(s2, 32);
            if (quad == 0) { NRM[(16 * tt + r16) * 4 + 2 * vh] = s1; NRM[(16 * tt + r16) * 4 + 2 * vh + 1] = s2; }
            bf16x8 klf[2];
#pragma unroll
            for (int ks = 0; ks < 2; ++ks) klf[ks] = LDFRAG(KLT, 16 * w + r16, P64, ks);
#pragma unroll
            for (int v9 = 0; v9 < 9; ++v9) { f32x4 acc = Cacc[v9] * decay;
#pragma unroll
                for (int ks = 0; ks < 2; ++ks) acc = MFMA16(klf[ks], LDFRAG(VT, 16 * v9 + r16, P64, ks), acc);
                Cacc[v9] = acc; }
        }
        __syncthreads();
#pragma unroll
        for (int v9 = 0; v9 < 9; ++v9) *(LAS u32x2*)(ST + (16 * v9 + r16) * P128 + 16 * w + 4 * quad) = pack4(Cacc[v9][0], Cacc[v9][1], Cacc[v9][2], Cacc[v9][3]);
        {
            const int t = 16 * tt + r16; const float mean = (NRM[t * 4] + NRM[t * 4 + 2]) * (1.f / 128.f); const float var = fmaxf((NRM[t * 4 + 1] + NRM[t * 4 + 3]) * (1.f / 128.f) - mean * mean, 0.f);
            const float rstd = __builtin_amdgcn_rsqf(var + LN_EPS);
            bf16_t* yp = y + (rowbase + c * 64 + t) * D + 512 + h * 128 + 64 * vh + 4 * quad;
#pragma unroll
            for (int vt = 0; vt < 4; ++vt) { float r[4], gt[4]; unpack4(rgc[vt], gt); const f32x4 nv = *(const LAS f32x4*)(NWL + 64 * vh + 16 * vt + 4 * quad);
#pragma unroll
                for (int j = 0; j < 4; ++j) r[j] = gt[j] * (o[vt][j] - mean) * rstd * nv[j];
                *(u32x2*)(yp + 16 * vt) = pack4(r[0], r[1], r[2], r[3]); }
        }
        m_st = m_new;
    }
    __syncthreads();
}

__device__ __forceinline__ unsigned xcc_id() { return (unsigned)__builtin_amdgcn_s_getreg((3 << 11) | 20) & 0xFu; }
__device__ __forceinline__ void grid_bar(unsigned* bar, unsigned xcc, unsigned nxb, unsigned nx, unsigned round) {
    asm volatile("s_waitcnt vmcnt(0)" ::: "memory");
    __syncthreads();
    if (threadIdx.x == 0) {
        const unsigned prev = __hip_atomic_fetch_add(bar + 64 * (1 + xcc), 1u, __ATOMIC_RELAXED, __HIP_MEMORY_SCOPE_AGENT);
        if (prev + 1u == round * nxb) {
            __builtin_amdgcn_fence(__ATOMIC_RELEASE, "agent");
            asm volatile("s_waitcnt vmcnt(0)" ::: "memory");
            __hip_atomic_fetch_add(bar, 1u, __ATOMIC_RELAXED, __HIP_MEMORY_SCOPE_AGENT);
        }
        while (__hip_atomic_load(bar, __ATOMIC_RELAXED, __HIP_MEMORY_SCOPE_AGENT) < round * nx) __builtin_amdgcn_s_sleep(1);
        __builtin_amdgcn_fence(__ATOMIC_ACQUIRE, "agent");
        asm volatile("s_waitcnt vmcnt(0)" ::: "memory");
    }
    __syncthreads();
}
constexpr size_t WS_ATH = 434 * MiB, WS_ATM = 450 * MiB, WS_DECH = 466 * MiB, WS_SCM = 467 * MiB;
__device__ __forceinline__ void hgrn2_pre(const Args& a, int b, int h, int c, LAS unsigned char* lds, int tid, int w, int lane) {
    const bf16_t* projb = (const bf16_t*)(a.ws + WS_PROJ); const float* lbl = a.in[4];
    bf16_t* QBH = (bf16_t*)a.out; bf16_t* KLH = QBH + (size_t)T * 512; bf16_t* ATH = (bf16_t*)(a.ws + WS_ATH); float* DECH = (float*)(a.ws + WS_DECH);
    LAS bf16_t* QD = (LAS bf16_t*)lds; LAS bf16_t* KD = QD + 64 * P128;
    const int tg = lane >> 2, dg = lane & 3, quad = lane >> 4, r16 = lane & 15, tt = w >> 1, vh = w & 1;
    const size_t item = (size_t)((b * 4 + h) * 64 + c), row0 = (size_t)b * SEQ + c * 64;
    float lb[4];
#pragma unroll
    for (int k = 0; k < 4; ++k) { const int d = h * 128 + 16 * w + 4 * dg + k; lb[k] = __builtin_amdgcn_rcpf(1.f + __expf(lbl[512 + d] - lbl[d])); }
    const bf16_t* pcol = projb + h * 128 + 16 * w + 4 * dg;
    float q[4][4], lf[4][4], kk[4][4];
#pragma unroll
    for (int i = 0; i < 4; ++i) { const bf16_t* p = pcol + (row0 + 4 * tg + i) * NP; float hq[4], hf[4]; unpack4(*(const u32x2*)(p + HQ), hq); unpack4(*(const u32x2*)(p + HF), hf);
#pragma unroll
        for (int k = 0; k < 4; ++k) { q[i][k] = hq[k]; const float f = lb[k] + (1.f - lb[k]) * sigm(hf[k]); lf[i][k] = __logf(f); kk[i][k] = 1.f - f; } }
    float bref[4], blast[4];
#pragma unroll
    for (int k = 0; k < 4; ++k) {
        lf[1][k] += lf[0][k]; lf[2][k] += lf[1][k]; lf[3][k] += lf[2][k];
        const float tot = lf[3][k]; float run = tot;
#pragma unroll
        for (int off = 4; off < 64; off <<= 1) { const float t2 = __shfl_up(run, off); if (lane >= off) run += t2; }
        const float excl = run - tot;
#pragma unroll
        for (int i = 0; i < 4; ++i) lf[i][k] += excl;
        bref[k] = __shfl(lf[3][k], 28 + dg); blast[k] = __shfl(lf[3][k], 60 + dg);
    }
    {
        float eref[4], elast[4];
#pragma unroll
        for (int k = 0; k < 4; ++k) { eref[k] = __expf(bref[k]); elast[k] = __expf(blast[k] - bref[k]); }
        if (tg == 15) *(f32x4*)(DECH + item * 128 + 16 * w + 4 * dg) = (f32x4){__expf(blast[0]), __expf(blast[1]), __expf(blast[2]), __expf(blast[3])};
        float kl[4][4];
#pragma unroll
        for (int i = 0; i < 4; ++i) { float qd[4], kd[4], qb[4];
#pragma unroll
            for (int k = 0; k < 4; ++k) { const float e1 = __expf(lf[i][k] - bref[k]), e2 = __expf(bref[k] - lf[i][k]);
                qd[k] = q[i][k] * e1; kd[k] = kk[i][k] * e2; qb[k] = qd[k] * eref[k]; kl[i][k] = kd[k] * elast[k]; }
            const int off = (4 * tg + i) * P128 + 16 * w + 4 * dg;
            *(LAS u32x2*)(QD + off) = pack4(qd[0], qd[1], qd[2], qd[3]); *(LAS u32x2*)(KD + off) = pack4(kd[0], kd[1], kd[2], kd[3]);
            *(u32x2*)(QBH + (row0 + 4 * tg + i) * 512 + h * 128 + 16 * w + 4 * dg) = pack4(qb[0], qb[1], qb[2], qb[3]); }
#pragma unroll
        for (int k = 0; k < 4; ++k) *(u32x2*)(KLH + item * 8192 + (16 * w + 4 * dg + k) * 64 + 4 * tg) = pack4(kl[0][k], kl[1][k], kl[2][k], kl[3][k]);
    }
    __syncthreads();
    {
        bf16x8 qf[4];
#pragma unroll
        for (int ks = 0; ks < 4; ++ks) qf[ks] = LDFRAG(QD, 16 * tt + r16, P128, ks);
#pragma unroll
        for (int si = 0; si < 2; ++si) { const int st = 2 * vh + si; f32x4 acc = {0.f, 0.f, 0.f, 0.f};
            if (st <= tt) {
#pragma unroll
                for (int ks = 0; ks < 4; ++ks) { const bf16x8 kf = LDFRAG(KD, 16 * st + r16, P128, ks); acc = MFMA16(kf, qf[ks], acc); }
                const int t = 16 * tt + r16, s0 = 16 * st + 4 * quad;
#pragma unroll
                for (int j = 0; j < 4; ++j) acc[j] = (s0 + j <= t) ? acc[j] : 0.f;
            }
            *(u32x2*)(ATH + item * 4096 + (16 * tt + r16) * 64 + 16 * st + 4 * quad) = pack4(acc[0], acc[1], acc[2], acc[3]); }
    }
    __syncthreads();
}
__device__ __forceinline__ void mlstm_pre(const Args& a, int b, int h, int c, LAS unsigned char* lds, int tid, int w, int lane) {
    const bf16_t* projb = (const bf16_t*)(a.ws + WS_PROJ); const float* gates = (const float*)(a.ws + WS_GATES);
    const float* cw = a.in[6]; const float* cb = a.in[7];
    bf16_t* QMM = (bf16_t*)a.out + (size_t)T * 1024; bf16_t* KLM = QMM + (size_t)T * 512; bf16_t* ATM = (bf16_t*)(a.ws + WS_ATM); float* SCM = (float*)(a.ws + WS_SCM);
    LAS bf16_t* QM = (LAS bf16_t*)lds; LAS bf16_t* KM = QM + 64 * P128;
    const int tg = lane >> 2, dg = lane & 3, quad = lane >> 4, r16 = lane & 15, tt = w >> 1, vh = w & 1;
    const size_t item = (size_t)((b * 4 + h) * 64 + c), row0 = (size_t)b * SEQ + c * 64;
    const float mi = gates[(row0 + lane) * 8 + h], mf = gates[(row0 + lane) * 8 + 4 + h];
    float bs = fminf(mf, 0.f) - log1pf(__expf(-fabsf(mf)));
#pragma unroll
    for (int off = 1; off < 64; off <<= 1) { const float t2 = __shfl_up(bs, off); if (lane >= off) bs += t2; }
    const float imb = mi - bs; float pm = imb;
#pragma unroll
    for (int off = 1; off < 64; off <<= 1) { const float t2 = __shfl_up(pm, off); if (lane >= off) pm = fmaxf(pm, t2); }
    const float pm63 = __shfl(pm, 63);
    if (w == 0) { f32x2_nat o2 = {bs, pm}; *(f32x2_nat*)(SCM + (row0 + lane) * 8 + h * 2) = o2; }
    const float aloc = __expf(imb - pm63);
    const bf16_t* pcol = projb + h * 128 + 16 * w + 4 * dg; const int ch = h * 128 + 16 * w + 4 * dg;
    float qv[4][4], kv[4][4];
    {
        float xq[7][4], xk[7][4];
#pragma unroll
        for (int i = 0; i < 7; ++i) { const int tpos = c * 64 + 4 * tg + i - 3;
            if (tpos >= 0) { const bf16_t* p = pcol + ((size_t)b * SEQ + tpos) * NP; unpack4(*(const u32x2*)(p + MQ), xq[i]); unpack4(*(const u32x2*)(p + MK), xk[i]); }
            else {
#pragma unroll
                for (int k = 0; k < 4; ++k) { xq[i][k] = 0.f; xk[i][k] = 0.f; } } }
        f32x4 wq[4], wk[4];
#pragma unroll
        for (int j = 0; j < 4; ++j) { wq[j] = *(const f32x4*)(cw + j * 1024 + ch); wk[j] = *(const f32x4*)(cw + j * 1024 + 512 + ch); }
        const f32x4 bq = *(const f32x4*)(cb + ch), bk = *(const f32x4*)(cb + 512 + ch);
#pragma unroll
        for (int i = 0; i < 4; ++i)
#pragma unroll
            for (int k = 0; k < 4; ++k) { float aq = bq[k], ak = bk[k];
#pragma unroll
                for (int j = 0; j < 4; ++j) { aq += xq[i + j][k] * wq[j][k]; ak += xk[i + j][k] * wk[j][k]; }
                qv[i][k] = aq * sigm(aq) * 0.08838834764831845f; kv[i][k] = ak * sigm(ak); }
    }
    {
        float ae[4];
#pragma unroll
        for (int i = 0; i < 4; ++i) ae[i] = __shfl(aloc, 4 * tg + i);
#pragma unroll
        for (int i = 0; i < 4; ++i) { const int off = (4 * tg + i) * P128 + 16 * w + 4 * dg; const u32x2 qp = pack4(qv[i][0], qv[i][1], qv[i][2], qv[i][3]);
            *(LAS u32x2*)(QM + off) = qp; *(LAS u32x2*)(KM + off) = pack4(kv[i][0], kv[i][1], kv[i][2], kv[i][3]);
            *(u32x2*)(QMM + (row0 + 4 * tg + i) * 512 + h * 128 + 16 * w + 4 * dg) = qp; }
#pragma unroll
        for (int k = 0; k < 4; ++k) *(u32x2*)(KLM + item * 8192 + (16 * w + 4 * dg + k) * 64 + 4 * tg) = pack4(kv[0][k] * ae[0], kv[1][k] * ae[1], kv[2][k] * ae[2], kv[3][k] * ae[3]);
    }
    __syncthreads();
    {
        bf16x8 qf[4];
#pragma unroll
        for (int ks = 0; ks < 4; ++ks) qf[ks] = LDFRAG(QM, 16 * tt + r16, P128, ks);
        const float pmt = __shfl(pm, 16 * tt + r16);
#pragma unroll
        for (int si = 0; si < 2; ++si) { const int st = 2 * vh + si; f32x4 acc = {0.f, 0.f, 0.f, 0.f};
            if (st <= tt) {
#pragma unroll
                for (int ks = 0; ks < 4; ++ks) { const bf16x8 kf = LDFRAG(KM, 16 * st + r16, P128, ks); acc = MFMA16(kf, qf[ks], acc); }
                const int t = 16 * tt + r16, s0 = 16 * st + 4 * quad;
#pragma unroll
                for (int j = 0; j < 4; ++j) { const float ims = __shfl(imb, s0 + j); acc[j] = (s0 + j <= t) ? acc[j] * __expf(ims - pmt) : 0.f; }
            }
            *(u32x2*)(ATM + item * 4096 + (16 * tt + r16) * 64 + 16 * st + 4 * quad) = pack4(acc[0], acc[1], acc[2], acc[3]); }
    }
    __syncthreads();
}
template <int KIND> __device__ __forceinline__ void scan_loop(const Args& a, int b, int h, LAS unsigned char* lds, int tid, int w, int lane, unsigned* bar, unsigned xcc, unsigned nxb, unsigned nx, unsigned& bround) {
    constexpr int NV = KIND ? 144 : 128, NVT = NV / 16;
    const bf16_t* projb = (const bf16_t*)(a.ws + WS_PROJ); bf16_t* y = (bf16_t*)(a.ws + WS_Y);
    const bf16_t* QBG = KIND ? (const bf16_t*)a.out + (size_t)T * 1024 : (const bf16_t*)a.out; const bf16_t* KLG = QBG + (size_t)T * 512;
    const bf16_t* ATG = (const bf16_t*)(a.ws + (KIND ? WS_ATM : WS_ATH)); const float* DECH = (const float*)(a.ws + WS_DECH); const float* SCM = (const float*)(a.ws + WS_SCM);
    const float* nw = KIND ? a.in[8] : a.in[5];
    LAS bf16_t* QB = (LAS bf16_t*)lds; LAS bf16_t* ATT = QB + 64 * P128; LAS bf16_t* KLT = ATT + 64 * P64; LAS bf16_t* VT = KLT + 128 * P64; LAS bf16_t* ST = VT + NV * P64;
    LAS float* NRM = (LAS float*)(ST + NV * P128); LAS float* NWL = NRM + 256;
    const int tg = lane >> 2, dg = lane & 3, quad = lane >> 4, r16 = lane & 15, tt = w >> 1, vh = w & 1;
    for (int e = tid; e < NV * P128 / 2; e += 512) ((LAS unsigned*)ST)[e] = 0u;
    if (KIND) for (int e = tid; e < 16 * P64 / 2; e += 512) ((LAS unsigned*)(VT + 128 * P64))[e] = (e < P64 / 2) ? 0x3F803F80u : 0u;
    if (tid < 128) NWL[tid] = nw[h * 128 + tid];
    f32x4 Sacc[10];
#pragma unroll
    for (int i = 0; i < 10; ++i) Sacc[i] = (f32x4){0.f, 0.f, 0.f, 0.f};
    float m_st = -1e30f;
    const size_t rowbase = (size_t)b * SEQ, item0 = (size_t)(b * 4 + h) * 64;
    const bf16_t* pv = projb + (KIND ? MV : HI) + h * 128 + 16 * w + 4 * dg;
    const bf16_t* pgat = projb + (KIND ? MO : HG) + h * 128 + 64 * vh + 4 * quad;
    struct PSet { u32x4n rqb[2], rat, rkl[2]; f32x4 rdec, rdec2; f32x2_nat rsc; }; u32x2 rv[4];
    PSet SA, SB; SA.rdec = SB.rdec = SA.rdec2 = SB.rdec2 = (f32x4){1.f, 1.f, 1.f, 1.f}; SA.rsc = SB.rsc = (f32x2_nat){0.f, 0.f};
#define SCAN_LOAD(P_, cc) do { const size_t rb_ = rowbase + (size_t)(cc) * 64, it_ = item0 + (cc); \
        _Pragma("unroll") for (int i = 0; i < 2; ++i) { const int e = tid + 512 * i; P_.rqb[i] = *(const u32x4n*)(QBG + (rb_ + (e >> 4)) * 512 + h * 128 + (e & 15) * 8); P_.rkl[i] = *(const u32x4n*)(KLG + it_ * 8192 + (size_t)e * 8); } \
        P_.rat = *(const u32x4n*)(ATG + it_ * 4096 + (size_t)tid * 8); \
        if (KIND) P_.rsc = *(const f32x2_nat*)(SCM + (rb_ + lane) * 8 + h * 2); else { P_.rdec = *(const f32x4*)(DECH + it_ * 128 + 32 * tt + 4 * quad); P_.rdec2 = *(const f32x4*)(DECH + it_ * 128 + 32 * tt + 16 + 4 * quad); } } while (0)
    SCAN_LOAD(SA, 0); SCAN_LOAD(SB, 1);
#pragma unroll
    for (int i = 0; i < 4; ++i) rv[i] = *(const u32x2*)(pv + (rowbase + 4 * tg + i) * NP);
    __syncthreads();
#define SCAN_STEP(P_, c) do { \
        u32x2 rgc[4]; f32x4 dec = P_.rdec, dec2 = P_.rdec2; float rt_ = 1.f, wi_ = 0.f, mt_ = 0.f, decay = 1.f, scU = 1.f, m_new = 0.f; \
_Pragma("unroll") \
        for (int i = 0; i < 2; ++i) { const int e = tid + 512 * i; *(LAS u32x4n*)(QB + (e >> 4) * P128 + (e & 15) * 8) = P_.rqb[i]; *(LAS u32x4n*)(KLT + (e >> 3) * P64 + (e & 7) * 8) = P_.rkl[i]; } \
        *(LAS u32x4n*)(ATT + (tid >> 3) * P64 + (tid & 7) * 8) = P_.rat; \
        { float vv[4][4]; \
_Pragma("unroll") \
            for (int i = 0; i < 4; ++i) unpack4(rv[i], vv[i]); \
_Pragma("unroll") \
            for (int k = 0; k < 4; ++k) *(LAS u32x2*)(VT + (16 * w + 4 * dg + k) * P64 + 4 * tg) = pack4(vv[0][k], vv[1][k], vv[2][k], vv[3][k]); } \
        if (KIND) {                                                    \
            const float bs = P_.rsc[0], pm = P_.rsc[1]; const float g = __shfl(bs, 63), amax = g + __shfl(pm, 63); \
            const float inter = bs + m_st, m_t = fmaxf(inter, pm + bs); \
            const float wi = __expf(inter - m_t), rr = __expf(bs + pm - m_t); \
            m_new = fmaxf(g + m_st, amax); decay = __expf(g + m_st - m_new); scU = __expf(amax - m_new); \
            rt_ = __shfl(rr, 16 * tt + r16); wi_ = __shfl(wi, 16 * tt + r16); mt_ = __shfl(m_t, 16 * tt + r16); \
        } \
        __syncthreads(); \
        if ((((c) & 15) == 14) && (c) < 62) grid_bar(bar, xcc, nxb, nx, ++bround);     \
        { const int cn = ((c) + 2 < 64) ? (c) + 2 : 63; SCAN_LOAD(P_, cn); { const int c1 = ((c) + 1 < 64) ? (c) + 1 : 63; _Pragma("unroll") for (int i = 0; i < 4; ++i) rv[i] = *(const u32x2*)(pv + (rowbase + (size_t)c1 * 64 + 4 * tg + i) * NP); } _Pragma("unroll") for (int vt = 0; vt < 4; ++vt) rgc[vt] = *(const u32x2*)(pgat + (rowbase + (size_t)(c) * 64 + 16 * tt + r16) * NP + 16 * vt); } \
        f32x4 o[4]; \
        { \
            bf16x8 af[2], qbf[4]; \
_Pragma("unroll") \
            for (int ks = 0; ks < 2; ++ks) af[ks] = LDFRAG(ATT, 16 * tt + r16, P64, ks); \
_Pragma("unroll") \
            for (int ks = 0; ks < 4; ++ks) qbf[ks] = LDFRAG(QB, 16 * tt + r16, P128, ks); \
            float dn = 1.f; \
            if (KIND) { f32x4 a1 = {0.f, 0.f, 0.f, 0.f}, a2 = {0.f, 0.f, 0.f, 0.f}; \
_Pragma("unroll") \
                for (int ks = 0; ks < 2; ++ks) a1 = MFMA16(LDFRAG(VT, 128 + r16, P64, ks), af[ks], a1); \
_Pragma("unroll") \
                for (int ks = 0; ks < 4; ++ks) a2 = MFMA16(LDFRAG(ST, 128 + r16, P128, ks), qbf[ks], a2); \
                const float dl = rt_ * a1[0] + wi_ * a2[0]; const float den = __shfl(dl, r16); \
                dn = __builtin_amdgcn_rcpf(fmaxf(fabsf(den), __expf(-mt_))); } \
            float s1 = 0.f, s2 = 0.f; \
_Pragma("unroll") \
            for (int vt = 0; vt < 4; ++vt) { const int v0 = 64 * vh + 16 * vt; f32x4 a1 = {0.f, 0.f, 0.f, 0.f}, a2 = {0.f, 0.f, 0.f, 0.f}; \
_Pragma("unroll") \
                for (int ks = 0; ks < 2; ++ks) a1 = MFMA16(LDFRAG(VT, v0 + r16, P64, ks), af[ks], a1); \
_Pragma("unroll") \
                for (int ks = 0; ks < 4; ++ks) a2 = MFMA16(LDFRAG(ST, v0 + r16, P128, ks), qbf[ks], a2); \
                f32x4 acc = KIND ? (a1 * rt_ + a2 * wi_) * dn : (a1 + a2); \
                o[vt] = acc; s1 += (acc[0] + acc[1]) + (acc[2] + acc[3]); s2 += (acc[0] * acc[0] + acc[1] * acc[1]) + (acc[2] * acc[2] + acc[3] * acc[3]); } \
            s1 += __shfl_xor(s1, 16); s1 += __shfl_xor(s1, 32); s2 += __shfl_xor(s2, 16); s2 += __shfl_xor(s2, 32); \
            if (quad == 0) { NRM[(16 * tt + r16) * 4 + 2 * vh] = s1; NRM[(16 * tt + r16) * 4 + 2 * vh + 1] = s2; } \
            bf16x8 klf[2][2]; \
_Pragma("unroll") \
            for (int dt2 = 0; dt2 < 2; ++dt2) { _Pragma("unroll") for (int ks = 0; ks < 2; ++ks) klf[dt2][ks] = LDFRAG(KLT, 32 * tt + 16 * dt2 + r16, P64, ks); } \
_Pragma("unroll") \
            for (int vt = 0; vt < 4; ++vt) { bf16x8 vf[2]; \
_Pragma("unroll") \
                for (int ks = 0; ks < 2; ++ks) vf[ks] = LDFRAG(VT, 64 * vh + 16 * vt + r16, P64, ks); \
_Pragma("unroll") \
                for (int dt2 = 0; dt2 < 2; ++dt2) { f32x4 u = {0.f, 0.f, 0.f, 0.f}; \
_Pragma("unroll") \
                    for (int ks = 0; ks < 2; ++ks) u = MFMA16(klf[dt2][ks], vf[ks], u); \
                    if (KIND) Sacc[dt2 * 4 + vt] = Sacc[dt2 * 4 + vt] * decay + u * scU; else Sacc[dt2 * 4 + vt] = Sacc[dt2 * 4 + vt] * (dt2 ? dec2 : dec) + u; } } \
            if (KIND && vh == 0) { bf16x8 vf[2]; \
_Pragma("unroll") \
                for (int ks = 0; ks < 2; ++ks) vf[ks] = LDFRAG(VT, 128 + r16, P64, ks); \
_Pragma("unroll") \
                for (int dt2 = 0; dt2 < 2; ++dt2) { f32x4 u = {0.f, 0.f, 0.f, 0.f}; \
_Pragma("unroll") \
                    for (int ks = 0; ks < 2; ++ks) u = MFMA16(klf[dt2][ks], vf[ks], u); \
                    Sacc[8 + dt2] = Sacc[8 + dt2] * decay + u * scU; } } \
        } \
        __syncthreads(); \
_Pragma("unroll") \
        for (int dt2 = 0; dt2 < 2; ++dt2) { \
_Pragma("unroll") \
            for (int vt = 0; vt < 4; ++vt) *(LAS u32x2*)(ST + (64 * vh + 16 * vt + r16) * P128 + 32 * tt + 16 * dt2 + 4 * quad) = pack4(Sacc[dt2 * 4 + vt][0], Sacc[dt2 * 4 + vt][1], Sacc[dt2 * 4 + vt][2], Sacc[dt2 * 4 + vt][3]); \
            if (KIND && vh == 0) *(LAS u32x2*)(ST + (128 + r16) * P128 + 32 * tt + 16 * dt2 + 4 * quad) = pack4(Sacc[8 + dt2][0], Sacc[8 + dt2][1], Sacc[8 + dt2][2], Sacc[8 + dt2][3]); } \
        { \
            const int t = 16 * tt + r16; const f32x4 nr = *(const LAS f32x4*)(NRM + t * 4); \
            const float mean = KIND ? (nr[0] + nr[2]) * (1.f / 128.f) : 0.f; const float var = fmaxf((nr[1] + nr[3]) * (1.f / 128.f) - mean * mean, 0.f); \
            const float rstd = __builtin_amdgcn_rsqf(var + LN_EPS); \
            bf16_t* yp = y + (rowbase + (c) * 64 + t) * D + (KIND ? 512 : 0) + h * 128 + 64 * vh + 4 * quad; \
_Pragma("unroll") \
            for (int vt = 0; vt < 4; ++vt) { float r[4], gt[4]; unpack4(rgc[vt], gt); const f32x4 nv = *(const LAS f32x4*)(NWL + 64 * vh + 16 * vt + 4 * quad); \
_Pragma("unroll") \
                for (int j = 0; j < 4; ++j) r[j] = gt[j] * (o[vt][j] - mean) * rstd * nv[j]; \
                *(u32x2*)(yp + 16 * vt) = pack4(r[0], r[1], r[2], r[3]); } \
        } \
        if (KIND) m_st = m_new; \
    } while (0)
    for (int c2 = 0; c2 < 64; c2 += 2) { SCAN_STEP(SA, c2); SCAN_STEP(SB, c2 + 1); }
#undef SCAN_STEP
#undef SCAN_LOAD
    __syncthreads();
}

__device__ __forceinline__ void ln_rows(const float* r, const float* gam, const float* bet, float* xo, bf16_t* xbo, int lane, int gw, int NGW) {
    const f32x4 *gp = (const f32x4*)gam + lane, *bp = (const f32x4*)bet + lane;
    for (int m = gw; m < T; m += 2 * NGW) {
        f32x4 v[2][4]; float s[2] = {0.f, 0.f};
#pragma unroll
        for (int q = 0; q < 2; ++q) { const f32x4* xr = (const f32x4*)(r + (size_t)(m + q * NGW) * D) + lane;
#pragma unroll
            for (int j = 0; j < 4; ++j) v[q][j] = xr[64 * j]; }
#pragma unroll
        for (int q = 0; q < 2; ++q)
#pragma unroll
            for (int j = 0; j < 4; ++j) s[q] += (v[q][j][0] + v[q][j][1]) + (v[q][j][2] + v[q][j][3]);
#pragma unroll
        for (int q = 0; q < 2; ++q) { const float mean = wave_sum(s[q]) * (1.f / D); float s2 = 0.f;
#pragma unroll
            for (int j = 0; j < 4; ++j) { v[q][j] = v[q][j] - mean; s2 += (v[q][j][0] * v[q][j][0] + v[q][j][1] * v[q][j][1]) + (v[q][j][2] * v[q][j][2] + v[q][j][3] * v[q][j][3]); }
            const float rstd = __builtin_amdgcn_rsqf(wave_sum(s2) * (1.f / D) + LN_EPS); const size_t mm = (size_t)(m + q * NGW);
#pragma unroll
            for (int j = 0; j < 4; ++j) { const f32x4 o = v[q][j] * rstd * gp[64 * j] + bp[64 * j];
                if (xo) ((f32x4*)(xo + mm * D) + lane)[64 * j] = o;
                if (xbo) { uint2 w; w.x = pk2(o[0], o[1]); w.y = pk2(o[2], o[3]); ((uint2*)(xbo + mm * D) + lane)[64 * j] = w; } } }
    }
}

__device__ __forceinline__ void ln_rows16(const bf16_t* r, const float* gam, const float* bet, float* xo, bf16_t* xbo, int lane, int gw, int NGW) {
    for (int m = gw; m < T; m += 2 * NGW) {
        float v[2][16]; float s[2] = {0.f, 0.f};
#pragma unroll
        for (int q = 0; q < 2; ++q) { const int mq = (m + q * NGW < T) ? m + q * NGW : m; const u32x4n* xr = (const u32x4n*)(r + (size_t)mq * D) + lane;
#pragma unroll
            for (int j = 0; j < 2; ++j) { const u32x4n w = xr[64 * j]; const unsigned ww[4] = {w.x, w.y, w.z, w.w};
#pragma unroll
                for (int i = 0; i < 4; ++i) { v[q][8 * j + 2 * i] = bflo(ww[i]); v[q][8 * j + 2 * i + 1] = bfhi(ww[i]); } } }
#pragma unroll
        for (int q = 0; q < 2; ++q)
#pragma unroll
            for (int i = 0; i < 16; ++i) s[q] += v[q][i];
#pragma unroll
        for (int q = 0; q < 2; ++q) { const float mean = wave_sum(s[q]) * (1.f / D); float s2 = 0.f;
#pragma unroll
            for (int i = 0; i < 16; ++i) { v[q][i] -= mean; s2 += v[q][i] * v[q][i]; }
            const float rstd = __builtin_amdgcn_rsqf(wave_sum(s2) * (1.f / D) + LN_EPS); const size_t mm = (size_t)(m + q * NGW); if (m + q * NGW >= T) continue;
#pragma unroll
            for (int j = 0; j < 2; ++j) { const int e0 = 8 * (lane + 64 * j); const f32x4 g0 = *(const f32x4*)(gam + e0), g1 = *(const f32x4*)(gam + e0 + 4), b0 = *(const f32x4*)(bet + e0), b1 = *(const f32x4*)(bet + e0 + 4);
                float o[8];
#pragma unroll
                for (int i = 0; i < 4; ++i) { o[i] = v[q][8 * j + i] * rstd * g0[i] + b0[i]; o[4 + i] = v[q][8 * j + 4 + i] * rstd * g1[i] + b1[i]; }
                if (xo) { *(f32x4*)(xo + mm * D + e0) = (f32x4){o[0], o[1], o[2], o[3]}; *(f32x4*)(xo + mm * D + e0 + 4) = (f32x4){o[4], o[5], o[6], o[7]}; }
                if (xbo) { u32x4n w; w.x = pk2(o[0], o[1]); w.y = pk2(o[2], o[3]); w.z = pk2(o[4], o[5]); w.w = pk2(o[6], o[7]); *(u32x4n*)(xbo + mm * D + e0) = w; } } }
    }
}

__device__ __forceinline__ void attn_phase(const bf16_t* qb, const bf16_t* kb, const bf16_t* vT, bf16_t* ao, LAS unsigned char* lds, int wave, int lane, int blk, int G) {
    LAS bf16_t* P = (LAS bf16_t*)(lds + wave * 8448);
    const int r16 = lane & 15, quad = lane >> 4;
    for (int bi = blk; bi < (T / 128) * 4; bi += G) {
        const int h = bi & 3, r0 = (bi >> 2) * 128 + wave * 16, b = r0 / SEQ;
        bf16x8 qa[8];
        const bf16_t* qp = qb + (size_t)(r0 + r16) * D + h * 256 + quad * 8;
#pragma unroll
        for (int ks = 0; ks < 8; ++ks) qa[ks] = *(const bf16x8*)(qp + ks * 32);
        f32x4 s[16];
        const bf16_t* kp = kb + (size_t)(b * 256 + r16) * D + h * 256 + quad * 8;
#pragma unroll
        for (int nt = 0; nt < 16; ++nt) { f32x4 acc = {0.f, 0.f, 0.f, 0.f};
#pragma unroll
            for (int ks = 0; ks < 8; ++ks) { const bf16x8 bfr = *(const bf16x8*)(kp + (size_t)nt * 16 * D + ks * 32); acc = __builtin_amdgcn_mfma_f32_16x16x32_bf16(qa[ks], bfr, acc, 0, 0, 0); }
            s[nt] = acc; }
        float sm[4];
#pragma unroll
        for (int j = 0; j < 4; ++j) { float mx = s[0][j];
#pragma unroll
            for (int nt = 1; nt < 16; ++nt) mx = fmaxf(mx, s[nt][j]);
            mx = fmaxf(mx, __shfl_xor(mx, 1)); mx = fmaxf(mx, __shfl_xor(mx, 2)); mx = fmaxf(mx, __shfl_xor(mx, 4)); mx = fmaxf(mx, __shfl_xor(mx, 8));
            float sum = 0.f;
#pragma unroll
            for (int nt = 0; nt < 16; ++nt) { const float p = __expf((s[nt][j] - mx) * 0.0625f); sum += p; P[(quad * 4 + j) * 264 + nt * 16 + r16] = f2bf(p); }
            sum += __shfl_xor(sum, 1); sum += __shfl_xor(sum, 2); sum += __shfl_xor(sum, 4); sum += __shfl_xor(sum, 8);
            sm[j] = 1.f / sum; }
        WAVE_LDS_SYNC();
        bf16x8 pa[8];
#pragma unroll
        for (int ks = 0; ks < 8; ++ks) pa[ks] = *(const LAS bf16x8*)(P + r16 * 264 + ks * 32 + quad * 8);
        WAVE_LDS_SYNC();
        const bf16_t* vp = vT + (size_t)(h * 256 + r16) * NMEMR + b * 256 + quad * 8;
        bf16_t* op = ao + (size_t)(r0 + quad * 4) * D + h * 256 + r16;
#pragma unroll
        for (int nt = 0; nt < 16; ++nt) { f32x4 acc = {0.f, 0.f, 0.f, 0.f};
#pragma unroll
            for (int ks = 0; ks < 8; ++ks) { const bf16x8 bfr = *(const bf16x8*)(vp + (size_t)nt * 16 * NMEMR + ks * 32); acc = __builtin_amdgcn_mfma_f32_16x16x32_bf16(pa[ks], bfr, acc, 0, 0, 0); }
#pragma unroll
            for (int j = 0; j < 4; ++j) op[(size_t)j * D + nt * 16] = f2bf(acc[j] * sm[j]); }
    }
}


__device__ __forceinline__ void attn_phase2(const bf16_t* qb, const bf16_t* kb, const bf16_t* vT, bf16_t* ao, LAS unsigned char* lds, int tid, int wave, int lane, int blk, int G) {
    constexpr int PKV = 264;
    LAS bf16_t* KV = (LAS bf16_t*)lds;
    const int r16 = lane & 15, quad = lane >> 4;
    for (int bi = blk; bi < (T / 128) * 4; bi += G) {
        const int h = bi & 3, chunk = bi >> 2, r0 = chunk * 128 + wave * 16, b = chunk >> 5;
        { const bf16_t* sp = kb + (size_t)(b * 256 + (tid >> 5)) * D + h * 256 + (tid & 31) * 8; LAS bf16_t* dp = KV + (tid >> 5) * PKV + (tid & 31) * 8;
#pragma unroll 1
            for (int q4 = 0; q4 < 4; ++q4) { u32x4n v[4];
#pragma unroll
                for (int i = 0; i < 4; ++i) v[i] = *(const u32x4n*)(sp + (size_t)(16 * i) * D);
#pragma unroll
                for (int i = 0; i < 4; ++i) *(LAS u32x4n*)(dp + (16 * i) * PKV) = v[i];
                sp += (size_t)64 * D; dp += 64 * PKV; } }
        bf16x8 qf[8];
        { const bf16_t* qp = qb + (size_t)(r0 + r16) * D + h * 256 + quad * 8;
#pragma unroll
            for (int ks = 0; ks < 8; ++ks) qf[ks] = *(const bf16x8*)(qp + ks * 32); }
        __syncthreads();
        f32x4 sc[16];
#pragma unroll
        for (int nt = 0; nt < 16; ++nt) { f32x4 acc = {0.f, 0.f, 0.f, 0.f};
#pragma unroll
            for (int ks = 0; ks < 8; ++ks) acc = MFMA16(LDFRAG(KV, nt * 16 + r16, PKV, ks), qf[ks], acc);
            sc[nt] = acc; }
        float mx = sc[0][0];
#pragma unroll
        for (int nt = 0; nt < 16; ++nt)
#pragma unroll
            for (int j = 0; j < 4; ++j) mx = fmaxf(mx, sc[nt][j]);
        mx = fmaxf(mx, __shfl_xor(mx, 16)); mx = fmaxf(mx, __shfl_xor(mx, 32));
        float sum = 0.f;
#pragma unroll
        for (int nt = 0; nt < 16; ++nt)
#pragma unroll
            for (int j = 0; j < 4; ++j) { const float pv = __expf((sc[nt][j] - mx) * 0.0625f); sc[nt][j] = pv; sum += pv; }
        sum += __shfl_xor(sum, 16); sum += __shfl_xor(sum, 32);
        const float inv = __builtin_amdgcn_rcpf(sum);
        bf16x8 pf[8];
#pragma unroll
        for (int k2 = 0; k2 < 8; ++k2) { u32x4n w; w.x = pk2(sc[2 * k2][0], sc[2 * k2][1]); w.y = pk2(sc[2 * k2][2], sc[2 * k2][3]); w.z = pk2(sc[2 * k2 + 1][0], sc[2 * k2 + 1][1]); w.w = pk2(sc[2 * k2 + 1][2], sc[2 * k2 + 1][3]);
            pf[k2] = __builtin_bit_cast(bf16x8, w); }
        __syncthreads();
        { const bf16_t* sp = vT + (size_t)(h * 256 + (tid >> 5)) * NMEMR + b * 256 + (tid & 31) * 8; LAS bf16_t* dp = KV + (tid >> 5) * PKV + (tid & 31) * 8;
#pragma unroll 1
            for (int q4 = 0; q4 < 4; ++q4) { u32x4n v[4];
#pragma unroll
                for (int i = 0; i < 4; ++i) v[i] = *(const u32x4n*)(sp + (size_t)(16 * i) * NMEMR);
#pragma unroll
                for (int i = 0; i < 4; ++i) *(LAS u32x4n*)(dp + (16 * i) * PKV) = v[i];
                sp += (size_t)64 * NMEMR; dp += 64 * PKV; } }
        __syncthreads();
        bf16_t* op = ao + (size_t)(r0 + r16) * D + h * 256 + 4 * quad;
#pragma unroll
        for (int dt = 0; dt < 16; ++dt) { f32x4 acc = {0.f, 0.f, 0.f, 0.f};
#pragma unroll
            for (int k2 = 0; k2 < 8; ++k2) { const LAS bf16_t* vp = KV + (dt * 16 + r16) * PKV + 32 * k2 + 4 * quad;
                const u32x2 lo = *(const LAS u32x2*)vp, hi = *(const LAS u32x2*)(vp + 16);
                const u32x4n av = {lo.x, lo.y, hi.x, hi.y};
                acc = MFMA16(__builtin_bit_cast(bf16x8, av), pf[k2], acc); }
            *(u32x2*)(op + dt * 16) = pack4(acc[0] * inv, acc[1] * inv, acc[2] * inv, acc[3] * inv); }
        __syncthreads();
    }
}


__device__ __forceinline__ void attn_phase3(const bf16_t* qb, const bf16_t* kb, const bf16_t* vT, bf16_t* ao, LAS unsigned char* lds, int tid, int wave, int lane, int blk, int G) {
    constexpr int PKV = 264;
    LAS bf16_t* KV = (LAS bf16_t*)lds;
    const int r16 = lane & 15, quad = lane >> 4;
    for (int bi = blk; bi < (T / 256) * 4; bi += G) {
        const int h = bi & 3, chunk = bi >> 2, r0 = chunk * 256 + wave * 32, b = chunk >> 4;
        { const bf16_t* sp = kb + (size_t)(b * 256 + (tid >> 5)) * D + h * 256 + (tid & 31) * 8; LAS bf16_t* dp = KV + (tid >> 5) * PKV + (tid & 31) * 8;
#pragma unroll 1
            for (int q4 = 0; q4 < 4; ++q4) { u32x4n v[4];
#pragma unroll
                for (int i = 0; i < 4; ++i) v[i] = *(const u32x4n*)(sp + (size_t)(16 * i) * D);
#pragma unroll
                for (int i = 0; i < 4; ++i) *(LAS u32x4n*)(dp + (16 * i) * PKV) = v[i];
                sp += (size_t)64 * D; dp += 64 * PKV; } }
        bf16x8 qfA[8], qfB[8];
        { const bf16_t* qp = qb + (size_t)(r0 + r16) * D + h * 256 + quad * 8;
#pragma unroll
            for (int ks = 0; ks < 8; ++ks) { qfA[ks] = *(const bf16x8*)(qp + ks * 32); qfB[ks] = *(const bf16x8*)(qp + (size_t)16 * D + ks * 32); } }
        __syncthreads();
        f32x4 scA[16], scB[16];
#pragma unroll
        for (int nt = 0; nt < 16; ++nt) { f32x4 aA = {0.f, 0.f, 0.f, 0.f}, aB = {0.f, 0.f, 0.f, 0.f};
#pragma unroll
            for (int ks = 0; ks < 8; ++ks) { const bf16x8 kf = LDFRAG(KV, nt * 16 + r16, PKV, ks); aA = MFMA16(kf, qfA[ks], aA); aB = MFMA16(kf, qfB[ks], aB); }
            scA[nt] = aA; scB[nt] = aB; }
        bf16x8 pfA[8], pfB[8]; float invA, invB;
#define ATT_SOFTMAX(sc, pf, inv) do { float mx = sc[0][0]; \
            _Pragma("unroll") for (int nt = 0; nt < 16; ++nt) { _Pragma("unroll") for (int j = 0; j < 4; ++j) mx = fmaxf(mx, sc[nt][j]); } \
            mx = fmaxf(mx, __shfl_xor(mx, 16)); mx = fmaxf(mx, __shfl_xor(mx, 32)); float sum = 0.f; \
            _Pragma("unroll") for (int nt = 0; nt < 16; ++nt) { _Pragma("unroll") for (int j = 0; j < 4; ++j) { const float pv = __expf((sc[nt][j] - mx) * 0.0625f); sc[nt][j] = pv; sum += pv; } } \
            sum += __shfl_xor(sum, 16); sum += __shfl_xor(sum, 32); inv = __builtin_amdgcn_rcpf(sum); \
            _Pragma("unroll") for (int k2 = 0; k2 < 8; ++k2) { u32x4n w; w.x = pk2(sc[2 * k2][0], sc[2 * k2][1]); w.y = pk2(sc[2 * k2][2], sc[2 * k2][3]); w.z = pk2(sc[2 * k2 + 1][0], sc[2 * k2 + 1][1]); w.w = pk2(sc[2 * k2 + 1][2], sc[2 * k2 + 1][3]); \
                pf[k2] = __builtin_bit_cast(bf16x8, w); } } while (0)
        ATT_SOFTMAX(scA, pfA, invA); ATT_SOFTMAX(scB, pfB, invB);
#undef ATT_SOFTMAX
        __syncthreads();
        { const bf16_t* sp = vT + (size_t)(h * 256 + (tid >> 5)) * NMEMR + b * 256 + (tid & 31) * 8; LAS bf16_t* dp = KV + (tid >> 5) * PKV + (tid & 31) * 8;
#pragma unroll 1
            for (int q4 = 0; q4 < 4; ++q4) { u32x4n v[4];
#pragma unroll
                for (int i = 0; i < 4; ++i) v[i] = *(const u32x4n*)(sp + (size_t)(16 * i) * NMEMR);
#pragma unroll
                for (int i = 0; i < 4; ++i) *(LAS u32x4n*)(dp + (16 * i) * PKV) = v[i];
                sp += (size_t)64 * NMEMR; dp += 64 * PKV; } }
        __syncthreads();
        bf16_t* op = ao + (size_t)(r0 + r16) * D + h * 256 + 4 * quad;
#pragma unroll
        for (int dt = 0; dt < 16; ++dt) { f32x4 aA = {0.f, 0.f, 0.f, 0.f}, aB = {0.f, 0.f, 0.f, 0.f};
#pragma unroll
            for (int k2 = 0; k2 < 8; ++k2) { const LAS bf16_t* vp = KV + (dt * 16 + r16) * PKV + 32 * k2 + 4 * quad;
                const u32x2 lo = *(const LAS u32x2*)vp, hi = *(const LAS u32x2*)(vp + 16);
                const u32x4n av = {lo.x, lo.y, hi.x, hi.y}; const bf16x8 avf = __builtin_bit_cast(bf16x8, av);
                aA = MFMA16(avf, pfA[k2], aA); aB = MFMA16(avf, pfB[k2], aB); }
            *(u32x2*)(op + dt * 16) = pack4(aA[0] * invA, aA[1] * invA, aA[2] * invA, aA[3] * invA);
            *(u32x2*)(op + (size_t)16 * D + dt * 16) = pack4(aB[0] * invB, aB[1] * invB, aB[2] * invB, aB[3] * invB); }
        __syncthreads();
    }
}

__device__ __forceinline__ void conv_phase(const bf16_t* ub, const float* cw, const float* cb, bf16_t* hb, int half, int gtid, int NT) {
    for (int item = gtid; item < TH * 352; item += NT) {
        const int tl = item / 352, c8 = item - tl * 352, n0 = c8 * 8, t = half * TH + tl, tpos = t & (SEQ - 1);
        float ga[8], va[8];
#pragma unroll
        for (int i = 0; i < 8; ++i) { ga[i] = cb[n0 + i]; va[i] = cb[DFF + n0 + i]; }
#pragma unroll
        for (int j = 0; j < 3; ++j) { if (tpos - 2 + j >= 0) { const bf16_t* p = ub + (size_t)(tl - 2 + j) * NUP + n0;
            const uint4 gq = *(const uint4*)p, vq = *(const uint4*)(p + DFF); const unsigned gw4[4] = {gq.x, gq.y, gq.z, gq.w}, vw4[4] = {vq.x, vq.y, vq.z, vq.w};
            const float* wg = cw + (size_t)j * NUP + n0; const float* wv = wg + DFF;
#pragma unroll
            for (int i = 0; i < 4; ++i) { ga[2 * i] += bflo(gw4[i]) * wg[2 * i]; ga[2 * i + 1] += bfhi(gw4[i]) * wg[2 * i + 1]; va[2 * i] += bflo(vw4[i]) * wv[2 * i]; va[2 * i + 1] += bfhi(vw4[i]) * wv[2 * i + 1]; } } }
        uint4 o; o.x = pk2(gelu_tanh(ga[0]) * va[0], gelu_tanh(ga[1]) * va[1]); o.y = pk2(gelu_tanh(ga[2]) * va[2], gelu_tanh(ga[3]) * va[3]);
        o.z = pk2(gelu_tanh(ga[4]) * va[4], gelu_tanh(ga[5]) * va[5]); o.w = pk2(gelu_tanh(ga[6]) * va[6], gelu_tanh(ga[7]) * va[7]);
        *(uint4*)(hb + (size_t)t * DFF + n0) = o;
    }
}

template <class Epi> __device__ __forceinline__ void run_gemm(LAS unsigned char* lds, const bf16_t* A, const bf16_t* Bt, int M, int N, int K, const Epi& E) {
    pg8::Gemm g{A, Bt, M, N, K}; pg8::StaticOrder S; S.init(M, N, (int)gridDim.x, (int)blockIdx.x);
    pg8::gemm_phase2<Epi, pg8::StaticOrder, true, true>(lds, g, S, E);
}
__global__ void __launch_bounds__(512, 2) fwd_megakernel(Args a) {
    extern __shared__ __attribute__((aligned(16))) unsigned char shm[];
    LAS unsigned char* lds = (LAS unsigned char*)shm;
    const int tid = threadIdx.x, lane = tid & 63, wave = __builtin_amdgcn_readfirstlane(tid >> 6);
    const int G = gridDim.x, blk = blockIdx.x, gw = blk * 8 + wave, NGW = G * 8;
    unsigned char* ws = a.ws;
    const int lo = a.ph_lo, hi = a.ph_hi;
#if N_LAUNCH_MODE == 0
    cg::grid_group grid = cg::this_grid();
    unsigned* const bar = (unsigned*)(ws + WS_BAR); const unsigned xcc = xcc_id(); unsigned nxb = 0, nx = 0, bround = 0;
    if (tid == 0) { __hip_atomic_fetch_add(bar + 64 * (17 + xcc), 1u, __ATOMIC_RELAXED, __HIP_MEMORY_SCOPE_AGENT); __hip_atomic_fetch_add(bar + 64 * 33, 1u, __ATOMIC_RELAXED, __HIP_MEMORY_SCOPE_AGENT);
        while (__hip_atomic_load(bar + 64 * 33, __ATOMIC_RELAXED, __HIP_MEMORY_SCOPE_AGENT) < (unsigned)G) __builtin_amdgcn_s_sleep(1); }
    __syncthreads();
    nxb = __hip_atomic_load(bar + 64 * (17 + xcc), __ATOMIC_RELAXED, __HIP_MEMORY_SCOPE_AGENT);
    for (int x_ = 0; x_ < 16; ++x_) nx += (__hip_atomic_load(bar + 64 * (17 + x_), __ATOMIC_RELAXED, __HIP_MEMORY_SCOPE_AGENT) != 0u) ? 1u : 0u;
    if (a.ph_hi < 0) grid.sync();
#define SEAM(k) do { if (lo <= (k) && (k) + 1 < hi) grid_bar(bar, xcc, nxb, nx, ++bround); } while (0)
#define SEAM2() do { if (hi - lo > 1) grid_bar(bar, xcc, nxb, nx, ++bround); } while (0)
#else
#define SEAM(k) do { } while (0)
#define SEAM2() do { } while (0)
#endif
#define IN(k) (lo <= (k) && (k) < hi)
    bf16_t* xb = (bf16_t*)(ws + WS_XB); bf16_t* projb = (bf16_t*)(ws + WS_PROJ);
    float* x1 = (float*)(ws + WS_X1); bf16_t* x1b = (bf16_t*)(ws + WS_X1B); bf16_t* qb = (bf16_t*)(ws + WS_QB); bf16_t* x2b = (bf16_t*)(ws + WS_X1B); bf16_t* r16b = (bf16_t*)(ws + WS_X1)  ; bf16_t* r3b = (bf16_t*)(ws + WS_XB)  ;
    bf16_t* kb = (bf16_t*)(ws + WS_KB); bf16_t* vT = (bf16_t*)(ws + WS_VT); bf16_t* memb = (bf16_t*)(ws + WS_MEMB);
    bf16_t* ub = (bf16_t*)(ws + WS_UB); bf16_t* hb = (bf16_t*)(ws + WS_HB);

    if (IN(0)) { p0_prep(a, lds, tid, wave, lane, gw, NGW); __syncthreads(); SEAM(0); }
    if (IN(1)) {
        run_gemm(lds, xb, (const bf16_t*)(ws + WS_WIN), T, NP, D, pg8::EpiB16{projb, NP, a.in[3], 0x00C3u, 0xC000u});
        __syncthreads(); SEAM(1); }
    if (IN(2)) {
        for (int it = blk; it < 1024; it += G) { const int kind = it >> 9, bh = (it >> 4) & 31, c = it & 15;
            if (kind == 0) hgrn2_pre(a, bh >> 2, bh & 3, c, lds, tid, wave, lane); else mlstm_pre(a, bh >> 2, bh & 3, c, lds, tid, wave, lane); }
        __syncthreads(); SEAM(2); }
    if (IN(3)) {
        if (blk < 32) scan_loop<0>(a, (blk >> 2) & 7, blk & 3, lds, tid, wave, lane, bar, xcc, nxb, nx, bround);
        else if (blk < 64) scan_loop<1>(a, (blk >> 2) & 7, blk & 3, lds, tid, wave, lane, bar, xcc, nxb, nx, bround);
        else {
            for (int sl = 1; sl < 4; ++sl) {
                for (int it = blk - 64; it < 1024; it += G - 64) { const int kind = it >> 9, bh = (it >> 4) & 31, c = 16 * sl + (it & 15);
                    if (kind == 0) hgrn2_pre(a, bh >> 2, bh & 3, c, lds, tid, wave, lane); else mlstm_pre(a, bh >> 2, bh & 3, c, lds, tid, wave, lane); }
                __syncthreads(); grid_bar(bar, xcc, nxb, nx, ++bround); }
            late_prep(a, lds, wave, lane, (blk - 64) * 8 + wave, (G - 64) * 8); __syncthreads();
            { pg8::Gemm g{memb, (const bf16_t*)(ws + WS_WKV), NMEMR, D, D}; pg8::StaticOrder S; S.init(NMEMR, D, G - 64, blk - 64); pg8::gemm_phase2<pg8::EpiB16, pg8::StaticOrder, true, true>(lds, g, S, pg8::EpiB16{kb, D, nullptr, 0u, 0u}); }
            { pg8::Gemm g{(const bf16_t*)(ws + WS_WKV) + (size_t)D * D, memb, D, NMEMR, D}; pg8::StaticOrder S; S.init(D, NMEMR, G - 64, blk - 64); pg8::gemm_phase2<pg8::EpiB16, pg8::StaticOrder, true, true>(lds, g, S, pg8::EpiB16{vT, NMEMR, nullptr, 0u, 0u}); }
        }
        __syncthreads();
        SEAM(3); }
    if (IN(4)) { run_gemm(lds, (const bf16_t*)(ws + WS_Y), (const bf16_t*)(ws + WS_WOUT), T, D, D, pg8::EpiResO16<false>{a.in[0], r16b, D, ALPHA, (float*)(ws + WS_ST1)}); __syncthreads(); SEAM(4); }
    if (IN(6)) { run_gemm(lds, r16b, (const bf16_t*)(ws + WS_WQ), T, D, D, pg8::EpiLNq{qb, D, (const float*)(ws + WS_ST1), (const float*)(ws + WS_CV), (const float*)(ws + WS_CV) + 1024}); __syncthreads(); SEAM(6); }
    if (IN(7)) { attn_phase3(qb, kb, vT, xb  , lds, tid, wave, lane, blk, G); __syncthreads(); SEAM(7); }
    if (IN(8)) { run_gemm(lds, xb  , (const bf16_t*)(ws + WS_WO), T, D, D, pg8::EpiResLN{r16b, (const float*)(ws + WS_ST1), a.in[10], a.in[11], r16b, D, ALPHA, nullptr}); __syncthreads(); SEAM(8); }
    if (IN(9)) { ln_rows16(r16b, a.in[15], a.in[16], nullptr, x2b, lane, gw, NGW); SEAM(9); }
    if (IN(10)) {
        pg8::Gemm g{x2b, (const bf16_t*)(ws + WS_WUP), 136 * 256, NUP, D}; pg8::StaticOrder S; S.init(136 * 256, NUP, (int)gridDim.x, (int)blockIdx.x);
        pg8::gemm_phase2_ffn<pg8::EpiFFN, pg8::StaticOrder, true, true>(lds, g, S, pg8::EpiFFN{hb, a.in[18], a.in[19]});
        __syncthreads(); SEAM(10); }
    if (IN(14)) { run_gemm(lds, hb, (const bf16_t*)(ws + WS_WDN), T, D, DFF, pg8::EpiResO16<true>{x2b, r3b, D, ALPHA, nullptr}); __syncthreads(); SEAM(14); }
    if (IN(15)) { ln_rows16(r3b, a.in[21], a.in[22], a.out, nullptr, lane, gw, NGW); }
}

extern "C" void kernel_launch(void* const* d_in, const int* in_sizes, int n_in, void* d_out, int out_size, void* d_ws, size_t ws_size, hipStream_t stream) {
    static int grid = 0;
    if (grid == 0) {
        int dev = 0, cus = 0, per_cu = 0;
        hipGetDevice(&dev); hipDeviceGetAttribute(&cus, hipDeviceAttributeMultiprocessorCount, dev);
        if (hipFuncSetAttribute((const void*)fwd_megakernel, hipFuncAttributeMaxDynamicSharedMemorySize, LDS_BYTES) != hipSuccess) { fprintf(stderr, "hipFuncSetAttribute failed\n"); }
        if (hipOccupancyMaxActiveBlocksPerMultiprocessor(&per_cu, (const void*)fwd_megakernel, 512, LDS_BYTES) != hipSuccess || per_cu < 1) { fprintf(stderr, "occupancy query: %d\n", per_cu); per_cu = 1; }
        (void)hipGetLastError();
        grid = cus * per_cu;
        if (ws_size < 482 * MiB) fprintf(stderr, "workspace too small: %zu\n", ws_size);
    }
    Args a{};
    for (int i = 0; i < 23; ++i) a.in[i] = (const float*)d_in[i];
    a.out = (float*)d_out; a.ws = (unsigned char*)d_ws;
#if N_LAUNCH_MODE == 0
    (void)hipMemsetAsync((unsigned char*)d_ws + WS_BAR, 0, 64 * 34 * 4, stream);
    a.ph_lo = 0; a.ph_hi = NPH; void* args[] = {&a};
    hipError_t e = hipLaunchCooperativeKernel((const void*)fwd_megakernel, dim3(grid), dim3(512), args, LDS_BYTES, stream);
    if (e != hipSuccess) fprintf(stderr, "cooperative launch failed: %s (grid %d)\n", hipGetErrorString(e), grid);
#else
    for (int ph = 0; ph < NPH; ++ph) { a.ph_lo = ph; a.ph_hi = ph + 1; hipLaunchKernelGGL(fwd_megakernel, dim3(grid), dim3(512), LDS_BYTES, stream, a); }
#endif
}
```

```cpp
#include <hip/hip_runtime.h>
#include <hip/hip_cooperative_groups.h>
#include <cstdio>
#include <cstdint>
namespace cg = cooperative_groups;
namespace pg8 {
#define PG8_LAS __attribute__((address_space(3)))
typedef unsigned short bf16_t;
typedef short bf16x8 __attribute__((ext_vector_type(8)));
typedef float f32x4 __attribute__((ext_vector_type(4)));
typedef unsigned u32x4 __attribute__((ext_vector_type(4)));
constexpr int BM = 256, BK = 64, HALF = 128, HTB = HALF * BK * 2  , STAGE_BYTES = 8 * HTB, NXCD = 8, WGM = 8;

__host__ __device__ __forceinline__ int lds_byte(int r, int c) { const int st = (r >> 4) * 2 + (c >> 5), rr = r & 15, cc = c & 31, ob = rr * 64 + cc * 2; return st * 1024 + (ob ^ (((ob >> 9) & 1) << 5)); }
__host__ __device__ __forceinline__ void stage_rc(int b, int& R, int& C) { const int st = b / 1024, sb = b % 1024, swz = sb ^ (((sb >> 9) & 1) << 5); R = (st >> 1) * 16 + swz / 64; C = (st & 1) * 32 + (swz % 64) / 2; }
__host__ __device__ __forceinline__ int perm32(int rho) { const int n = rho >> 4, i = rho & 15; return 8 * (i >> 2) + 4 * n + (i & 3); }

struct Unit { int pm, pn; };
struct Gemm { const bf16_t* A; const bf16_t* Bt; int M, N, K; };

struct StaticOrder {
    int nM, nN, nwg, G, c;
    __host__ __device__ void init(int M, int N, int G_, int c_) { nM = M / BM; nN = N / BM; nwg = nM * nN; G = G_; c = c_; }
    __host__ __device__ bool next(int i, Unit& u) const {
        const long L = (long)i * G + c; if (L >= nwg) return false;
        int wgid = (int)L; { const int q = nwg / NXCD, r = nwg % NXCD, xcd = wgid % NXCD, off = wgid / NXCD; wgid = (xcd < r ? xcd * (q + 1) : r * (q + 1) + (xcd - r) * q) + off; }
        const int nig = WGM * nN, gid = wgid / nig, fm = gid * WGM, gsz = (nM - fm) < WGM ? (nM - fm) : WGM;
        u.pm = fm + ((wgid % nig) % gsz); u.pn = (wgid % nig) / gsz; return true;
    }
    __device__ __forceinline__ void a_ready(const Unit&) const {}
    __device__ __forceinline__ void done(const Unit&) const {}
};
typedef __bf16 bf16x2_nat __attribute__((ext_vector_type(2))); typedef float f32x2_nat __attribute__((ext_vector_type(2)));
__device__ __forceinline__ unsigned cvt_pk_bf16(float lo, float hi) { f32x2_nat v = {lo, hi}; bf16x2_nat r = __builtin_convertvector(v, bf16x2_nat); return __builtin_bit_cast(unsigned, r); }
typedef float f32x2 __attribute__((ext_vector_type(2)));
struct EpiB16 {
    static constexpr bool PERM = true, AFTER_DRAIN = false;
    bf16_t* O; int ldc; const float* bias; unsigned silu_mask, sig_mask;
    __device__ __forceinline__ void operator()(const f32x4 (&acc)[2][2][4][2], const Unit& u, int wr, int wc, int fr, int fq) const {
        const int row0 = u.pm * BM + wr * 64 + fr; const int col0 = u.pn * BM + wc * 32 + 8 * fq;
        const int act = ((silu_mask >> u.pn) & 1u) ? 1 : (((sig_mask >> u.pn) & 1u) ? 2 : 0);
        f32x4 bv[2][2];
#pragma unroll
        for (int bj = 0; bj < 2; ++bj)
#pragma unroll
            for (int n = 0; n < 2; ++n) bv[bj][n] = bias ? *(const f32x4*)(bias + col0 + bj * HALF + 4 * n) : (f32x4){0.f, 0.f, 0.f, 0.f};
#pragma unroll
        for (int ai = 0; ai < 2; ++ai)
#pragma unroll
            for (int m = 0; m < 4; ++m) { bf16_t* rowp = O + (size_t)(row0 + ai * HALF + m * 16) * ldc + col0;
#pragma unroll
                for (int bj = 0; bj < 2; ++bj) { f32x4 v0 = acc[ai][bj][m][0] + bv[bj][0], v1 = acc[ai][bj][m][1] + bv[bj][1];
                    if (act) {
#pragma unroll
                        for (int j = 0; j < 4; ++j) { const float s0 = __builtin_amdgcn_rcpf(1.f + __expf(-v0[j])), s1 = __builtin_amdgcn_rcpf(1.f + __expf(-v1[j]));
                            v0[j] = (act == 1) ? v0[j] * s0 : s0; v1[j] = (act == 1) ? v1[j] * s1 : s1; } }
                    u32x4 w; w.x = cvt_pk_bf16(v0[0], v0[1]); w.y = cvt_pk_bf16(v0[2], v0[3]); w.z = cvt_pk_bf16(v1[0], v1[1]); w.w = cvt_pk_bf16(v1[2], v1[3]);
                    *(u32x4*)(rowp + bj * HALF) = w; } }
    }
};
template <bool BASE16> struct EpiResO16 {
    static constexpr bool PERM = false, AFTER_DRAIN = false;
    const void* base; bf16_t* out; int ldc; float alpha; float* stats;
    __device__ __forceinline__ void operator()(const f32x4 (&acc)[2][2][4][2], const Unit& u, int wr, int wc, int fr, int fq) const {
        typedef unsigned u32x2e __attribute__((ext_vector_type(2)));
        const int row0 = u.pm * BM + wr * 64 + fr, col0 = u.pn * BM + wc * 32 + 4 * fq;
#pragma unroll
        for (int ai = 0; ai < 2; ++ai)
#pragma unroll
            for (int m = 0; m < 4; ++m) { const size_t off = (size_t)(row0 + ai * HALF + m * 16) * ldc + col0; float rs = 0.f, rq = 0.f;
#pragma unroll
                for (int bj = 0; bj < 2; ++bj)
#pragma unroll
                    for (int n = 0; n < 2; ++n) { f32x4 bs;
                        if (BASE16) { const u32x2e bw = *(const u32x2e*)((const bf16_t*)base + off + bj * HALF + n * 16);
                            bs = (f32x4){__uint_as_float(bw.x << 16), __uint_as_float(bw.x & 0xffff0000u), __uint_as_float(bw.y << 16), __uint_as_float(bw.y & 0xffff0000u)}; }
                        else bs = __builtin_nontemporal_load((const f32x4*)((const float*)base + off + bj * HALF + n * 16));
                        const f32x4 v = bs * alpha + acc[ai][bj][m][n]; u32x2e w; w.x = cvt_pk_bf16(v[0], v[1]); w.y = cvt_pk_bf16(v[2], v[3]);
                        rs += (v[0] + v[1]) + (v[2] + v[3]); rq += (v[0] * v[0] + v[1] * v[1]) + (v[2] * v[2] + v[3] * v[3]);
                        *(u32x2e*)(out + off + bj * HALF + n * 16) = w; }
                if (stats) { rs += __shfl_xor(rs, 16); rs += __shfl_xor(rs, 32); rq += __shfl_xor(rq, 16); rq += __shfl_xor(rq, 32);
                    if (fq == 0) { float* sp = stats + 2 * (size_t)(row0 + ai * HALF + m * 16); atomicAdd(sp, rs); atomicAdd(sp + 1, rq); } } }
    }
};
struct EpiLNq {
    static constexpr bool PERM = true, AFTER_DRAIN = false;
    bf16_t* O; int ldc; const float* st; const float* c1; const float* c2;
    __device__ __forceinline__ void operator()(const f32x4 (&acc)[2][2][4][2], const Unit& u, int wr, int wc, int fr, int fq) const {
        const int row0 = u.pm * BM + wr * 64 + fr, col0 = u.pn * BM + wc * 32 + 8 * fq;
        f32x4 k1[2][2], k2[2][2];
#pragma unroll
        for (int bj = 0; bj < 2; ++bj)
#pragma unroll
            for (int n = 0; n < 2; ++n) { k1[bj][n] = *(const f32x4*)(c1 + col0 + bj * HALF + 4 * n); k2[bj][n] = *(const f32x4*)(c2 + col0 + bj * HALF + 4 * n); }
#pragma unroll
        for (int ai = 0; ai < 2; ++ai)
#pragma unroll
            for (int m = 0; m < 4; ++m) { const int row = row0 + ai * HALF + m * 16; const f32x2_nat sv = *(const f32x2_nat*)(st + 2 * (size_t)row);
                const float mu = sv[0] * (1.f / 1024.f), rstd = __builtin_amdgcn_rsqf(fmaxf(sv[1] * (1.f / 1024.f) - mu * mu, 0.f) + 1e-5f);
                bf16_t* rowp = O + (size_t)row * ldc + col0;
#pragma unroll
                for (int bj = 0; bj < 2; ++bj) { const f32x4 v0 = (acc[ai][bj][m][0] - k1[bj][0] * mu) * rstd + k2[bj][0], v1 = (acc[ai][bj][m][1] - k1[bj][1] * mu) * rstd + k2[bj][1];
                    u32x4 w; w.x = cvt_pk_bf16(v0[0], v0[1]); w.y = cvt_pk_bf16(v0[2], v0[3]); w.z = cvt_pk_bf16(v1[0], v1[1]); w.w = cvt_pk_bf16(v1[2], v1[3]);
                    *(u32x4*)(rowp + bj * HALF) = w; } }
    }
};
struct EpiResLN {
    static constexpr bool PERM = false, AFTER_DRAIN = false;
    const bf16_t* rsrc; const float* st; const float* gam; const float* bet; bf16_t* out; int ldc; float alpha; float* stats;
    __device__ __forceinline__ void operator()(const f32x4 (&acc)[2][2][4][2], const Unit& u, int wr, int wc, int fr, int fq) const {
        typedef unsigned u32x2e __attribute__((ext_vector_type(2)));
        const int row0 = u.pm * BM + wr * 64 + fr, col0 = u.pn * BM + wc * 32 + 4 * fq;
        f32x4 gv[2][2], bv[2][2];
#pragma unroll
        for (int bj = 0; bj < 2; ++bj)
#pragma unroll
            for (int n = 0; n < 2; ++n) { gv[bj][n] = *(const f32x4*)(gam + col0 + bj * HALF + n * 16); bv[bj][n] = *(const f32x4*)(bet + col0 + bj * HALF + n * 16); }
#pragma unroll
        for (int ai = 0; ai < 2; ++ai)
#pragma unroll
            for (int m = 0; m < 4; ++m) { const int row = row0 + ai * HALF + m * 16; const size_t off = (size_t)row * ldc + col0; const f32x2_nat sv = *(const f32x2_nat*)(st + 2 * (size_t)row);
                const float mu = sv[0] * (1.f / 1024.f), rstd = __builtin_amdgcn_rsqf(fmaxf(sv[1] * (1.f / 1024.f) - mu * mu, 0.f) + 1e-5f); float rs = 0.f, rq = 0.f;
#pragma unroll
                for (int bj = 0; bj < 2; ++bj)
#pragma unroll
                    for (int n = 0; n < 2; ++n) { const u32x2e bw = *(const u32x2e*)(rsrc + off + bj * HALF + n * 16);
                        const f32x4 rr = {__uint_as_float(bw.x << 16), __uint_as_float(bw.x & 0xffff0000u), __uint_as_float(bw.y << 16), __uint_as_float(bw.y & 0xffff0000u)};
                        const f32x4 xb_ = (rr - mu) * rstd * gv[bj][n] + bv[bj][n]; const f32x4 v = xb_ * alpha + acc[ai][bj][m][n];
                        u32x2e w; w.x = cvt_pk_bf16(v[0], v[1]); w.y = cvt_pk_bf16(v[2], v[3]);
                        rs += (v[0] + v[1]) + (v[2] + v[3]); rq += (v[0] * v[0] + v[1] * v[1]) + (v[2] * v[2] + v[3] * v[3]);
                        *(u32x2e*)(out + off + bj * HALF + n * 16) = w; }
                if (stats) { rs += __shfl_xor(rs, 16); rs += __shfl_xor(rs, 32); rq += __shfl_xor(rq, 16); rq += __shfl_xor(rq, 32);
                    if (fq == 0) { float* sp = stats + 2 * (size_t)row; atomicAdd(sp, rs); atomicAdd(sp + 1, rq); } } }
    }
};
struct EpiResB {
    static constexpr bool PERM = false, AFTER_DRAIN = false;
    const bf16_t* base; float* out; int ldc; float alpha;
    __device__ __forceinline__ void operator()(const f32x4 (&acc)[2][2][4][2], const Unit& u, int wr, int wc, int fr, int fq) const {
        const int row0 = u.pm * BM + wr * 64 + fr, col0 = u.pn * BM + wc * 32 + 4 * fq;
#pragma unroll
        for (int ai = 0; ai < 2; ++ai)
#pragma unroll
            for (int m = 0; m < 4; ++m) { const size_t off = (size_t)(row0 + ai * HALF + m * 16) * ldc + col0;
#pragma unroll
                for (int bj = 0; bj < 2; ++bj)
#pragma unroll
                    for (int n = 0; n < 2; ++n) { typedef unsigned u32x2e __attribute__((ext_vector_type(2))); const u32x2e bw = *(const u32x2e*)(base + off + bj * HALF + n * 16);
                        const f32x4 bs = {__uint_as_float(bw.x << 16), __uint_as_float(bw.x & 0xffff0000u), __uint_as_float(bw.y << 16), __uint_as_float(bw.y & 0xffff0000u)};
                        *(f32x4*)(out + off + bj * HALF + n * 16) = bs * alpha + acc[ai][bj][m][n]; } }
    }
};
struct EpiRes {
    static constexpr bool PERM = false, AFTER_DRAIN = false;
    const float* base; float* out; int ldc; float alpha;
    __device__ __forceinline__ void operator()(const f32x4 (&acc)[2][2][4][2], const Unit& u, int wr, int wc, int fr, int fq) const {
        const int row0 = u.pm * BM + wr * 64 + fr, col0 = u.pn * BM + wc * 32 + 4 * fq;
#pragma unroll
        for (int ai = 0; ai < 2; ++ai)
#pragma unroll
            for (int m = 0; m < 4; ++m) { const size_t off = (size_t)(row0 + ai * HALF + m * 16) * ldc + col0;
#pragma unroll
                for (int bj = 0; bj < 2; ++bj)
#pragma unroll
                    for (int n = 0; n < 2; ++n) { const f32x4 bs = *(const f32x4*)(base + off + bj * HALF + n * 16);
                        *(f32x4*)(out + off + bj * HALF + n * 16) = bs * alpha + acc[ai][bj][m][n]; } }
    }
};
template <class Epi, class Sched, bool STAMP = false>
__device__ __forceinline__ void gemm_phase(PG8_LAS unsigned char* lds, const Gemm g, const Sched& S, const Epi& E, unsigned long long* stamps) {
    const int tid = threadIdx.x, wid = __builtin_amdgcn_readfirstlane(tid >> 6), lane = tid & 63, wr = wid >> 2, wc = wid & 3, fr = lane & 15, fq = lane >> 4;
    const int K = g.K, nt = K / BK;
    int ts_lo = 0, ts_hi = 0, nts = 0; const unsigned long long rt_entry = STAMP ? (unsigned long long)wall_clock64() : 0ull;
#define PG8_STAMP() do { if (STAMP && wid == 0 && nts < 64) { const unsigned long long _c = (unsigned long long)clock64(); \
        ts_lo = (lane == nts) ? (int)(unsigned)_c : ts_lo; ts_hi = (lane == nts) ? (int)(unsigned)(_c >> 32) : ts_hi; ++nts; } } while (0)
    PG8_STAMP();
    unsigned voffA[2], voffB[2];
#pragma unroll
    for (int i = 0; i < 2; ++i) { int R, C; stage_rc(tid * 16 + i * 8192, R, C); const int Rb = Epi::PERM ? ((R & ~31) + perm32(R & 31)) : R;
        voffA[i] = (unsigned)(R * K + C) * 2u; voffB[i] = (unsigned)(Rb * K + C) * 2u; }
    const size_t kstep = (size_t)(BK * 2);
    const size_t hstep = (size_t)HALF * K * 2;
    const size_t tstep = 2 * hstep;
    const unsigned ldsw = (unsigned)wid * 1024u;
    const int aoff = lds_byte(wr * 64 + fr, fq * 8), boff = lds_byte(wc * 32 + fr, fq * 8);
#define PG8_SA(b, h) (((b) * 2 + (h)) * HTB)
#define PG8_SB(b, h) ((4 + (b) * 2 + (h)) * HTB)
#define PG8_STAGE(bufoff, gbase, voff) do { _Pragma("unroll") for (int _i = 0; _i < 2; ++_i) \
        __builtin_amdgcn_global_load_lds((const unsigned*)((const char*)(gbase) + (voff)[_i]), (PG8_LAS unsigned*)(lds + (bufoff) + ldsw + _i * 8192), 16, 0, 0); } while (0)
#define PG8_LDA(dst, b, h) do { _Pragma("unroll") for (int m = 0; m < 4; ++m) _Pragma("unroll") for (int k = 0; k < 2; ++k) dst[m][k] = *(const PG8_LAS bf16x8*)(lds + PG8_SA(b, h) + aoff + m * 2048 + k * 1024); } while (0)
#define PG8_LDB(dst, b, h) do { _Pragma("unroll") for (int n = 0; n < 2; ++n) _Pragma("unroll") for (int k = 0; k < 2; ++k) dst[n][k] = *(const PG8_LAS bf16x8*)(lds + PG8_SB(b, h) + boff + n * 2048 + k * 1024); } while (0)
#define PG8_MMA(ai, bj, At, Bt) do { __builtin_amdgcn_s_setprio(1); _Pragma("unroll") for (int m = 0; m < 4; ++m) _Pragma("unroll") for (int n = 0; n < 2; ++n) _Pragma("unroll") for (int k = 0; k < 2; ++k) \
        acc[ai][bj][m][n] = __builtin_amdgcn_mfma_f32_16x16x32_bf16(Bt[n][k], At[m][k], acc[ai][bj][m][n], 0, 0, 0); __builtin_amdgcn_s_setprio(0); } while (0)
#define PG8_WAIT_V(n) asm volatile("s_waitcnt vmcnt(" #n ")" ::: "memory")
#define PG8_WAIT_L(n) asm volatile("s_waitcnt lgkmcnt(" #n ")" ::: "memory")
#define PG8_BAR __builtin_amdgcn_s_barrier()
#define PG8_SCHED __builtin_amdgcn_sched_barrier(0)
    Unit cur, nxt; int ui = 0;
    if (!S.next(0, cur)) return;
    f32x4 acc[2][2][4][2];
#pragma unroll
    for (int a = 0; a < 2; ++a)
#pragma unroll
        for (int b = 0; b < 2; ++b)
#pragma unroll
            for (int m = 0; m < 4; ++m)
#pragma unroll
                for (int n = 0; n < 2; ++n) acc[a][b][m][n] = (f32x4){0.f, 0.f, 0.f, 0.f};
    bf16x8 At[4][2], B0[2][2], B1[2][2];
    const char* cA = (const char*)g.A + (size_t)cur.pm * tstep; const char* cB = (const char*)g.Bt + (size_t)cur.pn * tstep;
    S.a_ready(cur);
    PG8_STAGE(PG8_SB(0, 0), cB, voffB); PG8_STAGE(PG8_SA(0, 0), cA, voffA); PG8_STAGE(PG8_SB(0, 1), cB + hstep, voffB); PG8_STAGE(PG8_SA(0, 1), cA + hstep, voffA);
    if (wr == 1) PG8_BAR;
    PG8_WAIT_V(4); PG8_BAR;
    PG8_STAGE(PG8_SB(1, 0), cB + kstep, voffB); PG8_STAGE(PG8_SA(1, 0), cA + kstep, voffA); PG8_STAGE(PG8_SB(1, 1), cB + hstep + kstep, voffB);
    PG8_WAIT_V(6); PG8_BAR;
    PG8_STAMP();
    for (;;) {
        const bool has_next = S.next(ui + 1, nxt);
        const char* nA = has_next ? (const char*)g.A + (size_t)nxt.pm * tstep : cA; const char* nB = has_next ? (const char*)g.Bt + (size_t)nxt.pn * tstep : cB;
        for (int t = 0; t < nt; t += 2) {
            const bool last = (t == nt - 2);
            const char* a1 = cA + (size_t)(t + 1) * kstep;
            const char* a2 = last ? nA : cA + (size_t)(t + 2) * kstep; const char* b2 = last ? nB : cB + (size_t)(t + 2) * kstep;
            const char* a3 = a2 + kstep; const char* b3 = b2 + kstep;
            if (last && has_next) S.a_ready(nxt);
            PG8_LDB(B0, 0, 0); PG8_SCHED; PG8_LDA(At, 0, 0); PG8_STAGE(PG8_SA(1, 1), a1 + hstep, voffA);
            PG8_WAIT_L(8); PG8_BAR; PG8_WAIT_L(0); PG8_MMA(0, 0, At, B0); PG8_BAR; PG8_SCHED;
            PG8_LDB(B1, 0, 1); PG8_STAGE(PG8_SB(0, 0), b2, voffB);
            PG8_BAR; PG8_WAIT_L(0); PG8_MMA(0, 1, At, B1); PG8_BAR;
            PG8_LDA(At, 0, 1); PG8_STAGE(PG8_SA(0, 0), a2, voffA);
            PG8_BAR; PG8_WAIT_L(0); PG8_MMA(1, 0, At, B0); PG8_BAR; PG8_SCHED;
            PG8_STAGE(PG8_SB(0, 1), b2 + hstep, voffB);
            PG8_WAIT_V(6); PG8_BAR; PG8_MMA(1, 1, At, B1); PG8_BAR;
            PG8_LDB(B0, 1, 0); PG8_SCHED; PG8_LDA(At, 1, 0); PG8_STAGE(PG8_SA(0, 1), a2 + hstep, voffA);
            PG8_WAIT_L(8); PG8_BAR; PG8_WAIT_L(0); PG8_MMA(0, 0, At, B0); PG8_BAR; PG8_SCHED;
            PG8_LDB(B1, 1, 1); PG8_STAGE(PG8_SB(1, 0), b3, voffB);
            PG8_BAR; PG8_WAIT_L(0); PG8_MMA(0, 1, At, B1); PG8_BAR;
            PG8_LDA(At, 1, 1); PG8_STAGE(PG8_SA(1, 0), a3, voffA);
            PG8_BAR; PG8_WAIT_L(0); PG8_MMA(1, 0, At, B0); PG8_BAR; PG8_SCHED;
            PG8_STAGE(PG8_SB(1, 1), b3 + hstep, voffB);
            PG8_WAIT_V(6); PG8_BAR; PG8_MMA(1, 1, At, B1); PG8_BAR;
        }
        PG8_STAMP();
        if constexpr (!Epi::AFTER_DRAIN) { E(acc, cur, wr, wc, fr, fq); S.done(cur); }
        PG8_STAMP();
        if (!has_next) break;
#pragma unroll
        for (int a = 0; a < 2; ++a)
#pragma unroll
            for (int b = 0; b < 2; ++b)
#pragma unroll
                for (int m = 0; m < 4; ++m)
#pragma unroll
                    for (int n = 0; n < 2; ++n) acc[a][b][m][n] = (f32x4){0.f, 0.f, 0.f, 0.f};
        cur = nxt; cA = nA; cB = nB; ++ui;
    }
    PG8_WAIT_V(0);
    if (wr == 0) PG8_BAR;
    PG8_BAR;
    if constexpr (Epi::AFTER_DRAIN) { E.fused(acc, cur, wr, wc, fr, fq, lds, wid, lane); S.done(cur); }
    PG8_STAMP();
    if (STAMP && wid == 0) { stamps[lane] = lane < nts ? (((unsigned long long)(unsigned)ts_hi << 32) | (unsigned)ts_lo) : 0ull;
        if (lane == 62) stamps[62] = rt_entry; if (lane == 63) stamps[63] = (unsigned long long)wall_clock64(); }
#undef PG8_STAMP
#undef PG8_SA
#undef PG8_SB
#undef PG8_STAGE
#undef PG8_LDA
#undef PG8_LDB
#undef PG8_MMA
#undef PG8_WAIT_V
#undef PG8_WAIT_L
#undef PG8_BAR
#undef PG8_SCHED
}

struct EpiFFN {
    static constexpr bool PERM = true, AFTER_DRAIN = false;
    bf16_t* H; const float* cw; const float* cb;
    __device__ __forceinline__ void operator()(const f32x4 (&acc)[2][2][4][2], const Unit& u, int wr, int wc, int fr, int fq) const {
        const int batch = u.pm / 17, jj = u.pm % 17, col0 = u.pn * 128 + wc * 32 + 8 * fq;
        const int lane = (int)(threadIdx.x & 63u), src1 = (lane & 48) | ((lane - 1) & 15), src2 = (lane & 48) | ((lane - 2) & 15);
#pragma unroll
        for (int n = 0; n < 2; ++n) { const int col = col0 + 4 * n;
            f32x4 wg[3], wv[3];
#pragma unroll
            for (int tp = 0; tp < 3; ++tp) { wg[tp] = *(const f32x4*)(cw + tp * 5632 + col); wv[tp] = *(const f32x4*)(cw + tp * 5632 + 2816 + col); }
            const f32x4 bg = *(const f32x4*)(cb + col), bvv = *(const f32x4*)(cb + 2816 + col);
#pragma unroll
            for (int ai = 0; ai < 2; ++ai) { const int gbase = 248 * jj + 62 * (2 * ai + wr);
                f32x4 q1g = {0.f, 0.f, 0.f, 0.f}, q2g = q1g, q1v = q1g, q2v = q1g;
#pragma unroll
                for (int m = 0; m < 4; ++m) { const f32x4 g0 = acc[ai][0][m][n], v0 = acc[ai][1][m][n]; f32x4 r1g, r2g, r1v, r2v;
#pragma unroll
                    for (int j = 0; j < 4; ++j) { r1g[j] = __shfl(g0[j], src1); r2g[j] = __shfl(g0[j], src2); r1v[j] = __shfl(v0[j], src1); r2v[j] = __shfl(v0[j], src2); }
                    const int lr = 16 * m + fr, tok = gbase + lr - 2;
                    f32x4 p1g = (fr >= 1) ? r1g : q1g, p2g = (fr >= 2) ? r2g : q2g, p1v = (fr >= 1) ? r1v : q1v, p2v = (fr >= 2) ? r2v : q2v;
                    const f32x4 z = {0.f, 0.f, 0.f, 0.f};
                    if (tok < 1) { p1g = z; p1v = z; }
                    if (tok < 2) { p2g = z; p2v = z; }
                    const f32x4 gate = bg + wg[0] * p2g + wg[1] * p1g + wg[2] * g0, val = bvv + wv[0] * p2v + wv[1] * p1v + wv[2] * v0;
                    if (lr >= 2 && tok < 4096) { float o4[4];
#pragma unroll
                        for (int j = 0; j < 4; ++j) { const float x = gate[j]; const float uu = 0.7978845608028654f * (x + 0.044715f * x * x * x);
                            const float th = 1.f - 2.f * __builtin_amdgcn_rcpf(1.f + __expf(2.f * uu)); o4[j] = 0.5f * x * (1.f + th) * val[j]; }
                        typedef unsigned u32x2e __attribute__((ext_vector_type(2))); u32x2e w; w.x = cvt_pk_bf16(o4[0], o4[1]); w.y = cvt_pk_bf16(o4[2], o4[3]);
                        *(u32x2e*)(H + ((size_t)batch * 4096 + tok) * 2816 + col) = w; }
                    q1g = r1g; q2g = r2g; q1v = r1v; q2v = r2v; } } }
    }
};
template <class Epi, class Sched, bool STAMP = false>
__device__ __forceinline__ void gemm_phase_ffn(PG8_LAS unsigned char* lds, const Gemm g, const Sched& S, const Epi& E, unsigned long long* stamps) {
    const int tid = threadIdx.x, wid = __builtin_amdgcn_readfirstlane(tid >> 6), lane = tid & 63, wr = wid >> 2, wc = wid & 3, fr = lane & 15, fq = lane >> 4;
    const int K = g.K, nt = K / BK;
    int ts_lo = 0, ts_hi = 0, nts = 0; const unsigned long long rt_entry = STAMP ? (unsigned long long)wall_clock64() : 0ull;
#define PG8_STAMP() do { if (STAMP && wid == 0 && nts < 64) { const unsigned long long _c = (unsigned long long)clock64(); \
        ts_lo = (lane == nts) ? (int)(unsigned)_c : ts_lo; ts_hi = (lane == nts) ? (int)(unsigned)(_c >> 32) : ts_hi; ++nts; } } while (0)
    PG8_STAMP();
    unsigned voffA[2], voffB[2];
#pragma unroll
    for (int i = 0; i < 2; ++i) { int R, C; stage_rc(tid * 16 + i * 8192, R, C); const int Rb = Epi::PERM ? ((R & ~31) + perm32(R & 31)) : R;
        voffA[i] = (unsigned)((62 * (R >> 6) + (R & 63)) * K + C) * 2u; voffB[i] = (unsigned)(Rb * K + C) * 2u; }
    const size_t kstep = (size_t)(BK * 2);
    const size_t hstepA = (size_t)124 * K * 2, hstepB = (size_t)2816 * K * 2;
#define PG8_ABASE(pm_) ((const char*)g.A + ((long)((pm_) / 17) * 4096 + 248L * ((pm_) % 17) - 2L) * (long)K * 2L)
#define PG8_BBASE(pn_) ((const char*)g.Bt + (size_t)(pn_) * HALF * K * 2)
    const unsigned ldsw = (unsigned)wid * 1024u;
    const int aoff = lds_byte(wr * 64 + fr, fq * 8), boff = lds_byte(wc * 32 + fr, fq * 8);
#define PG8_SA(b, h) (((b) * 2 + (h)) * HTB)
#define PG8_SB(b, h) ((4 + (b) * 2 + (h)) * HTB)
#define PG8_STAGE(bufoff, gbase, voff) do { _Pragma("unroll") for (int _i = 0; _i < 2; ++_i) \
        __builtin_amdgcn_global_load_lds((const unsigned*)((const char*)(gbase) + (voff)[_i]), (PG8_LAS unsigned*)(lds + (bufoff) + ldsw + _i * 8192), 16, 0, 0); } while (0)
#define PG8_LDA(dst, b, h) do { _Pragma("unroll") for (int m = 0; m < 4; ++m) _Pragma("unroll") for (int k = 0; k < 2; ++k) dst[m][k] = *(const PG8_LAS bf16x8*)(lds + PG8_SA(b, h) + aoff + m * 2048 + k * 1024); } while (0)
#define PG8_LDB(dst, b, h) do { _Pragma("unroll") for (int n = 0; n < 2; ++n) _Pragma("unroll") for (int k = 0; k < 2; ++k) dst[n][k] = *(const PG8_LAS bf16x8*)(lds + PG8_SB(b, h) + boff + n * 2048 + k * 1024); } while (0)
#define PG8_MMA(ai, bj, At, Bt) do { __builtin_amdgcn_s_setprio(1); _Pragma("unroll") for (int m = 0; m < 4; ++m) _Pragma("unroll") for (int n = 0; n < 2; ++n) _Pragma("unroll") for (int k = 0; k < 2; ++k) \
        acc[ai][bj][m][n] = __builtin_amdgcn_mfma_f32_16x16x32_bf16(Bt[n][k], At[m][k], acc[ai][bj][m][n], 0, 0, 0); __builtin_amdgcn_s_setprio(0); } while (0)
#define PG8_WAIT_V(n) asm volatile("s_waitcnt vmcnt(" #n ")" ::: "memory")
#define PG8_WAIT_L(n) asm volatile("s_waitcnt lgkmcnt(" #n ")" ::: "memory")
#define PG8_BAR __builtin_amdgcn_s_barrier()
#define PG8_SCHED __builtin_amdgcn_sched_barrier(0)
    Unit cur, nxt; int ui = 0;
    if (!S.next(0, cur)) return;
    f32x4 acc[2][2][4][2];
#pragma unroll
    for (int a = 0; a < 2; ++a)
#pragma unroll
        for (int b = 0; b < 2; ++b)
#pragma unroll
            for (int m = 0; m < 4; ++m)
#pragma unroll
                for (int n = 0; n < 2; ++n) acc[a][b][m][n] = (f32x4){0.f, 0.f, 0.f, 0.f};
    bf16x8 At[4][2], B0[2][2], B1[2][2];
    const char* cA = PG8_ABASE(cur.pm); const char* cB = PG8_BBASE(cur.pn);
    S.a_ready(cur);
    PG8_STAGE(PG8_SB(0, 0), cB, voffB); PG8_STAGE(PG8_SA(0, 0), cA, voffA); PG8_STAGE(PG8_SB(0, 1), cB + hstepB, voffB); PG8_STAGE(PG8_SA(0, 1), cA + hstepA, voffA);
    if (wr == 1) PG8_BAR;
    PG8_WAIT_V(4); PG8_BAR;
    PG8_STAGE(PG8_SB(1, 0), cB + kstep, voffB); PG8_STAGE(PG8_SA(1, 0), cA + kstep, voffA); PG8_STAGE(PG8_SB(1, 1), cB + hstepB + kstep, voffB);
    PG8_WAIT_V(6); PG8_BAR;
    PG8_STAMP();
    for (;;) {
        const bool has_next = S.next(ui + 1, nxt);
        const char* nA = has_next ? PG8_ABASE(nxt.pm) : cA; const char* nB = has_next ? PG8_BBASE(nxt.pn) : cB;
        for (int t = 0; t < nt; t += 2) {
            const bool last = (t == nt - 2);
            const char* a1 = cA + (size_t)(t + 1) * kstep;
            const char* a2 = last ? nA : cA + (size_t)(t + 2) * kstep; const char* b2 = last ? nB : cB + (size_t)(t + 2) * kstep;
            const char* a3 = a2 + kstep; const char* b3 = b2 + kstep;
            if (last && has_next) S.a_ready(nxt);
            PG8_LDB(B0, 0, 0); PG8_SCHED; PG8_LDA(At, 0, 0); PG8_STAGE(PG8_SA(1, 1), a1 + hstepA, voffA);
            PG8_WAIT_L(8); PG8_BAR; PG8_WAIT_L(0); PG8_MMA(0, 0, At, B0); PG8_BAR; PG8_SCHED;
            PG8_LDB(B1, 0, 1); PG8_STAGE(PG8_SB(0, 0), b2, voffB);
            PG8_BAR; PG8_WAIT_L(0); PG8_MMA(0, 1, At, B1); PG8_BAR;
            PG8_LDA(At, 0, 1); PG8_STAGE(PG8_SA(0, 0), a2, voffA);
            PG8_BAR; PG8_WAIT_L(0); PG8_MMA(1, 0, At, B0); PG8_BAR; PG8_SCHED;
            PG8_STAGE(PG8_SB(0, 1), b2 + hstepB, voffB);
            PG8_WAIT_V(6); PG8_BAR; PG8_MMA(1, 1, At, B1); PG8_BAR;
            PG8_LDB(B0, 1, 0); PG8_SCHED; PG8_LDA(At, 1, 0); PG8_STAGE(PG8_SA(0, 1), a2 + hstepA, voffA);
            PG8_WAIT_L(8); PG8_BAR; PG8_WAIT_L(0); PG8_MMA(0, 0, At, B0); PG8_BAR; PG8_SCHED;
            PG8_LDB(B1, 1, 1); PG8_STAGE(PG8_SB(1, 0), b3, voffB);
            PG8_BAR; PG8_WAIT_L(0); PG8_MMA(0, 1, At, B1); PG8_BAR;
            PG8_LDA(At, 1, 1); PG8_STAGE(PG8_SA(1, 0), a3, voffA);
            PG8_BAR; PG8_WAIT_L(0); PG8_MMA(1, 0, At, B0); PG8_BAR; PG8_SCHED;
            PG8_STAGE(PG8_SB(1, 1), b3 + hstepB, voffB);
            PG8_WAIT_V(6); PG8_BAR; PG8_MMA(1, 1, At, B1); PG8_BAR;
        }
        PG8_STAMP();
        if constexpr (!Epi::AFTER_DRAIN) { E(acc, cur, wr, wc, fr, fq); S.done(cur); }
        PG8_STAMP();
        if (!has_next) break;
#pragma unroll
        for (int a = 0; a < 2; ++a)
#pragma unroll
            for (int b = 0; b < 2; ++b)
#pragma unroll
                for (int m = 0; m < 4; ++m)
#pragma unroll
                    for (int n = 0; n < 2; ++n) acc[a][b][m][n] = (f32x4){0.f, 0.f, 0.f, 0.f};
        cur = nxt; cA = nA; cB = nB; ++ui;
    }
    PG8_WAIT_V(0);
    if (wr == 0) PG8_BAR;
    PG8_BAR;
    if constexpr (Epi::AFTER_DRAIN) { E.fused(acc, cur, wr, wc, fr, fq, lds, wid, lane); S.done(cur); }
    PG8_STAMP();
    if (STAMP && wid == 0) { stamps[lane] = lane < nts ? (((unsigned long long)(unsigned)ts_hi << 32) | (unsigned)ts_lo) : 0ull;
        if (lane == 62) stamps[62] = rt_entry; if (lane == 63) stamps[63] = (unsigned long long)wall_clock64(); }
#undef PG8_STAMP
#undef PG8_SA
#undef PG8_SB
#undef PG8_STAGE
#undef PG8_LDA
#undef PG8_LDB
#undef PG8_MMA
#undef PG8_WAIT_V
#undef PG8_WAIT_L
#undef PG8_BAR
#undef PG8_SCHED
#undef PG8_ABASE
#undef PG8_BBASE
}

template <class Epi, class Sched, bool ALIGN_EPI = false, bool SP2 = false>
__device__ __forceinline__ void gemm_phase2(PG8_LAS unsigned char* lds, const Gemm g, const Sched& S, const Epi& E) {
    const int tid = threadIdx.x, wid = __builtin_amdgcn_readfirstlane(tid >> 6), lane = tid & 63, wr = wid >> 2, wc = wid & 3, fr = lane & 15, fq = lane >> 4;
    const int K = g.K, nt = K / BK;
    unsigned voffA[2], voffB[2];
#pragma unroll
    for (int i = 0; i < 2; ++i) { int R, C; stage_rc(tid * 16 + i * 8192, R, C); const int Rb = Epi::PERM ? ((R & ~31) + perm32(R & 31)) : R;
        voffA[i] = (unsigned)(R * K + C) * 2u; voffB[i] = (unsigned)(Rb * K + C) * 2u; }
    const size_t kstep = (size_t)(BK * 2);
    const size_t hstep = (size_t)HALF * K * 2;
    const size_t tstep = 2 * hstep;
    const unsigned ldsw = (unsigned)wid * 1024u;
    const int aoff = lds_byte(wr * 64 + fr, fq * 8), boff = lds_byte(wc * 32 + fr, fq * 8);
#define PG8_SA(b, h) (((b) * 2 + (h)) * HTB)
#define PG8_SB(b, h) ((4 + (b) * 2 + (h)) * HTB)
#define PG8_STAGE(bufoff, gbase, voff) do { _Pragma("unroll") for (int _i = 0; _i < 2; ++_i) \
        __builtin_amdgcn_global_load_lds((const unsigned*)((const char*)(gbase) + (voff)[_i]), (PG8_LAS unsigned*)(lds + (bufoff) + ldsw + _i * 8192), 16, 0, 0); } while (0)
#define PG8_LDA(dst, b, h) do { _Pragma("unroll") for (int m = 0; m < 4; ++m) _Pragma("unroll") for (int k = 0; k < 2; ++k) dst[m][k] = *(const PG8_LAS bf16x8*)(lds + PG8_SA(b, h) + aoff + m * 2048 + k * 1024); } while (0)
#define PG8_LDB(dst, b, h) do { _Pragma("unroll") for (int n = 0; n < 2; ++n) _Pragma("unroll") for (int k = 0; k < 2; ++k) dst[n][k] = *(const PG8_LAS bf16x8*)(lds + PG8_SB(b, h) + boff + n * 2048 + k * 1024); } while (0)
#define PG8_MMA(ai, bj, At, Bt) do { __builtin_amdgcn_s_setprio(1); _Pragma("unroll") for (int m = 0; m < 4; ++m) _Pragma("unroll") for (int n = 0; n < 2; ++n) _Pragma("unroll") for (int k = 0; k < 2; ++k) \
        acc[ai][bj][m][n] = __builtin_amdgcn_mfma_f32_16x16x32_bf16(Bt[n][k], At[m][k], acc[ai][bj][m][n], 0, 0, 0); __builtin_amdgcn_s_setprio(0); } while (0)
#define PG8_WAIT_V(n) asm volatile("s_waitcnt vmcnt(" #n ")" ::: "memory")
#define PG8_WAIT_L(n) asm volatile("s_waitcnt lgkmcnt(" #n ")" ::: "memory")
#define PG8_BAR __builtin_amdgcn_s_barrier()
#define PG8_SCHED __builtin_amdgcn_sched_barrier(0)
    Unit cur, nxt; int ui = 0;
    if (!S.next(0, cur)) return;
    f32x4 acc[2][2][4][2];
#pragma unroll
    for (int a = 0; a < 2; ++a)
#pragma unroll
        for (int b = 0; b < 2; ++b)
#pragma unroll
            for (int m = 0; m < 4; ++m)
#pragma unroll
                for (int n = 0; n < 2; ++n) acc[a][b][m][n] = (f32x4){0.f, 0.f, 0.f, 0.f};
    bf16x8 At[4][2], B0[2][2], B1[2][2];
    const char* cA = (const char*)g.A + (size_t)cur.pm * tstep; const char* cB = (const char*)g.Bt + (size_t)cur.pn * tstep;
    S.a_ready(cur);
    if constexpr (SP2) {
        PG8_STAGE(PG8_SB(0, 0), cB, voffB); PG8_STAGE(PG8_SB(0, 1), cB + hstep, voffB); PG8_STAGE(PG8_SA(0, 0), cA, voffA); PG8_STAGE(PG8_SA(0, 1), cA + hstep, voffA);
        if (wr == 1) PG8_BAR;
        PG8_WAIT_V(2); PG8_BAR;
        PG8_STAGE(PG8_SB(1, 0), cB + kstep, voffB); PG8_STAGE(PG8_SA(1, 0), cA + kstep, voffA); PG8_STAGE(PG8_SB(1, 1), cB + hstep + kstep, voffB);
        PG8_WAIT_V(6); PG8_BAR;
    } else {
        PG8_STAGE(PG8_SB(0, 0), cB, voffB); PG8_STAGE(PG8_SA(0, 0), cA, voffA); PG8_STAGE(PG8_SB(0, 1), cB + hstep, voffB); PG8_STAGE(PG8_SA(0, 1), cA + hstep, voffA);
        if (wr == 1) PG8_BAR;
        PG8_WAIT_V(4); PG8_BAR;
        PG8_STAGE(PG8_SB(1, 0), cB + kstep, voffB); PG8_STAGE(PG8_SA(1, 0), cA + kstep, voffA); PG8_STAGE(PG8_SB(1, 1), cB + hstep + kstep, voffB);
        PG8_WAIT_V(6); PG8_BAR;
    }
    for (;;) {
        const bool has_next = S.next(ui + 1, nxt);
        const char* nA = has_next ? (const char*)g.A + (size_t)nxt.pm * tstep : cA; const char* nB = has_next ? (const char*)g.Bt + (size_t)nxt.pn * tstep : cB;
        for (int t = 0; t < nt; t += 2) {
            const bool last = (t == nt - 2);
            const char* a1 = cA + (size_t)(t + 1) * kstep;
            const char* a2 = last ? nA : cA + (size_t)(t + 2) * kstep; const char* b2 = last ? nB : cB + (size_t)(t + 2) * kstep;
            const char* a3 = a2 + kstep; const char* b3 = b2 + kstep;
            if (last && has_next) S.a_ready(nxt);
            if constexpr (SP2) {
            PG8_LDB(B0, 0, 0); PG8_LDB(B1, 0, 1); PG8_SCHED; PG8_LDA(At, 0, 0); PG8_STAGE(PG8_SA(1, 1), a1 + hstep, voffA);
            PG8_WAIT_V(8); PG8_WAIT_L(0); PG8_BAR; PG8_MMA(0, 0, At, B0); PG8_MMA(0, 1, At, B1); PG8_BAR; PG8_SCHED;
            PG8_LDA(At, 0, 1); PG8_STAGE(PG8_SB(0, 0), b2, voffB); PG8_STAGE(PG8_SB(0, 1), b2 + hstep, voffB); PG8_STAGE(PG8_SA(0, 0), a2, voffA);
            PG8_WAIT_V(8); PG8_WAIT_L(0); PG8_BAR; PG8_MMA(1, 0, At, B0); PG8_MMA(1, 1, At, B1); PG8_BAR; PG8_SCHED;
            PG8_LDB(B0, 1, 0); PG8_LDB(B1, 1, 1); PG8_SCHED; PG8_LDA(At, 1, 0); PG8_STAGE(PG8_SA(0, 1), a2 + hstep, voffA);
            PG8_WAIT_V(8); PG8_WAIT_L(0); PG8_BAR; PG8_MMA(0, 0, At, B0); PG8_MMA(0, 1, At, B1); PG8_BAR; PG8_SCHED;
            PG8_LDA(At, 1, 1); PG8_STAGE(PG8_SB(1, 0), b3, voffB); PG8_STAGE(PG8_SB(1, 1), b3 + hstep, voffB); PG8_STAGE(PG8_SA(1, 0), a3, voffA);
            PG8_WAIT_V(8); PG8_WAIT_L(0); PG8_BAR; PG8_MMA(1, 0, At, B0); PG8_MMA(1, 1, At, B1); PG8_BAR; PG8_SCHED;
            } else {
            PG8_LDB(B0, 0, 0); PG8_SCHED; PG8_LDA(At, 0, 0); PG8_STAGE(PG8_SA(1, 1), a1 + hstep, voffA);
            PG8_WAIT_L(8); PG8_BAR; PG8_WAIT_L(0); PG8_MMA(0, 0, At, B0); PG8_BAR; PG8_SCHED;
            PG8_LDB(B1, 0, 1); PG8_STAGE(PG8_SB(0, 0), b2, voffB);
            PG8_BAR; PG8_WAIT_L(0); PG8_MMA(0, 1, At, B1); PG8_BAR;
            PG8_LDA(At, 0, 1); PG8_STAGE(PG8_SA(0, 0), a2, voffA);
            PG8_BAR; PG8_WAIT_L(0); PG8_MMA(1, 0, At, B0); PG8_BAR; PG8_SCHED;
            PG8_STAGE(PG8_SB(0, 1), b2 + hstep, voffB);
            PG8_WAIT_V(6); PG8_BAR; PG8_MMA(1, 1, At, B1); PG8_BAR;
            PG8_LDB(B0, 1, 0); PG8_SCHED; PG8_LDA(At, 1, 0); PG8_STAGE(PG8_SA(0, 1), a2 + hstep, voffA);
            PG8_WAIT_L(8); PG8_BAR; PG8_WAIT_L(0); PG8_MMA(0, 0, At, B0); PG8_BAR; PG8_SCHED;
            PG8_LDB(B1, 1, 1); PG8_STAGE(PG8_SB(1, 0), b3, voffB);
            PG8_BAR; PG8_WAIT_L(0); PG8_MMA(0, 1, At, B1); PG8_BAR;
            PG8_LDA(At, 1, 1); PG8_STAGE(PG8_SA(1, 0), a3, voffA);
            PG8_BAR; PG8_WAIT_L(0); PG8_MMA(1, 0, At, B0); PG8_BAR; PG8_SCHED;
            PG8_STAGE(PG8_SB(1, 1), b3 + hstep, voffB);
            PG8_WAIT_V(6); PG8_BAR; PG8_MMA(1, 1, At, B1); PG8_BAR;
            }
        }
        if constexpr (ALIGN_EPI) { if (wr == 0) PG8_BAR; }
        if constexpr (!Epi::AFTER_DRAIN) { E(acc, cur, wr, wc, fr, fq); S.done(cur); }
        if (!has_next) break;
#pragma unroll
        for (int a = 0; a < 2; ++a)
#pragma unroll
            for (int b = 0; b < 2; ++b)
#pragma unroll
                for (int m = 0; m < 4; ++m)
#pragma unroll
                    for (int n = 0; n < 2; ++n) acc[a][b][m][n] = (f32x4){0.f, 0.f, 0.f, 0.f};
        cur = nxt; cA = nA; cB = nB; ++ui;
        if constexpr (ALIGN_EPI) { if (wr == 1) PG8_BAR; }
    }
    PG8_WAIT_V(0);
    if constexpr (!ALIGN_EPI) { if (wr == 0) PG8_BAR; }
    PG8_BAR;
    if constexpr (Epi::AFTER_DRAIN) { E.fused(acc, cur, wr, wc, fr, fq, lds, wid, lane); S.done(cur); }
#undef PG8_SA
#undef PG8_SB
#undef PG8_STAGE
#undef PG8_LDA
#undef PG8_LDB
#undef PG8_MMA
#undef PG8_WAIT_V
#undef PG8_WAIT_L
#undef PG8_BAR
#undef PG8_SCHED
}
template <class Epi, class Sched, bool ALIGN_EPI = false, bool SP2 = false>
__device__ __forceinline__ void gemm_phase2_ffn(PG8_LAS unsigned char* lds, const Gemm g, const Sched& S, const Epi& E) {
    const int tid = threadIdx.x, wid = __builtin_amdgcn_readfirstlane(tid >> 6), lane = tid & 63, wr = wid >> 2, wc = wid & 3, fr = lane & 15, fq = lane >> 4;
    const int K = g.K, nt = K / BK;
    unsigned voffA[2], voffB[2];
#pragma unroll
    for (int i = 0; i < 2; ++i) { int R, C; stage_rc(tid * 16 + i * 8192, R, C); const int Rb = Epi::PERM ? ((R & ~31) + perm32(R & 31)) : R;
        voffA[i] = (unsigned)((62 * (R >> 6) + (R & 63)) * K + C) * 2u; voffB[i] = (unsigned)(Rb * K + C) * 2u; }
    const size_t kstep = (size_t)(BK * 2);
    const size_t hstepA = (size_t)124 * K * 2, hstepB = (size_t)2816 * K * 2;
#define PG8_ABASE(pm_) ((const char*)g.A + ((long)((pm_) / 17) * 4096 + 248L * ((pm_) % 17) - 2L) * (long)K * 2L)
#define PG8_BBASE(pn_) ((const char*)g.Bt + (size_t)(pn_) * HALF * K * 2)
    const unsigned ldsw = (unsigned)wid * 1024u;
    const int aoff = lds_byte(wr * 64 + fr, fq * 8), boff = lds_byte(wc * 32 + fr, fq * 8);
#define PG8_SA(b, h) (((b) * 2 + (h)) * HTB)
#define PG8_SB(b, h) ((4 + (b) * 2 + (h)) * HTB)
#define PG8_STAGE(bufoff, gbase, voff) do { _Pragma("unroll") for (int _i = 0; _i < 2; ++_i) \
        __builtin_amdgcn_global_load_lds((const unsigned*)((const char*)(gbase) + (voff)[_i]), (PG8_LAS unsigned*)(lds + (bufoff) + ldsw + _i * 8192), 16, 0, 0); } while (0)
#define PG8_LDA(dst, b, h) do { _Pragma("unroll") for (int m = 0; m < 4; ++m) _Pragma("unroll") for (int k = 0; k < 2; ++k) dst[m][k] = *(const PG8_LAS bf16x8*)(lds + PG8_SA(b, h) + aoff + m * 2048 + k * 1024); } while (0)
#define PG8_LDB(dst, b, h) do { _Pragma("unroll") for (int n = 0; n < 2; ++n) _Pragma("unroll") for (int k = 0; k < 2; ++k) dst[n][k] = *(const PG8_LAS bf16x8*)(lds + PG8_SB(b, h) + boff + n * 2048 + k * 1024); } while (0)
#define PG8_MMA(ai, bj, At, Bt) do { __builtin_amdgcn_s_setprio(1); _Pragma("unroll") for (int m = 0; m < 4; ++m) _Pragma("unroll") for (int n = 0; n < 2; ++n) _Pragma("unroll") for (int k = 0; k < 2; ++k) \
        acc[ai][bj][m][n] = __builtin_amdgcn_mfma_f32_16x16x32_bf16(Bt[n][k], At[m][k], acc[ai][bj][m][n], 0, 0, 0); __builtin_amdgcn_s_setprio(0); } while (0)
#define PG8_WAIT_V(n) asm volatile("s_waitcnt vmcnt(" #n ")" ::: "memory")
#define PG8_WAIT_L(n) asm volatile("s_waitcnt lgkmcnt(" #n ")" ::: "memory")
#define PG8_BAR __builtin_amdgcn_s_barrier()
#define PG8_SCHED __builtin_amdgcn_sched_barrier(0)
    Unit cur, nxt; int ui = 0;
    if (!S.next(0, cur)) return;
    f32x4 acc[2][2][4][2];
#pragma unroll
    for (int a = 0; a < 2; ++a)
#pragma unroll
        for (int b = 0; b < 2; ++b)
#pragma unroll
            for (int m = 0; m < 4; ++m)
#pragma unroll
                for (int n = 0; n < 2; ++n) acc[a][b][m][n] = (f32x4){0.f, 0.f, 0.f, 0.f};
    bf16x8 At[4][2], B0[2][2], B1[2][2];
    const char* cA = PG8_ABASE(cur.pm); const char* cB = PG8_BBASE(cur.pn);
    S.a_ready(cur);
    if constexpr (SP2) {
        PG8_STAGE(PG8_SB(0, 0), cB, voffB); PG8_STAGE(PG8_SB(0, 1), cB + hstepB, voffB); PG8_STAGE(PG8_SA(0, 0), cA, voffA); PG8_STAGE(PG8_SA(0, 1), cA + hstepA, voffA);
        if (wr == 1) PG8_BAR;
        PG8_WAIT_V(2); PG8_BAR;
        PG8_STAGE(PG8_SB(1, 0), cB + kstep, voffB); PG8_STAGE(PG8_SA(1, 0), cA + kstep, voffA); PG8_STAGE(PG8_SB(1, 1), cB + hstepB + kstep, voffB);
        PG8_WAIT_V(6); PG8_BAR;
    } else {
        PG8_STAGE(PG8_SB(0, 0), cB, voffB); PG8_STAGE(PG8_SA(0, 0), cA, voffA); PG8_STAGE(PG8_SB(0, 1), cB + hstepB, voffB); PG8_STAGE(PG8_SA(0, 1), cA + hstepA, voffA);
        if (wr == 1) PG8_BAR;
        PG8_WAIT_V(4); PG8_BAR;
        PG8_STAGE(PG8_SB(1, 0), cB + kstep, voffB); PG8_STAGE(PG8_SA(1, 0), cA + kstep, voffA); PG8_STAGE(PG8_SB(1, 1), cB + hstepB + kstep, voffB);
        PG8_WAIT_V(6); PG8_BAR;
    }
    for (;;) {
        const bool has_next = S.next(ui + 1, nxt);
        const char* nA = has_next ? PG8_ABASE(nxt.pm) : cA; const char* nB = has_next ? PG8_BBASE(nxt.pn) : cB;
        for (int t = 0; t < nt; t += 2) {
            const bool last = (t == nt - 2);
            const char* a1 = cA + (size_t)(t + 1) * kstep;
            const char* a2 = last ? nA : cA + (size_t)(t + 2) * kstep; const char* b2 = last ? nB : cB + (size_t)(t + 2) * kstep;
            const char* a3 = a2 + kstep; const char* b3 = b2 + kstep;
            if (last && has_next) S.a_ready(nxt);
            if constexpr (SP2) {
            PG8_LDB(B0, 0, 0); PG8_LDB(B1, 0, 1); PG8_SCHED; PG8_LDA(At, 0, 0); PG8_STAGE(PG8_SA(1, 1), a1 + hstepA, voffA);
            PG8_WAIT_V(8); PG8_WAIT_L(0); PG8_BAR; PG8_MMA(0, 0, At, B0); PG8_MMA(0, 1, At, B1); PG8_BAR; PG8_SCHED;
            PG8_LDA(At, 0, 1); PG8_STAGE(PG8_SB(0, 0), b2, voffB); PG8_STAGE(PG8_SB(0, 1), b2 + hstepB, voffB); PG8_STAGE(PG8_SA(0, 0), a2, voffA);
            PG8_WAIT_V(8); PG8_WAIT_L(0); PG8_BAR; PG8_MMA(1, 0, At, B0); PG8_MMA(1, 1, At, B1); PG8_BAR; PG8_SCHED;
            PG8_LDB(B0, 1, 0); PG8_LDB(B1, 1, 1); PG8_SCHED; PG8_LDA(At, 1, 0); PG8_STAGE(PG8_SA(0, 1), a2 + hstepA, voffA);
            PG8_WAIT_V(8); PG8_WAIT_L(0); PG8_BAR; PG8_MMA(0, 0, At, B0); PG8_MMA(0, 1, At, B1); PG8_BAR; PG8_SCHED;
            PG8_LDA(At, 1, 1); PG8_STAGE(PG8_SB(1, 0), b3, voffB); PG8_STAGE(PG8_SB(1, 1), b3 + hstepB, voffB); PG8_STAGE(PG8_SA(1, 0), a3, voffA);
            PG8_WAIT_V(8); PG8_WAIT_L(0); PG8_BAR; PG8_MMA(1, 0, At, B0); PG8_MMA(1, 1, At, B1); PG8_BAR; PG8_SCHED;
            } else {
            PG8_LDB(B0, 0, 0); PG8_SCHED; PG8_LDA(At, 0, 0); PG8_STAGE(PG8_SA(1, 1), a1 + hstepA, voffA);
            PG8_WAIT_L(8); PG8_BAR; PG8_WAIT_L(0); PG8_MMA(0, 0, At, B0); PG8_BAR; PG8_SCHED;
            PG8_LDB(B1, 0, 1); PG8_STAGE(PG8_SB(0, 0), b2, voffB);
            PG8_BAR; PG8_WAIT_L(0); PG8_MMA(0, 1, At, B1); PG8_BAR;
            PG8_LDA(At, 0, 1); PG8_STAGE(PG8_SA(0, 0), a2, voffA);
            PG8_BAR; PG8_WAIT_L(0); PG8_MMA(1, 0, At, B0); PG8_BAR; PG8_SCHED;
            PG8_STAGE(PG8_SB(0, 1), b2 + hstepB, voffB);
            PG8_WAIT_V(6); PG8_BAR; PG8_MMA(1, 1, At, B1); PG8_BAR;
            PG8_LDB(B0, 1, 0); PG8_SCHED; PG8_LDA(At, 1, 0); PG8_STAGE(PG8_SA(0, 1), a2 + hstepA, voffA);
            PG8_WAIT_L(8); PG8_BAR; PG8_WAIT_L(0); PG8_MMA(0, 0, At, B0); PG8_BAR; PG8_SCHED;
            PG8_LDB(B1, 1, 1); PG8_STAGE(PG8_SB(1, 0), b3, voffB);
            PG8_BAR; PG8_WAIT_L(0); PG8_MMA(0, 1, At, B1); PG8_BAR;
            PG8_LDA(At, 1, 1); PG8_STAGE(PG8_SA(1, 0), a3, voffA);
            PG8_BAR; PG8_WAIT_L(0); PG8_MMA(1, 0, At, B0); PG8_BAR; PG8_SCHED;
            PG8_STAGE(PG8_SB(1, 1), b3 + hstepB, voffB);
            PG8_WAIT_V(6); PG8_BAR; PG8_MMA(1, 1, At, B1); PG8_BAR;
            }
        }
        if constexpr (ALIGN_EPI) { if (wr == 0) PG8_BAR; }
        if constexpr (!Epi::AFTER_DRAIN) { E(acc, cur, wr, wc, fr, fq); S.done(cur); }
        if (!has_next) break;
#pragma unroll
        for (int a = 0; a < 2; ++a)
#pragma unroll
            for (int b = 0; b < 2; ++b)
#pragma unroll
                for (int m = 0; m < 4; ++m)
#pragma unroll
                    for (int n = 0; n < 2; ++n) acc[a][b][m][n] = (f32x4){0.f, 0.f, 0.f, 0.f};
        cur = nxt; cA = nA; cB = nB; ++ui;
        if constexpr (ALIGN_EPI) { if (wr == 1) PG8_BAR; }
    }
    PG8_WAIT_V(0);
    if constexpr (!ALIGN_EPI) { if (wr == 0) PG8_BAR; }
    PG8_BAR;
    if constexpr (Epi::AFTER_DRAIN) { E.fused(acc, cur, wr, wc, fr, fq, lds, wid, lane); S.done(cur); }
#undef PG8_SA
#undef PG8_SB
#undef PG8_STAGE
#undef PG8_LDA
#undef PG8_LDB
#undef PG8_MMA
#undef PG8_WAIT_V
#undef PG8_WAIT_L
#undef PG8_BAR
#undef PG8_SCHED
#undef PG8_ABASE
#undef PG8_BBASE
}
}


using pg8::bf16_t; using pg8::bf16x8; using pg8::f32x4; using pg8::f32x2_nat;
#define LAS __attribute__((address_space(3)))
#ifndef N_LAUNCH_MODE
#define N_LAUNCH_MODE 0
#endif
constexpr int T = 32768, D = 1024, SEQ = 4096, NMEMR = 2048, DIN = 4104, NP = 4096, DFF = 2816, NUP = 5632, TH = 16384;
constexpr float ALPHA = 1.189207115002721f, LN_EPS = 1e-5f;
constexpr int HQ = 0, HF = 512, HI = 1024, HG = 1536, MQ = 2048, MK = 2560, MV = 3072, MO = 3584;
constexpr size_t MiB = 1ull << 20;
constexpr size_t WS_WIN = 0, WS_WOUT = 8 * MiB, WS_WQ = 10 * MiB, WS_WKV = 12 * MiB, WS_WO = 16 * MiB, WS_WUP = 18 * MiB, WS_WDN = 29 * MiB,
                 WS_GATES = 35 * MiB, WS_MEMB = 36 * MiB, WS_KB = 40 * MiB, WS_VT = 44 * MiB,
                 WS_XB = 50 * MiB  , WS_PROJ = 114 * MiB, WS_X1 = 114 * MiB, WS_X1B = 242 * MiB  , WS_QB = 306 * MiB,
                 WS_UB = 50 * MiB, WS_HB = 306 * MiB, WS_Y = 370 * MiB, WS_BAR = 49 * MiB;
constexpr size_t WS_ST1 = 483 * MiB, WS_ST2 = WS_ST1 + 256 * 1024, WS_CV = WS_ST1 + 512 * 1024;
constexpr int LDS_BYTES = 144 * 1024;
constexpr int NPH = 16;
struct Args { const float* in[23]; float* out; unsigned char* ws; int ph_lo, ph_hi; };

#define WAVE_LDS_SYNC() asm volatile("s_waitcnt lgkmcnt(0)" ::: "memory")
__device__ __forceinline__ unsigned pk2(float a, float b) { return pg8::cvt_pk_bf16(a, b); }
__device__ __forceinline__ bf16_t f2bf(float a) { return (bf16_t)(pk2(a, a) & 0xffffu); }
__device__ __forceinline__ float bf2f(bf16_t u) { return __uint_as_float(((unsigned)u) << 16); }
__device__ __forceinline__ float bflo(unsigned u) { return __uint_as_float(u << 16); }
__device__ __forceinline__ float bfhi(unsigned u) { return __uint_as_float(u & 0xffff0000u); }
__device__ __forceinline__ float wave_sum(float v) {
#pragma unroll
    for (int o = 1; o < 64; o <<= 1) v += __shfl_xor(v, o);
    return v;
}
__device__ __forceinline__ float sigm(float x) { return __builtin_amdgcn_rcpf(1.f + __expf(-x)); }
__device__ __forceinline__ float gelu_tanh(float x) { const float u = 0.7978845608028654f * (x + 0.044715f * x * x * x); const float th = 1.f - 2.f * __builtin_amdgcn_rcpf(1.f + __expf(2.f * u)); return 0.5f * x * (1.f + th); }

__device__ __forceinline__ void transpose_item(const float* W, int ldw, int K, int N, bf16_t* WT, LAS float* scr, int item, int lane, const float* gsc = nullptr, const float* bsc = nullptr, float* c1 = nullptr, float* c2 = nullptr) {
    const int nblk = N / 32, kb = item / nblk, nb = item % nblk, k0 = 64 * kb, n0 = 32 * nb;
    if (gsc) {
        float s1 = 0.f, s2 = 0.f;
#pragma unroll 8
        for (int i = 0; i < 32; ++i) { const int kk = 2 * i + (lane >> 5); const float wv = W[(size_t)(k0 + kk) * ldw + n0 + (lane & 31)]; const float gw = wv * gsc[k0 + kk];
            s1 += gw; s2 += wv * bsc[k0 + kk]; scr[kk * 33 + (lane & 31)] = gw; }
        s1 += __shfl_xor(s1, 32); s2 += __shfl_xor(s2, 32);
        if (lane < 32) { atomicAdd(c1 + n0 + lane, s1); atomicAdd(c2 + n0 + lane, s2); }
    } else {
#pragma unroll 8
    for (int i = 0; i < 32; ++i) { const int kk = 2 * i + (lane >> 5); scr[kk * 33 + (lane & 31)] = W[(size_t)(k0 + kk) * ldw + n0 + (lane & 31)]; }
    }
    WAVE_LDS_SYNC();
    const int c = lane & 7;
#pragma unroll
    for (int j = 0; j < 4; ++j) { const int n = (lane >> 3) + 8 * j; const LAS float* s = scr + (8 * c) * 33 + n;
        uint4 o; o.x = pk2(s[0 * 33], s[1 * 33]); o.y = pk2(s[2 * 33], s[3 * 33]); o.z = pk2(s[4 * 33], s[5 * 33]); o.w = pk2(s[6 * 33], s[7 * 33]);
        *(uint4*)(WT + (size_t)(n0 + n) * K + k0 + 8 * c) = o; }
    WAVE_LDS_SYNC();
}
__device__ __forceinline__ void p0_prep(const Args& a, LAS unsigned char* lds, int tid, int wave, int lane, int gw, int NGW) {
    unsigned char* ws = a.ws;
    LAS float* wgT = (LAS float*)lds;
    LAS float* scr = (LAS float*)(lds + 32768 + wave * 8448);
    const float* w_in = a.in[2];
    for (int e = tid; e < 8192; e += 512) { const int k = e >> 3, c = e & 7; wgT[c * 1024 + k] = w_in[(size_t)k * DIN + 4096 + c]; }
    __syncthreads();
    constexpr int I_IN = 16 * 128, I_KV = 16 * 64;
    for (int it = gw; it < I_IN + I_KV; it += NGW) {
        if (it < I_IN) transpose_item(a.in[2], DIN, D, NP, (bf16_t*)(ws + WS_WIN), scr, it, lane);
        else transpose_item(a.in[13], 2 * D, D, 2 * D, (bf16_t*)(ws + WS_WKV), scr, it - I_IN, lane);
    }
    for (int i = (gw * 64 + lane); i < (512 * 1024 + 64 * 1024) / 16; i += NGW * 64) ((uint4*)(ws + WS_ST1))[i] = make_uint4(0u, 0u, 0u, 0u);
    const float* x = a.in[0]; const float* b_in = a.in[3];
    bf16_t* xb = (bf16_t*)(ws + WS_XB); float* gates = (float*)(ws + WS_GATES);
    f32x4 xn[4];
    if (gw < T) {
#pragma unroll
        for (int j = 0; j < 4; ++j) xn[j] = __builtin_nontemporal_load((const f32x4*)(x + (size_t)gw * D) + lane + 64 * j); }
    for (int m = gw; m < T; m += NGW) {
        uint2* xo = (uint2*)(xb + (size_t)m * D) + lane;
        f32x4 xc[4];
#pragma unroll
        for (int j = 0; j < 4; ++j) xc[j] = xn[j];
        if (m + NGW < T) {
#pragma unroll
            for (int j = 0; j < 4; ++j) xn[j] = __builtin_nontemporal_load((const f32x4*)(x + (size_t)(m + NGW) * D) + lane + 64 * j); }
        float g[8];
#pragma unroll
        for (int c = 0; c < 8; ++c) g[c] = 0.f;
#pragma unroll
        for (int j = 0; j < 4; ++j) { const f32x4 v = xc[j]; uint2 o; o.x = pk2(v[0], v[1]); o.y = pk2(v[2], v[3]); xo[64 * j] = o;
#pragma unroll
            for (int c = 0; c < 8; ++c) { const f32x4 w = *(const LAS f32x4*)(wgT + c * 1024 + 4 * (lane + 64 * j)); g[c] += (v[0] * w[0] + v[1] * w[1]) + (v[2] * w[2] + v[3] * w[3]); } }
#pragma unroll
        for (int c = 0; c < 8; ++c) g[c] = wave_sum(g[c]);
        float r = g[0];
#pragma unroll
        for (int c = 1; c < 8; ++c) r = (lane == c) ? g[c] : r;
        if (lane < 8) gates[(size_t)m * 8 + lane] = r + b_in[4096 + lane];
    }
    const float* mem = a.in[1]; bf16_t* memb = (bf16_t*)(ws + WS_MEMB);
    for (int m = gw; m < NMEMR; m += NGW) {
        const f32x4* xr = (const f32x4*)(mem + (size_t)m * D) + lane; uint2* xo = (uint2*)(memb + (size_t)m * D) + lane;
#pragma unroll
        for (int j = 0; j < 4; ++j) { const f32x4 v = xr[64 * j]; uint2 o; o.x = pk2(v[0], v[1]); o.y = pk2(v[2], v[3]); xo[64 * j] = o; }
    }
}

__device__ __forceinline__ void late_prep(const Args& a, LAS unsigned char* lds, int wave, int lane, int gw2, int NGW2) {
    unsigned char* ws = a.ws; LAS float* scr = (LAS float*)(lds + 32768 + wave * 8448);
    constexpr int I_SQ = 16 * 32, I_UP = 16 * 176, I_DN = 44 * 32;
    for (int it = gw2; it < 3 * I_SQ + I_UP + I_DN; it += NGW2) {
        int r = it;
        if (r < I_SQ) { transpose_item(a.in[9], D, D, D, (bf16_t*)(ws + WS_WOUT), scr, r, lane); continue; } r -= I_SQ;
        if (r < I_SQ) { transpose_item(a.in[12], D, D, D, (bf16_t*)(ws + WS_WQ), scr, r, lane, a.in[10], a.in[11], (float*)(ws + WS_CV), (float*)(ws + WS_CV) + 1024); continue; } r -= I_SQ;
        if (r < I_SQ) { transpose_item(a.in[14], D, D, D, (bf16_t*)(ws + WS_WO), scr, r, lane); continue; } r -= I_SQ;
        if (r < I_UP) { transpose_item(a.in[17], NUP, D, NUP, (bf16_t*)(ws + WS_WUP), scr, r, lane); continue; } r -= I_UP;
        transpose_item(a.in[20], D, DFF, D, (bf16_t*)(ws + WS_WDN), scr, r, lane);
    }
}
__device__ __forceinline__ void hgrn2_rec(const Args& a, int b, int h, LAS float* lds, int tid, int wave, int lane) {
    const bf16_t* projb = (const bf16_t*)(a.ws + WS_PROJ); bf16_t* y = (bf16_t*)(a.ws + WS_Y);
    const float* lbl = a.in[4]; const float* nw = a.in[5];
    LAS float* sq = lds; LAS float* sf = lds + 2048; LAS float* sv = lds + 4096; LAS float* spart = lds + 6144;
    const int v = tid & 127, g = tid >> 7;
    const float l0 = lbl[h * 128 + v], l1 = lbl[512 + h * 128 + v]; const float lb = 1.f / (1.f + __expf(l1 - l0));
    float S[32];
#pragma unroll
    for (int i = 0; i < 32; ++i) S[i] = 0.f;
    for (int t0 = 0; t0 < SEQ; t0 += 16) {
#pragma unroll
        for (int i = 0; i < 4; ++i) { const int tt = g + 4 * i; const bf16_t* pr = projb + (size_t)(b * SEQ + t0 + tt) * NP + h * 128 + v;
            const float hq = bf2f(pr[HQ]), hf = bf2f(pr[HF]), hi = bf2f(pr[HI]);
            sq[tt * 128 + v] = hq * sigm(hq); sf[tt * 128 + v] = lb + (1.f - lb) * sigm(hf); sv[tt * 128 + v] = hi; }
        __syncthreads();
        for (int tt = 0; tt < 16; ++tt) { const float vv = sv[tt * 128 + v]; float part = 0.f;
#pragma unroll
            for (int i = 0; i < 32; i += 4) { const f32x4 f4 = *(const LAS f32x4*)(sf + tt * 128 + g * 32 + i), q4 = *(const LAS f32x4*)(sq + tt * 128 + g * 32 + i);
#pragma unroll
                for (int jj = 0; jj < 4; ++jj) { S[i + jj] = f4[jj] * S[i + jj] + (1.f - f4[jj]) * vv; part += q4[jj] * S[i + jj]; } }
            spart[(tt * 4 + g) * 128 + v] = part; }
        __syncthreads();
#pragma unroll
        for (int q = 0; q < 2; ++q) { const int tt = 2 * wave + q; const size_t row = (size_t)(b * SEQ + t0 + tt);
            float o0 = 0.f, o1 = 0.f;
#pragma unroll
            for (int gg = 0; gg < 4; ++gg) { o0 += spart[(tt * 4 + gg) * 128 + lane]; o1 += spart[(tt * 4 + gg) * 128 + lane + 64]; }
            const float rstd = rsqrtf(wave_sum(o0 * o0 + o1 * o1) * (1.f / 128.f) + LN_EPS);
            const float g0 = bf2f(projb[row * NP + HG + h * 128 + lane]), g1 = bf2f(projb[row * NP + HG + h * 128 + lane + 64]);
            y[row * D + h * 128 + lane] = f2bf(o0 * rstd * nw[h * 128 + lane] * (g0 * sigm(g0)));
            y[row * D + h * 128 + lane + 64] = f2bf(o1 * rstd * nw[h * 128 + lane + 64] * (g1 * sigm(g1))); }
    }
}
__device__ __forceinline__ void mlstm_rec(const Args& a, int b, int h, LAS float* lds, int tid, int wave, int lane) {
    const bf16_t* projb = (const bf16_t*)(a.ws + WS_PROJ); bf16_t* y = (bf16_t*)(a.ws + WS_Y); const float* gates = (const float*)(a.ws + WS_GATES);
    const float* cw = a.in[6]; const float* cb = a.in[7]; const float* nw = a.in[8];
    LAS float* sq = lds; LAS float* sk = lds + 2048; LAS float* sv = lds + 4096; LAS float* spart = lds + 6144;
    LAS float* sgi = lds + 6144 + 16 * 4 * 132; LAS float* sgf = sgi + 16; LAS float* smt = sgf + 16;
    const int v = tid & 127, g = tid >> 7;
    float cwq[4], cwk[4];
#pragma unroll
    for (int j = 0; j < 4; ++j) { cwq[j] = cw[j * 1024 + h * 128 + v]; cwk[j] = cw[j * 1024 + 512 + h * 128 + v]; }
    const float cbq = cb[h * 128 + v], cbk = cb[512 + h * 128 + v];
    float C[32], nn[32];
#pragma unroll
    for (int i = 0; i < 32; ++i) { C[i] = 0.f; nn[i] = 0.f; }
    float mrun = -1e30f;
    for (int t0 = 0; t0 < SEQ; t0 += 16) {
#pragma unroll
        for (int i = 0; i < 4; ++i) { const int tt = g + 4 * i, t = t0 + tt; const bf16_t* pr = projb + (size_t)(b * SEQ + t) * NP + h * 128 + v;
            float aq = cbq, ak = cbk;
#pragma unroll
            for (int j = 0; j < 4; ++j) { const int ts = t - 3 + j; if (ts >= 0) { const bf16_t* ps = pr - (size_t)(3 - j) * NP; aq += bf2f(ps[MQ]) * cwq[j]; ak += bf2f(ps[MK]) * cwk[j]; } }
            sq[tt * 128 + v] = aq * sigm(aq) * 0.08838834764831845f; sk[tt * 128 + v] = ak * sigm(ak); sv[tt * 128 + v] = bf2f(pr[MV]); }
        if (tid < 16) { const size_t row = (size_t)(b * SEQ + t0 + tid); const float mi = gates[row * 8 + h], mf = gates[row * 8 + 4 + h];
            sgi[tid] = mi; sgf[tid] = fminf(mf, 0.f) - log1pf(__expf(-fabsf(mf))); }
        __syncthreads();
        for (int tt = 0; tt < 16; ++tt) { const float vv = sv[tt * 128 + v];
            const float it = sgi[tt], lf = sgf[tt]; const float mnew = fmaxf(lf + mrun, it); const float fp = __expf(lf + mrun - mnew), ip = __expf(it - mnew); mrun = mnew;
            float part = 0.f, dpart = 0.f; const float iv = ip * vv;
#pragma unroll
            for (int i = 0; i < 32; i += 4) { const f32x4 k4 = *(const LAS f32x4*)(sk + tt * 128 + g * 32 + i), q4 = *(const LAS f32x4*)(sq + tt * 128 + g * 32 + i);
#pragma unroll
                for (int jj = 0; jj < 4; ++jj) { C[i + jj] = fp * C[i + jj] + iv * k4[jj]; nn[i + jj] = fp * nn[i + jj] + ip * k4[jj]; part += q4[jj] * C[i + jj]; dpart += q4[jj] * nn[i + jj]; } }
            spart[(tt * 4 + g) * 132 + v] = part; if (v == 0) spart[(tt * 4 + g) * 132 + 128] = dpart; if (tid == 0) smt[tt] = mnew; }
        __syncthreads();
#pragma unroll
        for (int q = 0; q < 2; ++q) { const int tt = 2 * wave + q; const size_t row = (size_t)(b * SEQ + t0 + tt);
            float o0 = 0.f, o1 = 0.f, den = 0.f;
#pragma unroll
            for (int gg = 0; gg < 4; ++gg) { o0 += spart[(tt * 4 + gg) * 132 + lane]; o1 += spart[(tt * 4 + gg) * 132 + lane + 64]; den += spart[(tt * 4 + gg) * 132 + 128]; }
            const float dn = 1.f / fmaxf(fabsf(den), __expf(-smt[tt]));
            o0 *= dn; o1 *= dn;
            const float mean = wave_sum(o0 + o1) * (1.f / 128.f); const float d0 = o0 - mean, d1 = o1 - mean;
            const float rstd = rsqrtf(wave_sum(d0 * d0 + d1 * d1) * (1.f / 128.f) + LN_EPS);
            const float g0 = bf2f(projb[row * NP + MO + h * 128 + lane]), g1 = bf2f(projb[row * NP + MO + h * 128 + lane + 64]);
            y[row * D + 512 + h * 128 + lane] = f2bf(sigm(g0) * d0 * rstd * nw[h * 128 + lane]);
            y[row * D + 512 + h * 128 + lane + 64] = f2bf(sigm(g1) * d1 * rstd * nw[h * 128 + lane + 64]); }
    }
}

constexpr int P128 = 136, P64 = 72;
typedef unsigned u32x2 __attribute__((ext_vector_type(2)));
typedef unsigned u32x4n __attribute__((ext_vector_type(4)));
__device__ __forceinline__ u32x2 pack4(float a, float b, float c, float d) { u32x2 r; r.x = pk2(a, b); r.y = pk2(c, d); return r; }
__device__ __forceinline__ void unpack4(u32x2 u, float (&o)[4]) { o[0] = bflo(u.x); o[1] = bfhi(u.x); o[2] = bflo(u.y); o[3] = bfhi(u.y); }
#define MFMA16(a, b, c) __builtin_amdgcn_mfma_f32_16x16x32_bf16(a, b, c, 0, 0, 0)
#define LDFRAG(base, row, pitch, ks) (*(const LAS bf16x8*)((base) + (row) * (pitch) + (ks) * 32 + quad * 8))

__device__ __forceinline__ void hgrn2_chunk(const Args& a, int b, int h, LAS unsigned char* lds, int tid, int w, int lane) {
    const bf16_t* projb = (const bf16_t*)(a.ws + WS_PROJ); bf16_t* y = (bf16_t*)(a.ws + WS_Y);
    const float* lbl = a.in[4]; const float* nw = a.in[5];
    LAS bf16_t* QD = (LAS bf16_t*)lds; LAS bf16_t* KD = QD + 64 * P128; LAS bf16_t* QB = KD + 64 * P128;
    LAS bf16_t* KLT = QB + 64 * P128; LAS bf16_t* VT = KLT + 128 * P64; LAS bf16_t* ATT = VT + 128 * P64; LAS bf16_t* ST = ATT + 64 * P64;
    LAS float* NRM = (LAS float*)(ST + 128 * P128);
    const int tg = lane >> 2, dg = lane & 3, quad = lane >> 4, r16 = lane & 15;
    const int tt = w >> 1, vh = w & 1;
    for (int e = tid; e < 128 * P128 / 2; e += 512) ((LAS unsigned*)ST)[e] = 0u;
    LAS float* NWL = NRM + 128;
    if (tid < 128) NWL[tid] = nw[h * 128 + tid];
    float lb[4];
#pragma unroll
    for (int k = 0; k < 4; ++k) { const int d = h * 128 + 16 * w + 4 * dg + k; lb[k] = __builtin_amdgcn_rcpf(1.f + __expf(lbl[512 + d] - lbl[d])); }
    f32x4 Sacc[8];
#pragma unroll
    for (int i = 0; i < 8; ++i) Sacc[i] = (f32x4){0.f, 0.f, 0.f, 0.f};
    const size_t rowbase = (size_t)b * SEQ;
    const bf16_t* pcol = projb + h * 128 + 16 * w + 4 * dg;
    const bf16_t* pgat = projb + HG + h * 128 + 64 * vh + 4 * quad;
    u32x2 rq[4], rf[4], rv[4], rg[4];
#pragma unroll
    for (int i = 0; i < 4; ++i) { const bf16_t* p = pcol + (rowbase + 4 * tg + i) * NP; rq[i] = *(const u32x2*)(p + HQ); rf[i] = *(const u32x2*)(p + HF); rv[i] = *(const u32x2*)(p + HI); }
#pragma unroll
    for (int vt = 0; vt < 4; ++vt) rg[vt] = *(const u32x2*)(pgat + (rowbase + 16 * tt + r16) * NP + 16 * vt);
    __syncthreads();
    for (int c = 0; c < 64; ++c) {
        float q[4][4], lf[4][4], kk[4][4], vv[4][4]; u32x2 rgc[4];
#pragma unroll
        for (int i = 0; i < 4; ++i) { float hq[4], hf[4]; unpack4(rq[i], hq); unpack4(rf[i], hf); unpack4(rv[i], vv[i]);
#pragma unroll
            for (int k = 0; k < 4; ++k) { q[i][k] = hq[k]; const float f = lb[k] + (1.f - lb[k]) * sigm(hf[k]); lf[i][k] = __logf(f); kk[i][k] = 1.f - f; } }
#pragma unroll
        for (int vt = 0; vt < 4; ++vt) rgc[vt] = rg[vt];
        float bref[4], blast[4], dec[4];
#pragma unroll
        for (int k = 0; k < 4; ++k) {
            lf[1][k] += lf[0][k]; lf[2][k] += lf[1][k]; lf[3][k] += lf[2][k];
            const float tot = lf[3][k]; float run = tot;
#pragma unroll
            for (int off = 4; off < 64; off <<= 1) { const float t2 = __shfl_up(run, off); if (lane >= off) run += t2; }
            const float excl = run - tot;
#pragma unroll
            for (int i = 0; i < 4; ++i) lf[i][k] += excl;
            bref[k] = __shfl(lf[3][k], 28 + dg); blast[k] = __shfl(lf[3][k], 60 + dg);
        }
#pragma unroll
        for (int j = 0; j < 4; ++j) { float e = __expf(blast[0]); e = (j == 1) ? __expf(blast[1]) : e; e = (j == 2) ? __expf(blast[2]) : e; e = (j == 3) ? __expf(blast[3]) : e; dec[j] = __shfl(e, 60 + quad); }
        {
            float eref[4], elast[4];
#pragma unroll
            for (int k = 0; k < 4; ++k) { eref[k] = __expf(bref[k]); elast[k] = __expf(blast[k] - bref[k]); }
            float kl[4][4];
#pragma unroll
            for (int i = 0; i < 4; ++i) { float qd[4], kd[4], qb[4];
#pragma unroll
                for (int k = 0; k < 4; ++k) { const float e1 = __expf(lf[i][k] - bref[k]), e2 = __expf(bref[k] - lf[i][k]);
                    qd[k] = q[i][k] * e1; kd[k] = kk[i][k] * e2; qb[k] = qd[k] * eref[k]; kl[i][k] = kd[k] * elast[k]; }
                const int off = (4 * tg + i) * P128 + 16 * w + 4 * dg;
                *(LAS u32x2*)(QD + off) = pack4(qd[0], qd[1], qd[2], qd[3]); *(LAS u32x2*)(KD + off) = pack4(kd[0], kd[1], kd[2], kd[3]); *(LAS u32x2*)(QB + off) = pack4(qb[0], qb[1], qb[2], qb[3]); }
#pragma unroll
            for (int k = 0; k < 4; ++k) { const int off = (16 * w + 4 * dg + k) * P64 + 4 * tg;
                *(LAS u32x2*)(KLT + off) = pack4(kl[0][k], kl[1][k], kl[2][k], kl[3][k]); *(LAS u32x2*)(VT + off) = pack4(vv[0][k], vv[1][k], vv[2][k], vv[3][k]); }
        }
        __syncthreads();
        { const int cn = (c + 1 < 64) ? c + 1 : 63;
#pragma unroll
            for (int i = 0; i < 4; ++i) { const bf16_t* p = pcol + (rowbase + cn * 64 + 4 * tg + i) * NP; rq[i] = *(const u32x2*)(p + HQ); rf[i] = *(const u32x2*)(p + HF); rv[i] = *(const u32x2*)(p + HI); }
#pragma unroll
            for (int vt = 0; vt < 4; ++vt) rg[vt] = *(const u32x2*)(pgat + (rowbase + cn * 64 + 16 * tt + r16) * NP + 16 * vt); }
        {
            bf16x8 qf[4];
#pragma unroll
            for (int ks = 0; ks < 4; ++ks) qf[ks] = LDFRAG(QD, 16 * tt + r16, P128, ks);
#pragma unroll
            for (int si = 0; si < 2; ++si) { const int st = 2 * vh + si; f32x4 acc = {0.f, 0.f, 0.f, 0.f};
                if (st <= tt) {
#pragma unroll
                    for (int ks = 0; ks < 4; ++ks) { const bf16x8 kf = LDFRAG(KD, 16 * st + r16, P128, ks); acc = MFMA16(kf, qf[ks], acc); }
                    const int t = 16 * tt + r16, s0 = 16 * st + 4 * quad;
#pragma unroll
                    for (int j = 0; j < 4; ++j) acc[j] = (s0 + j <= t) ? acc[j] : 0.f;
                }
                *(LAS u32x2*)(ATT + (16 * tt + r16) * P64 + 16 * st + 4 * quad) = pack4(acc[0], acc[1], acc[2], acc[3]); }
        }
        __syncthreads();
        f32x4 o[4];
        {
            bf16x8 af[2], qbf[4];
#pragma unroll
            for (int ks = 0; ks < 2; ++ks) af[ks] = LDFRAG(ATT, 16 * tt + r16, P64, ks);
#pragma unroll
            for (int ks = 0; ks < 4; ++ks) qbf[ks] = LDFRAG(QB, 16 * tt + r16, P128, ks);
            float ss = 0.f;
#pragma unroll
            for (int vt = 0; vt < 4; ++vt) { const int v0 = 64 * vh + 16 * vt; f32x4 acc = {0.f, 0.f, 0.f, 0.f};
#pragma unroll
                for (int ks = 0; ks < 2; ++ks) acc = MFMA16(LDFRAG(VT, v0 + r16, P64, ks), af[ks], acc);
#pragma unroll
                for (int ks = 0; ks < 4; ++ks) acc = MFMA16(LDFRAG(ST, v0 + r16, P128, ks), qbf[ks], acc);
                o[vt] = acc; ss += (acc[0] * acc[0] + acc[1] * acc[1]) + (acc[2] * acc[2] + acc[3] * acc[3]); }
            ss += __shfl_xor(ss, 16); ss += __shfl_xor(ss, 32);
            if (quad == 0) NRM[(16 * tt + r16) * 2 + vh] = ss;
            bf16x8 klf[2];
#pragma unroll
            for (int ks = 0; ks < 2; ++ks) klf[ks] = LDFRAG(KLT, 16 * w + r16, P64, ks);
#pragma unroll
            for (int v8 = 0; v8 < 8; ++v8) { f32x4 acc = Sacc[v8];
#pragma unroll
                for (int j = 0; j < 4; ++j) acc[j] *= dec[j];
#pragma unroll
                for (int ks = 0; ks < 2; ++ks) acc = MFMA16(klf[ks], LDFRAG(VT, 16 * v8 + r16, P64, ks), acc);
                Sacc[v8] = acc; }
        }
        __syncthreads();
#pragma unroll
        for (int v8 = 0; v8 < 8; ++v8) *(LAS u32x2*)(ST + (16 * v8 + r16) * P128 + 16 * w + 4 * quad) = pack4(Sacc[v8][0], Sacc[v8][1], Sacc[v8][2], Sacc[v8][3]);
        {
            const int t = 16 * tt + r16; const float rstd = __builtin_amdgcn_rsqf((NRM[t * 2] + NRM[t * 2 + 1]) * (1.f / 128.f) + LN_EPS);
            bf16_t* yp = y + (rowbase + c * 64 + t) * D + h * 128 + 64 * vh + 4 * quad;
#pragma unroll
            for (int vt = 0; vt < 4; ++vt) { float r[4], gt[4]; unpack4(rgc[vt], gt); const f32x4 nv = *(const LAS f32x4*)(NWL + 64 * vh + 16 * vt + 4 * quad);
#pragma unroll
                for (int j = 0; j < 4; ++j) r[j] = o[vt][j] * rstd * nv[j] * gt[j];
                *(u32x2*)(yp + 16 * vt) = pack4(r[0], r[1], r[2], r[3]); }
        }
    }
    __syncthreads();
}

__device__ __forceinline__ void mlstm_chunk(const Args& a, int b, int h, LAS unsigned char* lds, int tid, int w, int lane) {
    const bf16_t* projb = (const bf16_t*)(a.ws + WS_PROJ); bf16_t* y = (bf16_t*)(a.ws + WS_Y); const float* gates = (const float*)(a.ws + WS_GATES);
    const float* cw = a.in[6]; const float* cb = a.in[7]; const float* nw = a.in[8];
    LAS bf16_t* QM = (LAS bf16_t*)lds; LAS bf16_t* KM = QM + 64 * P128; LAS bf16_t* QW = KM + 64 * P128;
    LAS bf16_t* KLT = QW + 64 * P128; LAS bf16_t* VT = KLT + 128 * P64; LAS bf16_t* ATT = VT + 144 * P64; LAS bf16_t* ST = ATT + 64 * P64;
    LAS float* NRM = (LAS float*)(ST + 144 * P128);
    const int tg = lane >> 2, dg = lane & 3, quad = lane >> 4, r16 = lane & 15;
    const int tt = w >> 1, vh = w & 1;
    for (int e = tid; e < 144 * P128 / 2; e += 512) ((LAS unsigned*)ST)[e] = 0u;
    for (int e = tid; e < 16 * P64 / 2; e += 512) ((LAS unsigned*)(VT + 128 * P64))[e] = (e < P64 / 2) ? 0x3F803F80u : 0u;
    LAS float* NWL = NRM + 256 + 1280;
    if (tid < 128) NWL[tid] = nw[h * 128 + tid];
    LAS float* CWT = NRM + 256;
    for (int e = tid; e < 1280; e += 512) { const int r = e >> 7, d = e & 127; CWT[e] = (r < 4) ? cw[r * 1024 + h * 128 + d] : (r < 8) ? cw[(r - 4) * 1024 + 512 + h * 128 + d] : (r == 8) ? cb[h * 128 + d] : cb[512 + h * 128 + d]; }
    f32x4 Cacc[9];
#pragma unroll
    for (int i = 0; i < 9; ++i) Cacc[i] = (f32x4){0.f, 0.f, 0.f, 0.f};
    float m_st = -1e30f;
    const size_t rowbase = (size_t)b * SEQ;
    const bf16_t* pcol = projb + h * 128 + 16 * w + 4 * dg;
    const bf16_t* pgat = projb + MO + h * 128 + 64 * vh + 4 * quad;
    u32x2 rq[7], rk[7], rv[4], rg[4]; float rmi, rmf;
#pragma unroll
    for (int i = 0; i < 7; ++i) { const int t = 4 * tg + i - 3; if (t >= 0) { const bf16_t* p = pcol + (rowbase + t) * NP; rq[i] = *(const u32x2*)(p + MQ); rk[i] = *(const u32x2*)(p + MK); } else { rq[i] = (u32x2){0u, 0u}; rk[i] = (u32x2){0u, 0u}; } }
#pragma unroll
    for (int i = 0; i < 4; ++i) rv[i] = *(const u32x2*)(pcol + (rowbase + 4 * tg + i) * NP + MV);
#pragma unroll
    for (int vt = 0; vt < 4; ++vt) rg[vt] = *(const u32x2*)(pgat + (rowbase + 16 * tt + r16) * NP + 16 * vt);
    rmi = gates[(rowbase + lane) * 8 + h]; rmf = gates[(rowbase + lane) * 8 + 4 + h];
    __syncthreads();
    for (int c = 0; c < 64; ++c) {
        const float mi = rmi, lfs = fminf(rmf, 0.f) - log1pf(__expf(-fabsf(rmf)));
        float bs = lfs;
#pragma unroll
        for (int off = 1; off < 64; off <<= 1) { const float t2 = __shfl_up(bs, off); if (lane >= off) bs += t2; }
        const float gsum = __shfl(bs, 63);
        const float imb = mi - bs; float pm = imb;
#pragma unroll
        for (int off = 1; off < 64; off <<= 1) { const float t2 = __shfl_up(pm, off); if (lane >= off) pm = fmaxf(pm, t2); }
        const float inter = bs + m_st, m_t = fmaxf(inter, pm + bs);
        const float w_inter = __expf(inter - m_t);
        const float m_new = fmaxf(gsum + m_st, gsum + __shfl(pm, 63));
        const float decay = __expf(gsum + m_st - m_new), aexp = __expf(gsum + imb - m_new);
        const float bm = bs - m_t;
        float qv[4][4], kv[4][4], vv[4][4]; u32x2 rgc[4];
        {
            const LAS float* cwp = CWT + 16 * w + 4 * dg;
            { float xq[7][4]; f32x4 wq[4];
#pragma unroll
                for (int i = 0; i < 7; ++i) unpack4(rq[i], xq[i]);
#pragma unroll
                for (int j = 0; j < 4; ++j) wq[j] = *(const LAS f32x4*)(cwp + j * 128);
                const f32x4 bq = *(const LAS f32x4*)(cwp + 8 * 128);
#pragma unroll
                for (int i = 0; i < 4; ++i)
#pragma unroll
                    for (int k = 0; k < 4; ++k) { float aq = bq[k];
#pragma unroll
                        for (int j = 0; j < 4; ++j) aq += xq[i + j][k] * wq[j][k];
                        qv[i][k] = aq * sigm(aq) * 0.08838834764831845f; } }
            { float xk[7][4]; f32x4 wk[4];
#pragma unroll
                for (int i = 0; i < 7; ++i) unpack4(rk[i], xk[i]);
#pragma unroll
                for (int j = 0; j < 4; ++j) wk[j] = *(const LAS f32x4*)(cwp + (4 + j) * 128);
                const f32x4 bk = *(const LAS f32x4*)(cwp + 9 * 128);
#pragma unroll
                for (int i = 0; i < 4; ++i)
#pragma unroll
                    for (int k = 0; k < 4; ++k) { float ak = bk[k];
#pragma unroll
                        for (int j = 0; j < 4; ++j) ak += xk[i + j][k] * wk[j][k];
                        kv[i][k] = ak * sigm(ak); } }
#pragma unroll
            for (int i = 0; i < 4; ++i) unpack4(rv[i], vv[i]);
#pragma unroll
            for (int vt = 0; vt < 4; ++vt) rgc[vt] = rg[vt];
        }
        {
            float wi[4], ae[4];
#pragma unroll
            for (int i = 0; i < 4; ++i) { wi[i] = __shfl(w_inter, 4 * tg + i); ae[i] = __shfl(aexp, 4 * tg + i); }
#pragma unroll
            for (int i = 0; i < 4; ++i) { const int off = (4 * tg + i) * P128 + 16 * w + 4 * dg;
                *(LAS u32x2*)(QM + off) = pack4(qv[i][0], qv[i][1], qv[i][2], qv[i][3]); *(LAS u32x2*)(KM + off) = pack4(kv[i][0], kv[i][1], kv[i][2], kv[i][3]);
                *(LAS u32x2*)(QW + off) = pack4(qv[i][0] * wi[i], qv[i][1] * wi[i], qv[i][2] * wi[i], qv[i][3] * wi[i]); }
#pragma unroll
            for (int k = 0; k < 4; ++k) { const int off = (16 * w + 4 * dg + k) * P64 + 4 * tg;
                *(LAS u32x2*)(KLT + off) = pack4(kv[0][k] * ae[0], kv[1][k] * ae[1], kv[2][k] * ae[2], kv[3][k] * ae[3]); *(LAS u32x2*)(VT + off) = pack4(vv[0][k], vv[1][k], vv[2][k], vv[3][k]); }
        }
        __syncthreads();
        { const int cn = (c + 1 < 64) ? c + 1 : 63; const size_t rb = rowbase + cn * 64;
#pragma unroll
            for (int i = 0; i < 7; ++i) { const bf16_t* p = pcol + (rb + 4 * tg + i - 3) * NP; rq[i] = *(const u32x2*)(p + MQ); rk[i] = *(const u32x2*)(p + MK); }
#pragma unroll
            for (int i = 0; i < 4; ++i) rv[i] = *(const u32x2*)(pcol + (rb + 4 * tg + i) * NP + MV);
#pragma unroll
            for (int vt = 0; vt < 4; ++vt) rg[vt] = *(const u32x2*)(pgat + (rb + 16 * tt + r16) * NP + 16 * vt);
            rmi = gates[(rb + lane) * 8 + h]; rmf = gates[(rb + lane) * 8 + 4 + h]; }
        {
            bf16x8 qf[4];
#pragma unroll
            for (int ks = 0; ks < 4; ++ks) qf[ks] = LDFRAG(QM, 16 * tt + r16, P128, ks);
            const float bmt = __shfl(bm, 16 * tt + r16);
#pragma unroll
            for (int si = 0; si < 2; ++si) { const int st = 2 * vh + si; f32x4 acc = {0.f, 0.f, 0.f, 0.f};
                if (st <= tt) {
#pragma unroll
                    for (int ks = 0; ks < 4; ++ks) { const bf16x8 kf = LDFRAG(KM, 16 * st + r16, P128, ks); acc = MFMA16(kf, qf[ks], acc); }
                    const int t = 16 * tt + r16, s0 = 16 * st + 4 * quad;
#pragma unroll
                    for (int j = 0; j < 4; ++j) { const float ims = __shfl(imb, s0 + j); acc[j] = (s0 + j <= t) ? acc[j] * __expf(bmt + ims) : 0.f; }
                }
                *(LAS u32x2*)(ATT + (16 * tt + r16) * P64 + 16 * st + 4 * quad) = pack4(acc[0], acc[1], acc[2], acc[3]); }
        }
        __syncthreads();
        f32x4 o[4];
        {
            bf16x8 af[2], qwf[4];
#pragma unroll
            for (int ks = 0; ks < 2; ++ks) af[ks] = LDFRAG(ATT, 16 * tt + r16, P64, ks);
#pragma unroll
            for (int ks = 0; ks < 4; ++ks) qwf[ks] = LDFRAG(QW, 16 * tt + r16, P128, ks);
            f32x4 ae4 = {0.f, 0.f, 0.f, 0.f};
#pragma unroll
            for (int ks = 0; ks < 2; ++ks) ae4 = MFMA16(LDFRAG(VT, 128 + r16, P64, ks), af[ks], ae4);
#pragma unroll
            for (int ks = 0; ks < 4; ++ks) ae4 = MFMA16(LDFRAG(ST, 128 + r16, P128, ks), qwf[ks], ae4);
            const float den = __shfl(ae4[0], r16);
            const float mt_t = __shfl(m_t, 16 * tt + r16);
            const float dn = __builtin_amdgcn_rcpf(fmaxf(fabsf(den), __expf(-mt_t)));
            float s1 = 0.f, s2 = 0.f;
#pragma unroll
            for (int vt = 0; vt < 4; ++vt) { const int v0 = 64 * vh + 16 * vt; f32x4 acc = {0.f, 0.f, 0.f, 0.f};
#pragma unroll
                for (int ks = 0; ks < 2; ++ks) acc = MFMA16(LDFRAG(VT, v0 + r16, P64, ks), af[ks], acc);
#pragma unroll
                for (int ks = 0; ks < 4; ++ks) acc = MFMA16(LDFRAG(ST, v0 + r16, P128, ks), qwf[ks], acc);
                acc = acc * dn; o[vt] = acc; s1 += (acc[0] + acc[1]) + (acc[2] + acc[3]); s2 += (acc[0] * acc[0] + acc[1] * acc[1]) + (acc[2] * acc[2] + acc[3] * acc[3]); }
            s1 += __shfl_xor(s1, 16); s1 += __shfl_xor(s1, 32); s2 += __shfl_xor(s2, 16); s2 += __shfl_xor(s2, 32);
            if (quad == 0) { NRM[(16 * tt + r16) * 4 + 2 * vh] = s1; NRM[(16 * tt + r16) * 4 + 2 * vh + 1] = s2; }
            bf16x8 klf[2];
#pragma unroll
            for (int ks = 0; ks < 2; ++ks) klf[ks] = LDFRAG(KLT, 16 * w + r16, P64, ks);
#pragma unroll
            for (int v9 = 0; v9 < 9; ++v9) { f32x4 acc = Cacc[v9] * decay;
#pragma unroll
                for (int ks = 0; ks < 2; ++ks) acc = MFMA16(klf[ks], LDFRAG(VT, 16 * v9 + r16, P64, ks), acc);
                Cacc[v9] = acc; }
        }
        __syncthreads();
#pragma unroll
        for (int v9 = 0; v9 < 9; ++v9) *(LAS u32x2*)(ST + (16 * v9 + r16) * P128 + 16 * w + 4 * quad) = pack4(Cacc[v9][0], Cacc[v9][1], Cacc[v9][2], Cacc[v9][3]);
        {
            const int t = 16 * tt + r16; const float mean = (NRM[t * 4] + NRM[t * 4 + 2]) * (1.f / 128.f); const float var = fmaxf((NRM[t * 4 + 1] + NRM[t * 4 + 3]) * (1.f / 128.f) - mean * mean, 0.f);
            const float rstd = __builtin_amdgcn_rsqf(var + LN_EPS);
            bf16_t* yp = y + (rowbase + c * 64 + t) * D + 512 + h * 128 + 64 * vh + 4 * quad;
#pragma unroll
            for (int vt = 0; vt < 4; ++vt) { float r[4], gt[4]; unpack4(rgc[vt], gt); const f32x4 nv = *(const LAS f32x4*)(NWL + 64 * vh + 16 * vt + 4 * quad);
#pragma unroll
                for (int j = 0; j < 4; ++j) r[j] = gt[j] * (o[vt][j] - mean) * rstd * nv[j];
                *(u32x2*)(yp + 16 * vt) = pack4(r[0], r[1], r[2], r[3]); }
        }
        m_st = m_new;
    }
    __syncthreads();
}

__device__ __forceinline__ unsigned xcc_id() { return (unsigned)__builtin_amdgcn_s_getreg((3 << 11) | 20) & 0xFu; }
__device__ __forceinline__ void grid_bar(unsigned* bar, unsigned xcc, unsigned nxb, unsigned nx, unsigned round) {
    asm volatile("s_waitcnt vmcnt(0)" ::: "memory");
    __syncthreads();
    if (threadIdx.x == 0) {
        const unsigned prev = __hip_atomic_fetch_add(bar + 64 * (1 + xcc), 1u, __ATOMIC_RELAXED, __HIP_MEMORY_SCOPE_AGENT);
        if (prev + 1u == round * nxb) {
            __builtin_amdgcn_fence(__ATOMIC_RELEASE, "agent");
            asm volatile("s_waitcnt vmcnt(0)" ::: "memory");
            __hip_atomic_fetch_add(bar, 1u, __ATOMIC_RELAXED, __HIP_MEMORY_SCOPE_AGENT);
        }
        while (__hip_atomic_load(bar, __ATOMIC_RELAXED, __HIP_MEMORY_SCOPE_AGENT) < round * nx) __builtin_amdgcn_s_sleep(1);
        __builtin_amdgcn_fence(__ATOMIC_ACQUIRE, "agent");
        asm volatile("s_waitcnt vmcnt(0)" ::: "memory");
    }
    __syncthreads();
}
constexpr size_t WS_ATH = 434 * MiB, WS_ATM = 450 * MiB, WS_DECH = 466 * MiB, WS_SCM = 467 * MiB;
__device__ __forceinline__ void hgrn2_pre(const Args& a, int b, int h, int c, LAS unsigned char* lds, int tid, int w, int lane) {
    const bf16_t* projb = (const bf16_t*)(a.ws + WS_PROJ); const float* lbl = a.in[4];
    bf16_t* QBH = (bf16_t*)a.out; bf16_t* KLH = QBH + (size_t)T * 512; bf16_t* ATH = (bf16_t*)(a.ws + WS_ATH); float* DECH = (float*)(a.ws + WS_DECH);
    LAS bf16_t* QD = (LAS bf16_t*)lds; LAS bf16_t* KD = QD + 64 * P128;
    const int tg = lane >> 2, dg = lane & 3, quad = lane >> 4, r16 = lane & 15, tt = w >> 1, vh = w & 1;
    const size_t item = (size_t)((b * 4 + h) * 64 + c), row0 = (size_t)b * SEQ + c * 64;
    float lb[4];
#pragma unroll
    for (int k = 0; k < 4; ++k) { const int d = h * 128 + 16 * w + 4 * dg + k; lb[k] = __builtin_amdgcn_rcpf(1.f + __expf(lbl[512 + d] - lbl[d])); }
    const bf16_t* pcol = projb + h * 128 + 16 * w + 4 * dg;
    float q[4][4], lf[4][4], kk[4][4];
#pragma unroll
    for (int i = 0; i < 4; ++i) { const bf16_t* p = pcol + (row0 + 4 * tg + i) * NP; float hq[4], hf[4]; unpack4(*(const u32x2*)(p + HQ), hq); unpack4(*(const u32x2*)(p + HF), hf);
#pragma unroll
        for (int k = 0; k < 4; ++k) { q[i][k] = hq[k]; const float f = lb[k] + (1.f - lb[k]) * sigm(hf[k]); lf[i][k] = __logf(f); kk[i][k] = 1.f - f; } }
    float bref[4], blast[4];
#pragma unroll
    for (int k = 0; k < 4; ++k) {
        lf[1][k] += lf[0][k]; lf[2][k] += lf[1][k]; lf[3][k] += lf[2][k];
        const float tot = lf[3][k]; float run = tot;
#pragma unroll
        for (int off = 4; off < 64; off <<= 1) { const float t2 = __shfl_up(run, off); if (lane >= off) run += t2; }
        const float excl = run - tot;
#pragma unroll
        for (int i = 0; i < 4; ++i) lf[i][k] += excl;
        bref[k] = __shfl(lf[3][k], 28 + dg); blast[k] = __shfl(lf[3][k], 60 + dg);
    }
    {
        float eref[4], elast[4];
#pragma unroll
        for (int k = 0; k < 4; ++k) { eref[k] = __expf(bref[k]); elast[k] = __expf(blast[k] - bref[k]); }
        if (tg == 15) *(f32x4*)(DECH + item * 128 + 16 * w + 4 * dg) = (f32x4){__expf(blast[0]), __expf(blast[1]), __expf(blast[2]), __expf(blast[3])};
        float kl[4][4];
#pragma unroll
        for (int i = 0; i < 4; ++i) { float qd[4], kd[4], qb[4];
#pragma unroll
            for (int k = 0; k < 4; ++k) { const float e1 = __expf(lf[i][k] - bref[k]), e2 = __expf(bref[k] - lf[i][k]);
                qd[k] = q[i][k] * e1; kd[k] = kk[i][k] * e2; qb[k] = qd[k] * eref[k]; kl[i][k] = kd[k] * elast[k]; }
            const int off = (4 * tg + i) * P128 + 16 * w + 4 * dg;
            *(LAS u32x2*)(QD + off) = pack4(qd[0], qd[1], qd[2], qd[3]); *(LAS u32x2*)(KD + off) = pack4(kd[0], kd[1], kd[2], kd[3]);
            *(u32x2*)(QBH + (row0 + 4 * tg + i) * 512 + h * 128 + 16 * w + 4 * dg) = pack4(qb[0], qb[1], qb[2], qb[3]); }
#pragma unroll
        for (int k = 0; k < 4; ++k) *(u32x2*)(KLH + item * 8192 + (16 * w + 4 * dg + k) * 64 + 4 * tg) = pack4(kl[0][k], kl[1][k], kl[2][k], kl[3][k]);
    }
    __syncthreads();
    {
        bf16x8 qf[4];
#pragma unroll
        for (int ks = 0; ks < 4; ++ks) qf[ks] = LDFRAG(QD, 16 * tt + r16, P128, ks);
#pragma unroll
        for (int si = 0; si < 2; ++si) { const int st = 2 * vh + si; f32x4 acc = {0.f, 0.f, 0.f, 0.f};
            if (st <= tt) {
#pragma unroll
                for (int ks = 0; ks < 4; ++ks) { const bf16x8 kf = LDFRAG(KD, 16 * st + r16, P128, ks); acc = MFMA16(kf, qf[ks], acc); }
                const int t = 16 * tt + r16, s0 = 16 * st + 4 * quad;
#pragma unroll
                for (int j = 0; j < 4; ++j) acc[j] = (s0 + j <= t) ? acc[j] : 0.f;
            }
            *(u32x2*)(ATH + item * 4096 + (16 * tt + r16) * 64 + 16 * st + 4 * quad) = pack4(acc[0], acc[1], acc[2], acc[3]); }
    }
    __syncthreads();
}
__device__ __forceinline__ void mlstm_pre(const Args& a, int b, int h, int c, LAS unsigned char* lds, int tid, int w, int lane) {
    const bf16_t* projb = (const bf16_t*)(a.ws + WS_PROJ); const float* gates = (const float*)(a.ws + WS_GATES);
    const float* cw = a.in[6]; const float* cb = a.in[7];
    bf16_t* QMM = (bf16_t*)a.out + (size_t)T * 1024; bf16_t* KLM = QMM + (size_t)T * 512; bf16_t* ATM = (bf16_t*)(a.ws + WS_ATM); float* SCM = (float*)(a.ws + WS_SCM);
    LAS bf16_t* QM = (LAS bf16_t*)lds; LAS bf16_t* KM = QM + 64 * P128;
    const int tg = lane >> 2, dg = lane & 3, quad = lane >> 4, r16 = lane & 15, tt = w >> 1, vh = w & 1;
    const size_t item = (size_t)((b * 4 + h) * 64 + c), row0 = (size_t)b * SEQ + c * 64;
    const float mi = gates[(row0 + lane) * 8 + h], mf = gates[(row0 + lane) * 8 + 4 + h];
    float bs = fminf(mf, 0.f) - log1pf(__expf(-fabsf(mf)));
#pragma unroll
    for (int off = 1; off < 64; off <<= 1) { const float t2 = __shfl_up(bs, off); if (lane >= off) bs += t2; }
    const float imb = mi - bs; float pm = imb;
#pragma unroll
    for (int off = 1; off < 64; off <<= 1) { const float t2 = __shfl_up(pm, off); if (lane >= off) pm = fmaxf(pm, t2); }
    const float pm63 = __shfl(pm, 63);
    if (w == 0) { f32x2_nat o2 = {bs, pm}; *(f32x2_nat*)(SCM + (row0 + lane) * 8 + h * 2) = o2; }
    const float aloc = __expf(imb - pm63);
    const bf16_t* pcol = projb + h * 128 + 16 * w + 4 * dg; const int ch = h * 128 + 16 * w + 4 * dg;
    float qv[4][4], kv[4][4];
    {
        float xq[7][4], xk[7][4];
#pragma unroll
        for (int i = 0; i < 7; ++i) { const int tpos = c * 64 + 4 * tg + i - 3;
            if (tpos >= 0) { const bf16_t* p = pcol + ((size_t)b * SEQ + tpos) * NP; unpack4(*(const u32x2*)(p + MQ), xq[i]); unpack4(*(const u32x2*)(p + MK), xk[i]); }
            else {
#pragma unroll
                for (int k = 0; k < 4; ++k) { xq[i][k] = 0.f; xk[i][k] = 0.f; } } }
        f32x4 wq[4], wk[4];
#pragma unroll
        for (int j = 0; j < 4; ++j) { wq[j] = *(const f32x4*)(cw + j * 1024 + ch); wk[j] = *(const f32x4*)(cw + j * 1024 + 512 + ch); }
        const f32x4 bq = *(const f32x4*)(cb + ch), bk = *(const f32x4*)(cb + 512 + ch);
#pragma unroll
        for (int i = 0; i < 4; ++i)
#pragma unroll
            for (int k = 0; k < 4; ++k) { float aq = bq[k], ak = bk[k];
#pragma unroll
                for (int j = 0; j < 4; ++j) { aq += xq[i + j][k] * wq[j][k]; ak += xk[i + j][k] * wk[j][k]; }
                qv[i][k] = aq * sigm(aq) * 0.08838834764831845f; kv[i][k] = ak * sigm(ak); }
    }
    {
        float ae[4];
#pragma unroll
        for (int i = 0; i < 4; ++i) ae[i] = __shfl(aloc, 4 * tg + i);
#pragma unroll
        for (int i = 0; i < 4; ++i) { const int off = (4 * tg + i) * P128 + 16 * w + 4 * dg; const u32x2 qp = pack4(qv[i][0], qv[i][1], qv[i][2], qv[i][3]);
            *(LAS u32x2*)(QM + off) = qp; *(LAS u32x2*)(KM + off) = pack4(kv[i][0], kv[i][1], kv[i][2], kv[i][3]);
            *(u32x2*)(QMM + (row0 + 4 * tg + i) * 512 + h * 128 + 16 * w + 4 * dg) = qp; }
#pragma unroll
        for (int k = 0; k < 4; ++k) *(u32x2*)(KLM + item * 8192 + (16 * w + 4 * dg + k) * 64 + 4 * tg) = pack4(kv[0][k] * ae[0], kv[1][k] * ae[1], kv[2][k] * ae[2], kv[3][k] * ae[3]);
    }
    __syncthreads();
    {
        bf16x8 qf[4];
#pragma unroll
        for (int ks = 0; ks < 4; ++ks) qf[ks] = LDFRAG(QM, 16 * tt + r16, P128, ks);
        const float pmt = __shfl(pm, 16 * tt + r16);
#pragma unroll
        for (int si = 0; si < 2; ++si) { const int st = 2 * vh + si; f32x4 acc = {0.f, 0.f, 0.f, 0.f};
            if (st <= tt) {
#pragma unroll
                for (int ks = 0; ks < 4; ++ks) { const bf16x8 kf = LDFRAG(KM, 16 * st + r16, P128, ks); acc = MFMA16(kf, qf[ks], acc); }
                const int t = 16 * tt + r16, s0 = 16 * st + 4 * quad;
#pragma unroll
                for (int j = 0; j < 4; ++j) { const float ims = __shfl(imb, s0 + j); acc[j] = (s0 + j <= t) ? acc[j] * __expf(ims - pmt) : 0.f; }
            }
            *(u32x2*)(ATM + item * 4096 + (16 * tt + r16) * 64 + 16 * st + 4 * quad) = pack4(acc[0], acc[1], acc[2], acc[3]); }
    }
    __syncthreads();
}
template <int KIND> __device__ __forceinline__ void scan_loop(const Args& a, int b, int h, LAS unsigned char* lds, int tid, int w, int lane, unsigned* bar, unsigned xcc, unsigned nxb, unsigned nx, unsigned& bround) {
    constexpr int NV = KIND ? 144 : 128, NVT = NV / 16;
    const bf16_t* projb = (const bf16_t*)(a.ws + WS_PROJ); bf16_t* y = (bf16_t*)(a.ws + WS_Y);
    const bf16_t* QBG = KIND ? (const bf16_t*)a.out + (size_t)T * 1024 : (const bf16_t*)a.out; const bf16_t* KLG = QBG + (size_t)T * 512;
    const bf16_t* ATG = (const bf16_t*)(a.ws + (KIND ? WS_ATM : WS_ATH)); const float* DECH = (const float*)(a.ws + WS_DECH); const float* SCM = (const float*)(a.ws + WS_SCM);
    const float* nw = KIND ? a.in[8] : a.in[5];
    LAS bf16_t* QB = (LAS bf16_t*)lds; LAS bf16_t* ATT = QB + 64 * P128; LAS bf16_t* KLT = ATT + 64 * P64; LAS bf16_t* VT = KLT + 128 * P64; LAS bf16_t* ST = VT + NV * P64;
    LAS float* NRM = (LAS float*)(ST + NV * P128); LAS float* NWL = NRM + 256;
    const int tg = lane >> 2, dg = lane & 3, quad = lane >> 4, r16 = lane & 15, tt = w >> 1, vh = w & 1;
    for (int e = tid; e < NV * P128 / 2; e += 512) ((LAS unsigned*)ST)[e] = 0u;
    if (KIND) for (int e = tid; e < 16 * P64 / 2; e += 512) ((LAS unsigned*)(VT + 128 * P64))[e] = (e < P64 / 2) ? 0x3F803F80u : 0u;
    if (tid < 128) NWL[tid] = nw[h * 128 + tid];
    f32x4 Sacc[10];
#pragma unroll
    for (int i = 0; i < 10; ++i) Sacc[i] = (f32x4){0.f, 0.f, 0.f, 0.f};
    float m_st = -1e30f;
    const size_t rowbase = (size_t)b * SEQ, item0 = (size_t)(b * 4 + h) * 64;
    const bf16_t* pv = projb + (KIND ? MV : HI) + h * 128 + 16 * w + 4 * dg;
    const bf16_t* pgat = projb + (KIND ? MO : HG) + h * 128 + 64 * vh + 4 * quad;
    struct PSet { u32x4n rqb[2], rat, rkl[2]; f32x4 rdec, rdec2; f32x2_nat rsc; }; u32x2 rv[4];
    PSet SA, SB; SA.rdec = SB.rdec = SA.rdec2 = SB.rdec2 = (f32x4){1.f, 1.f, 1.f, 1.f}; SA.rsc = SB.rsc = (f32x2_nat){0.f, 0.f};
#define SCAN_LOAD(P_, cc) do { const size_t rb_ = rowbase + (size_t)(cc) * 64, it_ = item0 + (cc); \
        _Pragma("unroll") for (int i = 0; i < 2; ++i) { const int e = tid + 512 * i; P_.rqb[i] = *(const u32x4n*)(QBG + (rb_ + (e >> 4)) * 512 + h * 128 + (e & 15) * 8); P_.rkl[i] = *(const u32x4n*)(KLG + it_ * 8192 + (size_t)e * 8); } \
        P_.rat = *(const u32x4n*)(ATG + it_ * 4096 + (size_t)tid * 8); \
        if (KIND) P_.rsc = *(const f32x2_nat*)(SCM + (rb_ + lane) * 8 + h * 2); else { P_.rdec = *(const f32x4*)(DECH + it_ * 128 + 32 * tt + 4 * quad); P_.rdec2 = *(const f32x4*)(DECH + it_ * 128 + 32 * tt + 16 + 4 * quad); } } while (0)
    SCAN_LOAD(SA, 0); SCAN_LOAD(SB, 1);
#pragma unroll
    for (int i = 0; i < 4; ++i) rv[i] = *(const u32x2*)(pv + (rowbase + 4 * tg + i) * NP);
    __syncthreads();
#define SCAN_STEP(P_, c) do { \
        u32x2 rgc[4]; f32x4 dec = P_.rdec, dec2 = P_.rdec2; float rt_ = 1.f, wi_ = 0.f, mt_ = 0.f, decay = 1.f, scU = 1.f, m_new = 0.f; \
_Pragma("unroll") \
        for (int i = 0; i < 2; ++i) { const int e = tid + 512 * i; *(LAS u32x4n*)(QB + (e >> 4) * P128 + (e & 15) * 8) = P_.rqb[i]; *(LAS u32x4n*)(KLT + (e >> 3) * P64 + (e & 7) * 8) = P_.rkl[i]; } \
        *(LAS u32x4n*)(ATT + (tid >> 3) * P64 + (tid & 7) * 8) = P_.rat; \
        { float vv[4][4]; \
_Pragma("unroll") \
            for (int i = 0; i < 4; ++i) unpack4(rv[i], vv[i]); \
_Pragma("unroll") \
            for (int k = 0; k < 4; ++k) *(LAS u32x2*)(VT + (16 * w + 4 * dg + k) * P64 + 4 * tg) = pack4(vv[0][k], vv[1][k], vv[2][k], vv[3][k]); } \
        if (KIND) {                                                    \
            const float bs = P_.rsc[0], pm = P_.rsc[1]; const float g = __shfl(bs, 63), amax = g + __shfl(pm, 63); \
            const float inter = bs + m_st, m_t = fmaxf(inter, pm + bs); \
            const float wi = __expf(inter - m_t), rr = __expf(bs + pm - m_t); \
            m_new = fmaxf(g + m_st, amax); decay = __expf(g + m_st - m_new); scU = __expf(amax - m_new); \
            rt_ = __shfl(rr, 16 * tt + r16); wi_ = __shfl(wi, 16 * tt + r16); mt_ = __shfl(m_t, 16 * tt + r16); \
        } \
        __syncthreads(); \
        if ((((c) & 15) == 14) && (c) < 62) grid_bar(bar, xcc, nxb, nx, ++bround);     \
        { const int cn = ((c) + 2 < 64) ? (c) + 2 : 63; SCAN_LOAD(P_, cn); { const int c1 = ((c) + 1 < 64) ? (c) + 1 : 63; _Pragma("unroll") for (int i = 0; i < 4; ++i) rv[i] = *(const u32x2*)(pv + (rowbase + (size_t)c1 * 64 + 4 * tg + i) * NP); } _Pragma("unroll") for (int vt = 0; vt < 4; ++vt) rgc[vt] = *(const u32x2*)(pgat + (rowbase + (size_t)(c) * 64 + 16 * tt + r16) * NP + 16 * vt); } \
        f32x4 o[4]; \
        { \
            bf16x8 af[2], qbf[4]; \
_Pragma("unroll") \
            for (int ks = 0; ks < 2; ++ks) af[ks] = LDFRAG(ATT, 16 * tt + r16, P64, ks); \
_Pragma("unroll") \
            for (int ks = 0; ks < 4; ++ks) qbf[ks] = LDFRAG(QB, 16 * tt + r16, P128, ks); \
            float dn = 1.f; \
            if (KIND) { f32x4 a1 = {0.f, 0.f, 0.f, 0.f}, a2 = {0.f, 0.f, 0.f, 0.f}; \
_Pragma("unroll") \
                for (int ks = 0; ks < 2; ++ks) a1 = MFMA16(LDFRAG(VT, 128 + r16, P64, ks), af[ks], a1); \
_Pragma("unroll") \
                for (int ks = 0; ks < 4; ++ks) a2 = MFMA16(LDFRAG(ST, 128 + r16, P128, ks), qbf[ks], a2); \
                const float dl = rt_ * a1[0] + wi_ * a2[0]; const float den = __shfl(dl, r16); \
                dn = __builtin_amdgcn_rcpf(fmaxf(fabsf(den), __expf(-mt_))); } \
            float s1 = 0.f, s2 = 0.f; \
_Pragma("unroll") \
            for (int vt = 0; vt < 4; ++vt) { const int v0 = 64 * vh + 16 * vt; f32x4 a1 = {0.f, 0.f, 0.f, 0.f}, a2 = {0.f, 0.f, 0.f, 0.f}; \
_Pragma("unroll") \
                for (int ks = 0; ks < 2; ++ks) a1 = MFMA16(LDFRAG(VT, v0 + r16, P64, ks), af[ks], a1); \
_Pragma("unroll") \
                for (int ks = 0; ks < 4; ++ks) a2 = MFMA16(LDFRAG(ST, v0 + r16, P128, ks), qbf[ks], a2); \
                f32x4 acc = KIND ? (a1 * rt_ + a2 * wi_) * dn : (a1 + a2); \
                o[vt] = acc; s1 += (acc[0] + acc[1]) + (acc[2] + acc[3]); s2 += (acc[0] * acc[0] + acc[1] * acc[1]) + (acc[2] * acc[2] + acc[3] * acc[3]); } \
            s1 += __shfl_xor(s1, 16); s1 += __shfl_xor(s1, 32); s2 += __shfl_xor(s2, 16); s2 += __shfl_xor(s2, 32); \
            if (quad == 0) { NRM[(16 * tt + r16) * 4 + 2 * vh] = s1; NRM[(16 * tt + r16) * 4 + 2 * vh + 1] = s2; } \
            bf16x8 klf[2][2]; \
_Pragma("unroll") \
            for (int dt2 = 0; dt2 < 2; ++dt2) { _Pragma("unroll") for (int ks = 0; ks < 2; ++ks) klf[dt2][ks] = LDFRAG(KLT, 32 * tt + 16 * dt2 + r16, P64, ks); } \
_Pragma("unroll") \
            for (int vt = 0; vt < 4; ++vt) { bf16x8 vf[2]; \
_Pragma("unroll") \
                for (int ks = 0; ks < 2; ++ks) vf[ks] = LDFRAG(VT, 64 * vh + 16 * vt + r16, P64, ks); \
_Pragma("unroll") \
                for (int dt2 = 0; dt2 < 2; ++dt2) { f32x4 u = {0.f, 0.f, 0.f, 0.f}; \
_Pragma("unroll") \
                    for (int ks = 0; ks < 2; ++ks) u = MFMA16(klf[dt2][ks], vf[ks], u); \
                    if (KIND) Sacc[dt2 * 4 + vt] = Sacc[dt2 * 4 + vt] * decay + u * scU; else Sacc[dt2 * 4 + vt] = Sacc[dt2 * 4 + vt] * (dt2 ? dec2 : dec) + u; } } \
            if (KIND && vh == 0) { bf16x8 vf[2]; \
_Pragma("unroll") \
                for (int ks = 0; ks < 2; ++ks) vf[ks] = LDFRAG(VT, 128 + r16, P64, ks); \
_Pragma("unroll") \
                for (int dt2 = 0; dt2 < 2; ++dt2) { f32x4 u = {0.f, 0.f, 0.f, 0.f}; \
_Pragma("unroll") \
                    for (int ks = 0; ks < 2; ++ks) u = MFMA16(klf[dt2][ks], vf[ks], u); \
                    Sacc[8 + dt2] = Sacc[8 + dt2] * decay + u * scU; } } \
        } \
        __syncthreads(); \
_Pragma("unroll") \
        for (int dt2 = 0; dt2 < 2; ++dt2) { \
_Pragma("unroll") \
            for (int vt = 0; vt < 4; ++vt) *(LAS u32x2*)(ST + (64 * vh + 16 * vt + r16) * P128 + 32 * tt + 16 * dt2 + 4 * quad) = pack4(Sacc[dt2 * 4 + vt][0], Sacc[dt2 * 4 + vt][1], Sacc[dt2 * 4 + vt][2], Sacc[dt2 * 4 + vt][3]); \
            if (KIND && vh == 0) *(LAS u32x2*)(ST + (128 + r16) * P128 + 32 * tt + 16 * dt2 + 4 * quad) = pack4(Sacc[8 + dt2][0], Sacc[8 + dt2][1], Sacc[8 + dt2][2], Sacc[8 + dt2][3]); } \
        { \
            const int t = 16 * tt + r16; const f32x4 nr = *(const LAS f32x4*)(NRM + t * 4); \
            const float mean = KIND ? (nr[0] + nr[2]) * (1.f / 128.f) : 0.f; const float var = fmaxf((nr[1] + nr[3]) * (1.f / 128.f) - mean * mean, 0.f); \
            const float rstd = __builtin_amdgcn_rsqf(var + LN_EPS); \
            bf16_t* yp = y + (rowbase + (c) * 64 + t) * D + (KIND ? 512 : 0) + h * 128 + 64 * vh + 4 * quad; \
_Pragma("unroll") \
            for (int vt = 0; vt < 4; ++vt) { float r[4], gt[4]; unpack4(rgc[vt], gt); const f32x4 nv = *(const LAS f32x4*)(NWL + 64 * vh + 16 * vt + 4 * quad); \
_Pragma("unroll") \
                for (int j = 0; j < 4; ++j) r[j] = gt[j] * (o[vt][j] - mean) * rstd * nv[j]; \
                *(u32x2*)(yp + 16 * vt) = pack4(r[0], r[1], r[2], r[3]); } \
        } \
        if (KIND) m_st = m_new; \
    } while (0)
    for (int c2 = 0; c2 < 64; c2 += 2) { SCAN_STEP(SA, c2); SCAN_STEP(SB, c2 + 1); }
#undef SCAN_STEP
#undef SCAN_LOAD
    __syncthreads();
}

__device__ __forceinline__ void ln_rows(const float* r, const float* gam, const float* bet, float* xo, bf16_t* xbo, int lane, int gw, int NGW) {
    const f32x4 *gp = (const f32x4*)gam + lane, *bp = (const f32x4*)bet + lane;
    for (int m = gw; m < T; m += 2 * NGW) {
        f32x4 v[2][4]; float s[2] = {0.f, 0.f};
#pragma unroll
        for (int q = 0; q < 2; ++q) { const f32x4* xr = (const f32x4*)(r + (size_t)(m + q * NGW) * D) + lane;
#pragma unroll
            for (int j = 0; j < 4; ++j) v[q][j] = xr[64 * j]; }
#pragma unroll
        for (int q = 0; q < 2; ++q)
#pragma unroll
            for (int j = 0; j < 4; ++j) s[q] += (v[q][j][0] + v[q][j][1]) + (v[q][j][2] + v[q][j][3]);
#pragma unroll
        for (int q = 0; q < 2; ++q) { const float mean = wave_sum(s[q]) * (1.f / D); float s2 = 0.f;
#pragma unroll
            for (int j = 0; j < 4; ++j) { v[q][j] = v[q][j] - mean; s2 += (v[q][j][0] * v[q][j][0] + v[q][j][1] * v[q][j][1]) + (v[q][j][2] * v[q][j][2] + v[q][j][3] * v[q][j][3]); }
            const float rstd = __builtin_amdgcn_rsqf(wave_sum(s2) * (1.f / D) + LN_EPS); const size_t mm = (size_t)(m + q * NGW);
#pragma unroll
            for (int j = 0; j < 4; ++j) { const f32x4 o = v[q][j] * rstd * gp[64 * j] + bp[64 * j];
                if (xo) ((f32x4*)(xo + mm * D) + lane)[64 * j] = o;
                if (xbo) { uint2 w; w.x = pk2(o[0], o[1]); w.y = pk2(o[2], o[3]); ((uint2*)(xbo + mm * D) + lane)[64 * j] = w; } } }
    }
}

__device__ __forceinline__ void ln_rows16(const bf16_t* r, const float* gam, const float* bet, float* xo, bf16_t* xbo, int lane, int gw, int NGW) {
    for (int m = gw; m < T; m += 2 * NGW) {
        float v[2][16]; float s[2] = {0.f, 0.f};
#pragma unroll
        for (int q = 0; q < 2; ++q) { const int mq = (m + q * NGW < T) ? m + q * NGW : m; const u32x4n* xr = (const u32x4n*)(r + (size_t)mq * D) + lane;
#pragma unroll
            for (int j = 0; j < 2; ++j) { const u32x4n w = xr[64 * j]; const unsigned ww[4] = {w.x, w.y, w.z, w.w};
#pragma unroll
                for (int i = 0; i < 4; ++i) { v[q][8 * j + 2 * i] = bflo(ww[i]); v[q][8 * j + 2 * i + 1] = bfhi(ww[i]); } } }
#pragma unroll
        for (int q = 0; q < 2; ++q)
#pragma unroll
            for (int i = 0; i < 16; ++i) s[q] += v[q][i];
#pragma unroll
        for (int q = 0; q < 2; ++q) { const float mean = wave_sum(s[q]) * (1.f / D); float s2 = 0.f;
#pragma unroll
            for (int i = 0; i < 16; ++i) { v[q][i] -= mean; s2 += v[q][i] * v[q][i]; }
            const float rstd = __builtin_amdgcn_rsqf(wave_sum(s2) * (1.f / D) + LN_EPS); const size_t mm = (size_t)(m + q * NGW); if (m + q * NGW >= T) continue;
#pragma unroll
            for (int j = 0; j < 2; ++j) { const int e0 = 8 * (lane + 64 * j); const f32x4 g0 = *(const f32x4*)(gam + e0), g1 = *(const f32x4*)(gam + e0 + 4), b0 = *(const f32x4*)(bet + e0), b1 = *(const f32x4*)(bet + e0 + 4);
                float o[8];
#pragma unroll
                for (int i = 0; i < 4; ++i) { o[i] = v[q][8 * j + i] * rstd * g0[i] + b0[i]; o[4 + i] = v[q][8 * j + 4 + i] * rstd * g1[i] + b1[i]; }
                if (xo) { __builtin_nontemporal_store((f32x4){o[0], o[1], o[2], o[3]}, (f32x4*)(xo + mm * D + e0)); __builtin_nontemporal_store((f32x4){o[4], o[5], o[6], o[7]}, (f32x4*)(xo + mm * D + e0 + 4)); }
                if (xbo) { u32x4n w; w.x = pk2(o[0], o[1]); w.y = pk2(o[2], o[3]); w.z = pk2(o[4], o[5]); w.w = pk2(o[6], o[7]); *(u32x4n*)(xbo + mm * D + e0) = w; } } }
    }
}

__device__ __forceinline__ void attn_phase(const bf16_t* qb, const bf16_t* kb, const bf16_t* vT, bf16_t* ao, LAS unsigned char* lds, int wave, int lane, int blk, int G) {
    LAS bf16_t* P = (LAS bf16_t*)(lds + wave * 8448);
    const int r16 = lane & 15, quad = lane >> 4;
    for (int bi = blk; bi < (T / 128) * 4; bi += G) {
        const int h = bi & 3, r0 = (bi >> 2) * 128 + wave * 16, b = r0 / SEQ;
        bf16x8 qa[8];
        const bf16_t* qp = qb + (size_t)(r0 + r16) * D + h * 256 + quad * 8;
#pragma unroll
        for (int ks = 0; ks < 8; ++ks) qa[ks] = *(const bf16x8*)(qp + ks * 32);
        f32x4 s[16];
        const bf16_t* kp = kb + (size_t)(b * 256 + r16) * D + h * 256 + quad * 8;
#pragma unroll
        for (int nt = 0; nt < 16; ++nt) { f32x4 acc = {0.f, 0.f, 0.f, 0.f};
#pragma unroll
            for (int ks = 0; ks < 8; ++ks) { const bf16x8 bfr = *(const bf16x8*)(kp + (size_t)nt * 16 * D + ks * 32); acc = __builtin_amdgcn_mfma_f32_16x16x32_bf16(qa[ks], bfr, acc, 0, 0, 0); }
            s[nt] = acc; }
        float sm[4];
#pragma unroll
        for (int j = 0; j < 4; ++j) { float mx = s[0][j];
#pragma unroll
            for (int nt = 1; nt < 16; ++nt) mx = fmaxf(mx, s[nt][j]);
            mx = fmaxf(mx, __shfl_xor(mx, 1)); mx = fmaxf(mx, __shfl_xor(mx, 2)); mx = fmaxf(mx, __shfl_xor(mx, 4)); mx = fmaxf(mx, __shfl_xor(mx, 8));
            float sum = 0.f;
#pragma unroll
            for (int nt = 0; nt < 16; ++nt) { const float p = __expf((s[nt][j] - mx) * 0.0625f); sum += p; P[(quad * 4 + j) * 264 + nt * 16 + r16] = f2bf(p); }
            sum += __shfl_xor(sum, 1); sum += __shfl_xor(sum, 2); sum += __shfl_xor(sum, 4); sum += __shfl_xor(sum, 8);
            sm[j] = 1.f / sum; }
        WAVE_LDS_SYNC();
        bf16x8 pa[8];
#pragma unroll
        for (int ks = 0; ks < 8; ++ks) pa[ks] = *(const LAS bf16x8*)(P + r16 * 264 + ks * 32 + quad * 8);
        WAVE_LDS_SYNC();
        const bf16_t* vp = vT + (size_t)(h * 256 + r16) * NMEMR + b * 256 + quad * 8;
        bf16_t* op = ao + (size_t)(r0 + quad * 4) * D + h * 256 + r16;
#pragma unroll
        for (int nt = 0; nt < 16; ++nt) { f32x4 acc = {0.f, 0.f, 0.f, 0.f};
#pragma unroll
            for (int ks = 0; ks < 8; ++ks) { const bf16x8 bfr = *(const bf16x8*)(vp + (size_t)nt * 16 * NMEMR + ks * 32); acc = __builtin_amdgcn_mfma_f32_16x16x32_bf16(pa[ks], bfr, acc, 0, 0, 0); }
#pragma unroll
            for (int j = 0; j < 4; ++j) op[(size_t)j * D + nt * 16] = f2bf(acc[j] * sm[j]); }
    }
}


__device__ __forceinline__ void attn_phase2(const bf16_t* qb, const bf16_t* kb, const bf16_t* vT, bf16_t* ao, LAS unsigned char* lds, int tid, int wave, int lane, int blk, int G) {
    constexpr int PKV = 264;
    LAS bf16_t* KV = (LAS bf16_t*)lds;
    const int r16 = lane & 15, quad = lane >> 4;
    for (int bi = blk; bi < (T / 128) * 4; bi += G) {
        const int h = bi & 3, chunk = bi >> 2, r0 = chunk * 128 + wave * 16, b = chunk >> 5;
        { const bf16_t* sp = kb + (size_t)(b * 256 + (tid >> 5)) * D + h * 256 + (tid & 31) * 8; LAS bf16_t* dp = KV + (tid >> 5) * PKV + (tid & 31) * 8;
#pragma unroll 1
            for (int q4 = 0; q4 < 4; ++q4) { u32x4n v[4];
#pragma unroll
                for (int i = 0; i < 4; ++i) v[i] = *(const u32x4n*)(sp + (size_t)(16 * i) * D);
#pragma unroll
                for (int i = 0; i < 4; ++i) *(LAS u32x4n*)(dp + (16 * i) * PKV) = v[i];
                sp += (size_t)64 * D; dp += 64 * PKV; } }
        bf16x8 qf[8];
        { const bf16_t* qp = qb + (size_t)(r0 + r16) * D + h * 256 + quad * 8;
#pragma unroll
            for (int ks = 0; ks < 8; ++ks) qf[ks] = *(const bf16x8*)(qp + ks * 32); }
        __syncthreads();
        f32x4 sc[16];
#pragma unroll
        for (int nt = 0; nt < 16; ++nt) { f32x4 acc = {0.f, 0.f, 0.f, 0.f};
#pragma unroll
            for (int ks = 0; ks < 8; ++ks) acc = MFMA16(LDFRAG(KV, nt * 16 + r16, PKV, ks), qf[ks], acc);
            sc[nt] = acc; }
        float mx = sc[0][0];
#pragma unroll
        for (int nt = 0; nt < 16; ++nt)
#pragma unroll
            for (int j = 0; j < 4; ++j) mx = fmaxf(mx, sc[nt][j]);
        mx = fmaxf(mx, __shfl_xor(mx, 16)); mx = fmaxf(mx, __shfl_xor(mx, 32));
        float sum = 0.f;
#pragma unroll
        for (int nt = 0; nt < 16; ++nt)
#pragma unroll
            for (int j = 0; j < 4; ++j) { const float pv = __expf((sc[nt][j] - mx) * 0.0625f); sc[nt][j] = pv; sum += pv; }
        sum += __shfl_xor(sum, 16); sum += __shfl_xor(sum, 32);
        const float inv = __builtin_amdgcn_rcpf(sum);
        bf16x8 pf[8];
#pragma unroll
        for (int k2 = 0; k2 < 8; ++k2) { u32x4n w; w.x = pk2(sc[2 * k2][0], sc[2 * k2][1]); w.y = pk2(sc[2 * k2][2], sc[2 * k2][3]); w.z = pk2(sc[2 * k2 + 1][0], sc[2 * k2 + 1][1]); w.w = pk2(sc[2 * k2 + 1][2], sc[2 * k2 + 1][3]);
            pf[k2] = __builtin_bit_cast(bf16x8, w); }
        __syncthreads();
        { const bf16_t* sp = vT + (size_t)(h * 256 + (tid >> 5)) * NMEMR + b * 256 + (tid & 31) * 8; LAS bf16_t* dp = KV + (tid >> 5) * PKV + (tid & 31) * 8;
#pragma unroll 1
            for (int q4 = 0; q4 < 4; ++q4) { u32x4n v[4];
#pragma unroll
                for (int i = 0; i < 4; ++i) v[i] = *(const u32x4n*)(sp + (size_t)(16 * i) * NMEMR);
#pragma unroll
                for (int i = 0; i < 4; ++i) *(LAS u32x4n*)(dp + (16 * i) * PKV) = v[i];
                sp += (size_t)64 * NMEMR; dp += 64 * PKV; } }
        __syncthreads();
        bf16_t* op = ao + (size_t)(r0 + r16) * D + h * 256 + 4 * quad;
#pragma unroll
        for (int dt = 0; dt < 16; ++dt) { f32x4 acc = {0.f, 0.f, 0.f, 0.f};
#pragma unroll
            for (int k2 = 0; k2 < 8; ++k2) { const LAS bf16_t* vp = KV + (dt * 16 + r16) * PKV + 32 * k2 + 4 * quad;
                const u32x2 lo = *(const LAS u32x2*)vp, hi = *(const LAS u32x2*)(vp + 16);
                const u32x4n av = {lo.x, lo.y, hi.x, hi.y};
                acc = MFMA16(__builtin_bit_cast(bf16x8, av), pf[k2], acc); }
            *(u32x2*)(op + dt * 16) = pack4(acc[0] * inv, acc[1] * inv, acc[2] * inv, acc[3] * inv); }
        __syncthreads();
    }
}


__device__ __forceinline__ void attn_phase3(const bf16_t* qb, const bf16_t* kb, const bf16_t* vT, bf16_t* ao, LAS unsigned char* lds, int tid, int wave, int lane, int blk, int G) {
    constexpr int PKV = 264;
    LAS bf16_t* KV = (LAS bf16_t*)lds;
    const int r16 = lane & 15, quad = lane >> 4;
    for (int bi = blk; bi < (T / 256) * 4; bi += G) {
        const int h = bi & 3, chunk = bi >> 2, r0 = chunk * 256 + wave * 32, b = chunk >> 4;
        { const bf16_t* sp = kb + (size_t)(b * 256 + (tid >> 5)) * D + h * 256 + (tid & 31) * 8; LAS bf16_t* dp = KV + (tid >> 5) * PKV + (tid & 31) * 8;
#pragma unroll 1
            for (int q4 = 0; q4 < 4; ++q4) { u32x4n v[4];
#pragma unroll
                for (int i = 0; i < 4; ++i) v[i] = *(const u32x4n*)(sp + (size_t)(16 * i) * D);
#pragma unroll
                for (int i = 0; i < 4; ++i) *(LAS u32x4n*)(dp + (16 * i) * PKV) = v[i];
                sp += (size_t)64 * D; dp += 64 * PKV; } }
        bf16x8 qfA[8], qfB[8];
        { const bf16_t* qp = qb + (size_t)(r0 + r16) * D + h * 256 + quad * 8;
#pragma unroll
            for (int ks = 0; ks < 8; ++ks) { qfA[ks] = *(const bf16x8*)(qp + ks * 32); qfB[ks] = *(const bf16x8*)(qp + (size_t)16 * D + ks * 32); } }
        __syncthreads();
        f32x4 scA[16], scB[16];
#pragma unroll
        for (int nt = 0; nt < 16; ++nt) { f32x4 aA = {0.f, 0.f, 0.f, 0.f}, aB = {0.f, 0.f, 0.f, 0.f};
#pragma unroll
            for (int ks = 0; ks < 8; ++ks) { const bf16x8 kf = LDFRAG(KV, nt * 16 + r16, PKV, ks); aA = MFMA16(kf, qfA[ks], aA); aB = MFMA16(kf, qfB[ks], aB); }
            scA[nt] = aA; scB[nt] = aB; }
        bf16x8 pfA[8], pfB[8]; float invA, invB;
#define ATT_SOFTMAX(sc, pf, inv) do { float mx = sc[0][0]; \
            _Pragma("unroll") for (int nt = 0; nt < 16; ++nt) { _Pragma("unroll") for (int j = 0; j < 4; ++j) mx = fmaxf(mx, sc[nt][j]); } \
            mx = fmaxf(mx, __shfl_xor(mx, 16)); mx = fmaxf(mx, __shfl_xor(mx, 32)); float sum = 0.f; \
            _Pragma("unroll") for (int nt = 0; nt < 16; ++nt) { _Pragma("unroll") for (int j = 0; j < 4; ++j) { const float pv = __expf((sc[nt][j] - mx) * 0.0625f); sc[nt][j] = pv; sum += pv; } } \
            sum += __shfl_xor(sum, 16); sum += __shfl_xor(sum, 32); inv = __builtin_amdgcn_rcpf(sum); \
            _Pragma("unroll") for (int k2 = 0; k2 < 8; ++k2) { u32x4n w; w.x = pk2(sc[2 * k2][0], sc[2 * k2][1]); w.y = pk2(sc[2 * k2][2], sc[2 * k2][3]); w.z = pk2(sc[2 * k2 + 1][0], sc[2 * k2 + 1][1]); w.w = pk2(sc[2 * k2 + 1][2], sc[2 * k2 + 1][3]); \
                pf[k2] = __builtin_bit_cast(bf16x8, w); } } while (0)
        ATT_SOFTMAX(scA, pfA, invA); ATT_SOFTMAX(scB, pfB, invB);
#undef ATT_SOFTMAX
        __syncthreads();
        { const bf16_t* sp = vT + (size_t)(h * 256 + (tid >> 5)) * NMEMR + b * 256 + (tid & 31) * 8; LAS bf16_t* dp = KV + (tid >> 5) * PKV + (tid & 31) * 8;
#pragma unroll 1
            for (int q4 = 0; q4 < 4; ++q4) { u32x4n v[4];
#pragma unroll
                for (int i = 0; i < 4; ++i) v[i] = *(const u32x4n*)(sp + (size_t)(16 * i) * NMEMR);
#pragma unroll
                for (int i = 0; i < 4; ++i) *(LAS u32x4n*)(dp + (16 * i) * PKV) = v[i];
                sp += (size_t)64 * NMEMR; dp += 64 * PKV; } }
        __syncthreads();
        bf16_t* op = ao + (size_t)(r0 + r16) * D + h * 256 + 4 * quad;
#pragma unroll
        for (int dt = 0; dt < 16; ++dt) { f32x4 aA = {0.f, 0.f, 0.f, 0.f}, aB = {0.f, 0.f, 0.f, 0.f};
#pragma unroll
            for (int k2 = 0; k2 < 8; ++k2) { const LAS bf16_t* vp = KV + (dt * 16 + r16) * PKV + 32 * k2 + 4 * quad;
                const u32x2 lo = *(const LAS u32x2*)vp, hi = *(const LAS u32x2*)(vp + 16);
                const u32x4n av = {lo.x, lo.y, hi.x, hi.y}; const bf16x8 avf = __builtin_bit_cast(bf16x8, av);
                aA = MFMA16(avf, pfA[k2], aA); aB = MFMA16(avf, pfB[k2], aB); }
            *(u32x2*)(op + dt * 16) = pack4(aA[0] * invA, aA[1] * invA, aA[2] * invA, aA[3] * invA);
            *(u32x2*)(op + (size_t)16 * D + dt * 16) = pack4(aB[0] * invB, aB[1] * invB, aB[2] * invB, aB[3] * invB); }
        __syncthreads();
    }
}

__device__ __forceinline__ void conv_phase(const bf16_t* ub, const float* cw, const float* cb, bf16_t* hb, int half, int gtid, int NT) {
    for (int item = gtid; item < TH * 352; item += NT) {
        const int tl = item / 352, c8 = item - tl * 352, n0 = c8 * 8, t = half * TH + tl, tpos = t & (SEQ - 1);
        float ga[8], va[8];
#pragma unroll
        for (int i = 0; i < 8; ++i) { ga[i] = cb[n0 + i]; va[i] = cb[DFF + n0 + i]; }
#pragma unroll
        for (int j = 0; j < 3; ++j) { if (tpos - 2 + j >= 0) { const bf16_t* p = ub + (size_t)(tl - 2 + j) * NUP + n0;
            const uint4 gq = *(const uint4*)p, vq = *(const uint4*)(p + DFF); const unsigned gw4[4] = {gq.x, gq.y, gq.z, gq.w}, vw4[4] = {vq.x, vq.y, vq.z, vq.w};
            const float* wg = cw + (size_t)j * NUP + n0; const float* wv = wg + DFF;
#pragma unroll
            for (int i = 0; i < 4; ++i) { ga[2 * i] += bflo(gw4[i]) * wg[2 * i]; ga[2 * i + 1] += bfhi(gw4[i]) * wg[2 * i + 1]; va[2 * i] += bflo(vw4[i]) * wv[2 * i]; va[2 * i + 1] += bfhi(vw4[i]) * wv[2 * i + 1]; } } }
        uint4 o; o.x = pk2(gelu_tanh(ga[0]) * va[0], gelu_tanh(ga[1]) * va[1]); o.y = pk2(gelu_tanh(ga[2]) * va[2], gelu_tanh(ga[3]) * va[3]);
        o.z = pk2(gelu_tanh(ga[4]) * va[4], gelu_tanh(ga[5]) * va[5]); o.w = pk2(gelu_tanh(ga[6]) * va[6], gelu_tanh(ga[7]) * va[7]);
        *(uint4*)(hb + (size_t)t * DFF + n0) = o;
    }
}

template <class Epi> __device__ __forceinline__ void run_gemm(LAS unsigned char* lds, const bf16_t* A, const bf16_t* Bt, int M, int N, int K, const Epi& E) {
    pg8::Gemm g{A, Bt, M, N, K}; pg8::StaticOrder S; S.init(M, N, (int)gridDim.x, (int)blockIdx.x);
    pg8::gemm_phase2<Epi, pg8::StaticOrder, true, true>(lds, g, S, E);
}
__global__ void __launch_bounds__(512, 2) fwd_megakernel(Args a) {
    extern __shared__ __attribute__((aligned(16))) unsigned char shm[];
    LAS unsigned char* lds = (LAS unsigned char*)shm;
    const int tid = threadIdx.x, lane = tid & 63, wave = __builtin_amdgcn_readfirstlane(tid >> 6);
    const int G = gridDim.x, blk = blockIdx.x, gw = blk * 8 + wave, NGW = G * 8;
    unsigned char* ws = a.ws;
    const int lo = a.ph_lo, hi = a.ph_hi;
#if N_LAUNCH_MODE == 0
    cg::grid_group grid = cg::this_grid();
    unsigned* const bar = (unsigned*)(ws + WS_BAR); const unsigned xcc = xcc_id(); unsigned nxb = 0, nx = 0, bround = 0;
    if (tid == 0) { __hip_atomic_fetch_add(bar + 64 * (17 + xcc), 1u, __ATOMIC_RELAXED, __HIP_MEMORY_SCOPE_AGENT); __hip_atomic_fetch_add(bar + 64 * 33, 1u, __ATOMIC_RELAXED, __HIP_MEMORY_SCOPE_AGENT);
        while (__hip_atomic_load(bar + 64 * 33, __ATOMIC_RELAXED, __HIP_MEMORY_SCOPE_AGENT) < (unsigned)G) __builtin_amdgcn_s_sleep(1); }
    __syncthreads();
    nxb = __hip_atomic_load(bar + 64 * (17 + xcc), __ATOMIC_RELAXED, __HIP_MEMORY_SCOPE_AGENT);
    for (int x_ = 0; x_ < 16; ++x_) nx += (__hip_atomic_load(bar + 64 * (17 + x_), __ATOMIC_RELAXED, __HIP_MEMORY_SCOPE_AGENT) != 0u) ? 1u : 0u;
    if (a.ph_hi < 0) grid.sync();
#define SEAM(k) do { if (lo <= (k) && (k) + 1 < hi) grid_bar(bar, xcc, nxb, nx, ++bround); } while (0)
#define SEAM2() do { if (hi - lo > 1) grid_bar(bar, xcc, nxb, nx, ++bround); } while (0)
#else
#define SEAM(k) do { } while (0)
#define SEAM2() do { } while (0)
#endif
#define IN(k) (lo <= (k) && (k) < hi)
    bf16_t* xb = (bf16_t*)(ws + WS_XB); bf16_t* projb = (bf16_t*)(ws + WS_PROJ);
    float* x1 = (float*)(ws + WS_X1); bf16_t* x1b = (bf16_t*)(ws + WS_X1B); bf16_t* qb = (bf16_t*)(ws + WS_QB); bf16_t* x2b = (bf16_t*)(ws + WS_X1B); bf16_t* r16b = (bf16_t*)(ws + WS_X1)  ; bf16_t* r3b = (bf16_t*)(ws + WS_XB)  ;
    bf16_t* kb = (bf16_t*)(ws + WS_KB); bf16_t* vT = (bf16_t*)(ws + WS_VT); bf16_t* memb = (bf16_t*)(ws + WS_MEMB);
    bf16_t* ub = (bf16_t*)(ws + WS_UB); bf16_t* hb = (bf16_t*)(ws + WS_HB);

    if (IN(0)) { p0_prep(a, lds, tid, wave, lane, gw, NGW); __syncthreads(); SEAM(0); }
    if (IN(1)) {
        run_gemm(lds, xb, (const bf16_t*)(ws + WS_WIN), T, NP, D, pg8::EpiB16{projb, NP, a.in[3], 0x00C3u, 0xC000u});
        __syncthreads(); SEAM(1); }
    if (IN(2)) {
        for (int it = blk; it < 1024; it += G) { const int kind = it >> 9, bh = (it >> 4) & 31, c = it & 15;
            if (kind == 0) hgrn2_pre(a, bh >> 2, bh & 3, c, lds, tid, wave, lane); else mlstm_pre(a, bh >> 2, bh & 3, c, lds, tid, wave, lane); }
        __syncthreads(); SEAM(2); }
    if (IN(3)) {
        if (blk < 32) scan_loop<0>(a, (blk >> 2) & 7, blk & 3, lds, tid, wave, lane, bar, xcc, nxb, nx, bround);
        else if (blk < 64) scan_loop<1>(a, (blk >> 2) & 7, blk & 3, lds, tid, wave, lane, bar, xcc, nxb, nx, bround);
        else {
            for (int sl = 1; sl < 4; ++sl) {
                for (int it = blk - 64; it < 1024; it += G - 64) { const int kind = it >> 9, bh = (it >> 4) & 31, c = 16 * sl + (it & 15);
                    if (kind == 0) hgrn2_pre(a, bh >> 2, bh & 3, c, lds, tid, wave, lane); else mlstm_pre(a, bh >> 2, bh & 3, c, lds, tid, wave, lane); }
                __syncthreads(); grid_bar(bar, xcc, nxb, nx, ++bround); }
            late_prep(a, lds, wave, lane, (blk - 64) * 8 + wave, (G - 64) * 8); __syncthreads();
            { pg8::Gemm g{memb, (const bf16_t*)(ws + WS_WKV), NMEMR, D, D}; pg8::StaticOrder S; S.init(NMEMR, D, G - 64, blk - 64); pg8::gemm_phase2<pg8::EpiB16, pg8::StaticOrder, true, true>(lds, g, S, pg8::EpiB16{kb, D, nullptr, 0u, 0u}); }
            { pg8::Gemm g{(const bf16_t*)(ws + WS_WKV) + (size_t)D * D, memb, D, NMEMR, D}; pg8::StaticOrder S; S.init(D, NMEMR, G - 64, blk - 64); pg8::gemm_phase2<pg8::EpiB16, pg8::StaticOrder, true, true>(lds, g, S, pg8::EpiB16{vT, NMEMR, nullptr, 0u, 0u}); }
        }
        __syncthreads();
        SEAM(3); }
    if (IN(4)) { run_gemm(lds, (const bf16_t*)(ws + WS_Y), (const bf16_t*)(ws + WS_WOUT), T, D, D, pg8::EpiResO16<false>{a.in[0], r16b, D, ALPHA, (float*)(ws + WS_ST1)}); __syncthreads(); SEAM(4); }
    if (IN(6)) { run_gemm(lds, r16b, (const bf16_t*)(ws + WS_WQ), T, D, D, pg8::EpiLNq{qb, D, (const float*)(ws + WS_ST1), (const float*)(ws + WS_CV), (const float*)(ws + WS_CV) + 1024}); __syncthreads(); SEAM(6); }
    if (IN(7)) { attn_phase3(qb, kb, vT, xb  , lds, tid, wave, lane, blk, G); __syncthreads(); SEAM(7); }
    if (IN(8)) { run_gemm(lds, xb  , (const bf16_t*)(ws + WS_WO), T, D, D, pg8::EpiResLN{r16b, (const float*)(ws + WS_ST1), a.in[10], a.in[11], r16b, D, ALPHA, nullptr}); __syncthreads(); SEAM(8); }
    if (IN(9)) { ln_rows16(r16b, a.in[15], a.in[16], nullptr, x2b, lane, gw, NGW); SEAM(9); }
    if (IN(10)) {
        pg8::Gemm g{x2b, (const bf16_t*)(ws + WS_WUP), 136 * 256, NUP, D}; pg8::StaticOrder S; S.init(136 * 256, NUP, (int)gridDim.x, (int)blockIdx.x);
        pg8::gemm_phase2_ffn<pg8::EpiFFN, pg8::StaticOrder, true, true>(lds, g, S, pg8::EpiFFN{hb, a.in[18], a.in[19]});
        __syncthreads(); SEAM(10); }
    if (IN(14)) { run_gemm(lds, hb, (const bf16_t*)(ws + WS_WDN), T, D, DFF, pg8::EpiResO16<true>{x2b, r3b, D, ALPHA, nullptr}); __syncthreads(); SEAM(14); }
    if (IN(15)) { ln_rows16(r3b, a.in[21], a.in[22], a.out, nullptr, lane, gw, NGW); }
}

extern "C" void kernel_launch(void* const* d_in, const int* in_sizes, int n_in, void* d_out, int out_size, void* d_ws, size_t ws_size, hipStream_t stream) {
    static int grid = 0;
    if (grid == 0) {
        int dev = 0, cus = 0, per_cu = 0;
        hipGetDevice(&dev); hipDeviceGetAttribute(&cus, hipDeviceAttributeMultiprocessorCount, dev);
        if (hipFuncSetAttribute((const void*)fwd_megakernel, hipFuncAttributeMaxDynamicSharedMemorySize, LDS_BYTES) != hipSuccess) { fprintf(stderr, "hipFuncSetAttribute failed\n"); }
        if (hipOccupancyMaxActiveBlocksPerMultiprocessor(&per_cu, (const void*)fwd_megakernel, 512, LDS_BYTES) != hipSuccess || per_cu < 1) { fprintf(stderr, "occupancy query: %d\n", per_cu); per_cu = 1; }
        (void)hipGetLastError();
        grid = cus * per_cu;
        if (ws_size < 482 * MiB) fprintf(stderr, "workspace too small: %zu\n", ws_size);
    }
    Args a{};
    for (int i = 0; i < 23; ++i) a.in[i] = (const float*)d_in[i];
    a.out = (float*)d_out; a.ws = (unsigned char*)d_ws;
#if N_LAUNCH_MODE == 0
    (void)hipMemsetAsync((unsigned char*)d_ws + WS_BAR, 0, 64 * 34 * 4, stream);
    a.ph_lo = 0; a.ph_hi = NPH; void* args[] = {&a};
    hipError_t e = hipLaunchCooperativeKernel((const void*)fwd_megakernel, dim3(grid), dim3(512), args, LDS_BYTES, stream);
    if (e != hipSuccess) fprintf(stderr, "cooperative launch failed: %s (grid %d)\n", hipGetErrorString(e), grid);
#else
    for (int ph = 0; ph < NPH; ++ph) { a.ph_lo = ph; a.ph_hi = ph + 1; hipLaunchKernelGGL(fwd_megakernel, dim3(grid), dim3(512), LDS_BYTES, stream, a); }
#endif
}
```
